# Optimizing an MI355X kernel written in HIP

```python
import math
import jax, jax.numpy as jnp
from jax import lax
import numpy as np

D_MODEL = 1024
BATCH = 4
SEQ = 8192
DEPTH = 2

CTX_LEN = 256
GRID_W = 64
RMS_EPS = 1e-6
POOL_WIDTH = 1024
POOL_WINDOWS = (2, 4, 8, 16)
POOL_GROUP = POOL_WIDTH // len(POOL_WINDOWS)
LRU_WIDTH = 1024
LRU_BLOCKS = 8
LRU_BLOCK_W = LRU_WIDTH // LRU_BLOCKS
CONV_W = 4
LRU_C = 8.0
MLA_HEADS = 8
Q_LORA = 384
KV_LORA = 256
QK_NOPE = 128
QK_ROPE = 64
V_DIM = 128
MLA_WIDTH = MLA_HEADS * V_DIM
MLA_SCALE = (QK_NOPE + QK_ROPE) ** -0.5
ROPE_FREQS = QK_ROPE // 4
ROPE_THETA = 10000.0
Q_BLOCK = 128
N_BRANCH = 3
IN_SPLITS = (POOL_WIDTH, LRU_WIDTH, LRU_WIDTH, Q_LORA, KV_LORA, QK_ROPE, N_BRANCH * D_MODEL)
IN_COLS = sum(IN_SPLITS)
D_FF = 2816
N_EXPERTS = 8
TOP_K = 2
EXPERT_FF = 3584
MOE_BLOCK = 256
N_DENSE = (DEPTH + 1) // 2
N_MOE = DEPTH // 2

kernel_name = "hybrid_pool_rglru_mla_moe_diffusion_trunk"


def rms_norm(x, g):
    xf = x.astype(jnp.float32)
    y = xf * lax.rsqrt(jnp.mean(xf * xf, axis=-1, keepdims=True) + RMS_EPS)
    return (y * g.astype(jnp.float32)).astype(x.dtype)


def modulate(h, shift, scale):
    return h * (1 + scale) + shift


def split_cols(z):
    offs = [int(o) for o in np.cumsum(IN_SPLITS)[:-1]]
    return jnp.split(z, offs, axis=-1)


def swiglu(h, w1, w3, w2):
    return (jax.nn.silu(h @ w1) * (h @ w3)) @ w2


def multiscale_pool(u):
    L = u.shape[1]
    cs = jnp.pad(jnp.cumsum(u.astype(jnp.float32), axis=1), ((0, 0), (1, 0), (0, 0)))
    t = jnp.arange(L)
    outs = []
    for g, w in enumerate(POOL_WINDOWS):
        lo = jnp.clip(t - w // 2, 0, L)
        hi = jnp.clip(t + w - w // 2, 0, L)
        cg = cs[..., g * POOL_GROUP:(g + 1) * POOL_GROUP]
        s = jnp.take(cg, hi, axis=1) - jnp.take(cg, lo, axis=1)
        outs.append(s / (hi - lo).astype(jnp.float32)[None, :, None])
    return jnp.concatenate(outs, axis=-1).astype(u.dtype) - u


def pool_branch(u, pool_w, pool_scale, pool_proj):
    B, L, _ = u.shape
    m = multiscale_pool(u).reshape(B, L, len(POOL_WINDOWS), POOL_GROUP)
    m = jnp.einsum('blgi,gij->blgj', m, pool_w).reshape(B, L, POOL_WIDTH) * pool_scale
    return m @ pool_proj


def short_conv(u, w, b):
    L = u.shape[1]
    left = CONV_W // 2
    up = jnp.pad(u, ((0, 0), (left, CONV_W - 1 - left), (0, 0)))
    out = b
    for k in range(CONV_W):
        out = out + w[k] * up[:, k:k + L]
    return out


def block_diag(u, w, b):
    B, L, _ = u.shape
    y = jnp.einsum('blnj,njk->blnk', u.reshape(B, L, LRU_BLOCKS, LRU_BLOCK_W), w)
    return y.reshape(B, L, LRU_WIDTH) + b


def rglru_coeffs(u, wa, ba, wx, bx, lam):
    r = jax.nn.sigmoid(block_diag(u, wa, ba).astype(jnp.float32))
    i = jax.nn.sigmoid(block_diag(u, wx, bx).astype(jnp.float32))
    log_a = -LRU_C * r * jax.nn.softplus(-lam.astype(jnp.float32))
    a = jnp.exp(log_a)
    b = jnp.sqrt(-jnp.expm1(2.0 * log_a)) * (i * u.astype(jnp.float32))
    return a, b


def linear_scan(a, b, h0, reverse):
    def combine(l, r):
        return l[0] * r[0], r[0] * l[1] + r[1]
    a_cum, b_cum = lax.associative_scan(combine, (a, b), reverse=reverse, axis=1)
    return a_cum * h0[:, None, :] + b_cum


def axial_rope_tables(n_tokens):
    rows = n_tokens // GRID_W
    row = jnp.repeat(jnp.arange(rows, dtype=jnp.float32), GRID_W)
    col = (jnp.arange(rows * GRID_W) % GRID_W).astype(jnp.float32)
    inv = ROPE_THETA ** (-jnp.arange(ROPE_FREQS, dtype=jnp.float32) / ROPE_FREQS)
    ang = jnp.stack([row[:, None] * inv, col[:, None] * inv], axis=1)
    return jnp.cos(ang), jnp.sin(ang)


def apply_axial_rope(x, cos, sin):
    xs = x.reshape(x.shape[:-1] + (2, 2, ROPE_FREQS))
    x1, x2 = xs[..., 0, :], xs[..., 1, :]
    out = jnp.stack([x1 * cos - x2 * sin, x2 * cos + x1 * sin], axis=-2)
    return out.reshape(x.shape).astype(x.dtype)


def mla_query(cq, q_norm_g, w_uq):
    B, L, _ = cq.shape
    return (rms_norm(cq, q_norm_g) @ w_uq).reshape(B, L, MLA_HEADS, QK_NOPE + QK_ROPE)


def mla_keys_values(ckv, k_rope, kv_norm_g, w_ukv):
    B, L, _ = ckv.shape
    kv = (rms_norm(ckv, kv_norm_g) @ w_ukv).reshape(B, L, MLA_HEADS, QK_NOPE + V_DIM)
    k_r = jnp.broadcast_to(k_rope[:, :, None, :], (B, L, MLA_HEADS, QK_ROPE))
    return jnp.concatenate([kv[..., :QK_NOPE], k_r], axis=-1), kv[..., QK_NOPE:]


def attend(q, k, v):
    s = jnp.einsum('bqhd,bkhd->bhqk', q, k).astype(jnp.float32) * MLA_SCALE
    p = jax.nn.softmax(s, axis=-1).astype(v.dtype)
    return jnp.einsum('bhqk,bkhd->bqhd', p, v)


def attend_blocks(q, k, v):
    B, L, H, Dk = q.shape
    nb = L // Q_BLOCK
    qb = q.reshape(B, nb, Q_BLOCK, H, Dk).transpose(1, 0, 2, 3, 4)
    ob = lax.map(lambda qi: attend(qi, k, v), qb)
    return ob.transpose(1, 0, 2, 3, 4).reshape(B, L, H, V_DIM)


def merge_branches(gt, ys, w_out):
    g = jnp.split(jax.nn.sigmoid(gt.astype(jnp.float32)).astype(gt.dtype), N_BRANCH, axis=-1)
    return (g[0] * ys[0] + g[1] * ys[1] + g[2] * ys[2]) @ w_out


def token_mixer(h_ctx, h_lat, cos, sin, w_in, pool_w, pool_scale, pool_proj, conv_w, conv_b,
                gate_a_w, gate_a_b, gate_x_w, gate_x_b, lru_lambda, lru_proj,
                q_norm_g, w_uq, kv_norm_g, w_ukv, mla_proj, w_out, need_ctx):
    B, L, _ = h_lat.shape
    pool_c, lx_c, lg_c, cq_c, ckv_c, kr_c, gt_c = split_cols(h_ctx @ w_in)
    pool_l, lx_l, lg_l, cq_l, ckv_l, kr_l, gt_l = split_cols(h_lat @ w_in)

    u_c = short_conv(lx_c, conv_w, conv_b)
    u_l = short_conv(lx_l, conv_w, conv_b)
    ctx_dirs, lat_dirs = [], []
    for d in range(2):
        rev = d == 1
        a, b = rglru_coeffs(u_c, gate_a_w[d], gate_a_b[d], gate_x_w[d], gate_x_b[d], lru_lambda[d])
        hc = linear_scan(a, b, jnp.zeros_like(b[:, 0]), rev)
        ctx_dirs.append(hc)
        h0 = hc[:, 0] if rev else hc[:, -1]
        a, b = rglru_coeffs(u_l, gate_a_w[d], gate_a_b[d], gate_x_w[d], gate_x_b[d], lru_lambda[d])
        lat_dirs.append(linear_scan(a, b, h0, rev))
    y_lru_l = ((lat_dirs[0] + lat_dirs[1]).astype(lx_l.dtype) * jax.nn.gelu(lg_l)) @ lru_proj

    k_c, v_c = mla_keys_values(ckv_c, kr_c, kv_norm_g, w_ukv)
    k_l, v_l = mla_keys_values(ckv_l, apply_axial_rope(kr_l, cos, sin), kv_norm_g, w_ukv)
    q_l = mla_query(cq_l, q_norm_g, w_uq)
    q_l = jnp.concatenate([q_l[..., :QK_NOPE],
                           apply_axial_rope(q_l[..., QK_NOPE:], cos[:, None], sin[:, None])], axis=-1)
    k_all = jnp.concatenate([k_c, k_l], axis=1)
    v_all = jnp.concatenate([v_c, v_l], axis=1)
    y_mla_l = attend_blocks(q_l, k_all, v_all).reshape(B, L, MLA_WIDTH) @ mla_proj

    y_pool_l = pool_branch(pool_l, pool_w, pool_scale, pool_proj)
    y_lat = merge_branches(gt_l, (y_pool_l, y_lru_l, y_mla_l), w_out)
    if not need_ctx:
        return None, y_lat

    Bc, Lc, _ = h_ctx.shape
    y_pool_c = pool_branch(pool_c, pool_w, pool_scale, pool_proj)
    y_lru_c = ((ctx_dirs[0] + ctx_dirs[1]).astype(lx_c.dtype) * jax.nn.gelu(lg_c)) @ lru_proj
    q_c = mla_query(cq_c, q_norm_g, w_uq)
    y_mla_c = attend(q_c, k_c, v_c).reshape(Bc, Lc, MLA_WIDTH) @ mla_proj
    y_ctx = merge_branches(gt_c, (y_pool_c, y_lru_c, y_mla_c), w_out)
    return y_ctx, y_lat


def moe_swiglu(h, router_w, w1, w3, w2):
    n_tok = h.shape[0]
    n_assign = n_tok * TOP_K
    logits = (h @ router_w).astype(jnp.float32)
    top_v, top_i = lax.top_k(logits, TOP_K)
    gates = jax.nn.softmax(top_v, axis=-1)
    e_flat = top_i.reshape(-1)
    tok_flat = jnp.repeat(jnp.arange(n_tok), TOP_K)
    order = jnp.argsort(e_flat)
    e_s, tok_s, g_s = e_flat[order], tok_flat[order], gates.reshape(-1)[order]
    counts = jnp.bincount(e_flat, length=N_EXPERTS)
    starts = jnp.cumsum(counts) - counts
    padded = (counts + MOE_BLOCK - 1) // MOE_BLOCK * MOE_BLOCK
    pad_end = jnp.cumsum(padded)
    pad_start = pad_end - padded
    dest = pad_start[e_s] + jnp.arange(n_assign) - starts[e_s]
    n_rows = -(-n_assign // MOE_BLOCK) * MOE_BLOCK + N_EXPERTS * MOE_BLOCK
    n_blocks = n_rows // MOE_BLOCK
    buf = jnp.zeros((n_rows, h.shape[1]), h.dtype).at[dest].set(h[tok_s])
    blk_e = jnp.minimum(jnp.searchsorted(pad_end, jnp.arange(n_blocks) * MOE_BLOCK, side='right'),
                        N_EXPERTS - 1)

    def expert_block(args):
        xb, e = args
        return swiglu(xb, w1[e], w3[e], w2[e])

    y_blk = lax.map(expert_block, (buf.reshape(n_blocks, MOE_BLOCK, h.shape[1]), blk_e))
    y_rows = y_blk.reshape(n_rows, h.shape[1])[dest]
    return jnp.zeros_like(h).at[tok_s].add(g_s[:, None].astype(h.dtype) * y_rows)


def setup_inputs(seed: int = 0) -> dict:
    key = jax.random.key(seed)
    ks = iter(jax.random.split(key, 48))

    def nrm(shape, scale):
        return scale * jax.random.normal(next(ks), shape, jnp.float32)

    D = D_MODEL
    u = jax.random.uniform(next(ks), (DEPTH, 2, LRU_WIDTH), jnp.float32, 0.9, 0.999)
    return {
        "x": nrm((BATCH, SEQ, D), 1.0),
        "c": nrm((BATCH, D), 1.0),
        "ctx": nrm((BATCH, CTX_LEN, D), 1.0),
        "c_ctx": nrm((D,), 1.0),
        "mod_w": nrm((DEPTH, D, 6 * D), 0.5 * D ** -0.5),
        "mod_b": nrm((DEPTH, 6 * D), 0.02),
        "pre_mix_g": 1.0 + nrm((DEPTH, D), 0.05),
        "post_mix_g": 1.0 + nrm((DEPTH, D), 0.05),
        "pre_ffn_g": 1.0 + nrm((DEPTH, D), 0.05),
        "post_ffn_g": 1.0 + nrm((DEPTH, D), 0.05),
        "w_in": nrm((DEPTH, D, IN_COLS), D ** -0.5),
        "pool_w": nrm((DEPTH, len(POOL_WINDOWS), POOL_GROUP, POOL_GROUP), POOL_GROUP ** -0.5),
        "pool_scale": 1.0 + nrm((DEPTH, POOL_WIDTH), 0.1),
        "pool_proj": nrm((DEPTH, POOL_WIDTH, D), POOL_WIDTH ** -0.5),
        "conv_w": nrm((DEPTH, CONV_W, LRU_WIDTH), CONV_W ** -0.5),
        "conv_b": nrm((DEPTH, LRU_WIDTH), 0.01),
        "gate_a_w": nrm((DEPTH, 2, LRU_BLOCKS, LRU_BLOCK_W, LRU_BLOCK_W), LRU_BLOCK_W ** -0.5),
        "gate_a_b": nrm((DEPTH, 2, LRU_WIDTH), 0.1),
        "gate_x_w": nrm((DEPTH, 2, LRU_BLOCKS, LRU_BLOCK_W, LRU_BLOCK_W), LRU_BLOCK_W ** -0.5),
        "gate_x_b": nrm((DEPTH, 2, LRU_WIDTH), 0.1),
        "lru_lambda": jnp.log(u) - jnp.log1p(-u),
        "lru_proj": nrm((DEPTH, LRU_WIDTH, D), LRU_WIDTH ** -0.5),
        "q_norm_g": 1.0 + nrm((DEPTH, Q_LORA), 0.05),
        "w_uq": nrm((DEPTH, Q_LORA, MLA_HEADS * (QK_NOPE + QK_ROPE)), Q_LORA ** -0.5),
        "kv_norm_g": 1.0 + nrm((DEPTH, KV_LORA), 0.05),
        "w_ukv": nrm((DEPTH, KV_LORA, MLA_HEADS * (QK_NOPE + V_DIM)), KV_LORA ** -0.5),
        "mla_proj": nrm((DEPTH, MLA_WIDTH, D), MLA_WIDTH ** -0.5),
        "w_out": nrm((DEPTH, D, D), D ** -0.5),
        "ffn_w1": nrm((N_DENSE, D, D_FF), D ** -0.5),
        "ffn_w3": nrm((N_DENSE, D, D_FF), D ** -0.5),
        "ffn_w2": nrm((N_DENSE, D_FF, D), D_FF ** -0.5),
        "router_w": nrm((N_MOE, D, N_EXPERTS), D ** -0.5),
        "moe_w1": nrm((N_MOE, N_EXPERTS, D, EXPERT_FF), D ** -0.5),
        "moe_w3": nrm((N_MOE, N_EXPERTS, D, EXPERT_FF), D ** -0.5),
        "moe_w2": nrm((N_MOE, N_EXPERTS, EXPERT_FF, D), EXPERT_FF ** -0.5),
    }


def reference(x, c, ctx, c_ctx, mod_w, mod_b, pre_mix_g, post_mix_g, pre_ffn_g, post_ffn_g, w_in,
              pool_w, pool_scale, pool_proj, conv_w, conv_b, gate_a_w, gate_a_b, gate_x_w, gate_x_b,
              lru_lambda, lru_proj, q_norm_g, w_uq, kv_norm_g, w_ukv, mla_proj, w_out,
              ffn_w1, ffn_w3, ffn_w2, router_w, moe_w1, moe_w3, moe_w2):
    cos, sin = axial_rope_tables(x.shape[1])
    x_lat, x_ctx = x, ctx
    for l in range(DEPTH):
        last = l == DEPTH - 1
        m_lat = jnp.split((jax.nn.silu(c) @ mod_w[l] + mod_b[l])[:, None, :], 6, axis=-1)
        m_ctx = jnp.split(jax.nn.silu(c_ctx) @ mod_w[l] + mod_b[l], 6, axis=-1)

        h_lat = modulate(rms_norm(x_lat, pre_mix_g[l]), m_lat[0], m_lat[1])
        h_ctx = modulate(rms_norm(x_ctx, pre_mix_g[l]), m_ctx[0], m_ctx[1])
        y_ctx, y_lat = token_mixer(h_ctx, h_lat, cos, sin, w_in[l], pool_w[l], pool_scale[l], pool_proj[l],
                                   conv_w[l], conv_b[l], gate_a_w[l], gate_a_b[l], gate_x_w[l], gate_x_b[l],
                                   lru_lambda[l], lru_proj[l], q_norm_g[l], w_uq[l], kv_norm_g[l], w_ukv[l],
                                   mla_proj[l], w_out[l], not last)
        x_lat = x_lat + m_lat[2] * rms_norm(y_lat, post_mix_g[l])

        h2_lat = modulate(rms_norm(x_lat, pre_ffn_g[l]), m_lat[3], m_lat[4])
        n_lat = h2_lat.shape[0] * h2_lat.shape[1]
        if last:
            tokens = h2_lat.reshape(n_lat, D_MODEL)
        else:
            x_ctx = x_ctx + m_ctx[2] * rms_norm(y_ctx, post_mix_g[l])
            h2_ctx = modulate(rms_norm(x_ctx, pre_ffn_g[l]), m_ctx[3], m_ctx[4])
            tokens = jnp.concatenate([h2_lat.reshape(n_lat, D_MODEL), h2_ctx.reshape(-1, D_MODEL)], axis=0)
        if l % 2 == 0:
            f = swiglu(tokens, ffn_w1[l // 2], ffn_w3[l // 2], ffn_w2[l // 2])
        else:
            f = moe_swiglu(tokens, router_w[l // 2], moe_w1[l // 2], moe_w3[l // 2], moe_w2[l // 2])
        x_lat = x_lat + m_lat[5] * rms_norm(f[:n_lat].reshape(x_lat.shape), post_ffn_g[l])
        if not last:
            x_ctx = x_ctx + m_ctx[5] * rms_norm(f[n_lat:].reshape(x_ctx.shape), post_ffn_g[l])
    return x_lat
```

```cpp
#include <hip/hip_runtime.h>
#include <stdint.h>
#include <stdio.h>

#ifndef ABL
#define ABL 0
#endif
#ifndef ABL_L
#define ABL_L 3
#endif
#ifndef MK_PER_PHASE
#define MK_PER_PHASE 0
#endif

#define LAS __attribute__((address_space(3)))
typedef unsigned short bf16_t;
typedef short bf16x8 __attribute__((ext_vector_type(8)));
typedef short s16x4 __attribute__((ext_vector_type(4)));
typedef float f32x4 __attribute__((ext_vector_type(4)));
typedef float f32x2 __attribute__((ext_vector_type(2)));
typedef float f32x16 __attribute__((ext_vector_type(16)));
typedef unsigned u32x4 __attribute__((ext_vector_type(4)));
typedef unsigned u32x2 __attribute__((ext_vector_type(2)));

constexpr int DM = 1024, NB = 4, SEQ = 8192, CTXL = 256, MLAT = NB * SEQ, MCTX = NB * CTXL, MTOT = MLAT + MCTX;
constexpr int INCOLS = 6848, NH = 8, DQK = 192, DVH = 128, SKV = SEQ + CTXL;
constexpr int QLORA = 384, KVLORA = 256, DFF = 2816, NEXP = 8, EFF = 3584;
constexpr float RMS_EPS = 1e-6f;
constexpr int Z2LD = 1792;
constexpr int NCHUNK = SKV / 64;

constexpr size_t MiB = 1u << 20;
constexpr size_t WS_CTL = 0, CTL_BYTES = 1 * MiB;
constexpr size_t WS_MVEC = 1 * MiB;
constexpr size_t WS_MPART = 2 * MiB;
constexpr size_t WS_KR = 2 * MiB;
constexpr size_t WS_ROPE = 10 * MiB;
constexpr size_t WS_SP8 = 12 * MiB + 512 * 1024;
constexpr size_t WS_RSTDQ = 13 * MiB, WS_RSTDKV = 13 * MiB + 256 * 1024;
constexpr size_t WS_SUMA = 14 * MiB, WS_SUMB = 16 * MiB + 512 * 1024;
constexpr size_t WS_E12 = 19 * MiB, WS_G1 = 19 * MiB + 128 * 1024, WS_DEST = 19 * MiB + 256 * 1024;
constexpr size_t WS_XC = 20 * MiB;
constexpr size_t WS_WTS = 25 * MiB, WTS_LSTRIDE = 25 * MiB;
constexpr size_t WO_IN1 = 0, WO_GT = 7 * MiB + 512 * 1024, WO_POOL = 13 * MiB + 512 * 1024, WO_GATE = 15 * MiB + 512 * 1024, WO_LRU = 16 * MiB + 512 * 1024,
                 WO_UQ = 18 * MiB + 512 * 1024, WO_UKV = 19 * MiB + 640 * 1024, WO_MLA = 20 * MiB + 640 * 1024, WO_OUT = 22 * MiB + 640 * 1024;
constexpr size_t WS_W13 = 75 * MiB, WS_W2 = 86 * MiB, WS_PPT = 91 * MiB + 512 * 1024  , WS_PWS = 95 * MiB + 512 * 1024  ;
constexpr size_t WS_DYN = 97 * MiB;
constexpr size_t SLAB = 66 * MiB;
constexpr size_t HM = 512 * 1024;
constexpr size_t D_H8 = 0  , D_H = 33 * MiB, D_Z2 = 99 * MiB, D_LX = 214 * MiB + HM, D_LA = 214 * MiB + HM, D_LG = 280 * MiB + HM, D_U = 346 * MiB + HM, D_GX = 412 * MiB + HM, D_HF = 478 * MiB + HM;
constexpr size_t D_MP = 33 * MiB, D_K = 214 * MiB + HM, D_V = 280 * MiB + HM, D_Q = 346 * MiB + HM  , D_AO = 99 * MiB;
constexpr size_t D_GT = 214 * MiB + HM, D_MG = 412 * MiB + HM, D_Y = 214 * MiB + HM, D_H2 = 280 * MiB + HM, D_HID = 0, D_F = 346 * MiB + HM;
constexpr size_t D_WM13 = 0, D_WM2 = 56 * MiB, D_XG = 84 * MiB, D_HIDG = 150 * MiB, D_YR = 346 * MiB + HM;
constexpr size_t WS_QC = 6 * MiB + HM;
constexpr size_t WS_END = WS_DYN + 544 * MiB + HM;
constexpr int CW_BAR = 4096, CW_CNT = 8192, CW_CUR = 8192 + 512;

constexpr int STAGE_BYTES = 131072, MISC_OFF = STAGE_BYTES, LDS_BYTES = STAGE_BYTES + 1024;
constexpr int NWAVES = 8, NTHR = 512;

#define LDS_WAIT() asm volatile("s_waitcnt lgkmcnt(0)" ::: "memory")
#define VM_WAIT() asm volatile("s_waitcnt vmcnt(0)" ::: "memory")
typedef __bf16 bf16x2_t __attribute__((ext_vector_type(2)));
__device__ __forceinline__ unsigned cvtpk(float lo, float hi) { const f32x2 v = {lo, hi}; return __builtin_bit_cast(unsigned, __builtin_convertvector(v, bf16x2_t)); }
__device__ __forceinline__ float bf_lo(unsigned w) { return __uint_as_float(w << 16); }
__device__ __forceinline__ float bf_hi(unsigned w) { return __uint_as_float(w & 0xffff0000u); }
__device__ __forceinline__ float bf2f(bf16_t b) { return __uint_as_float(((unsigned)b) << 16); }
__device__ __forceinline__ float wave_sum(float v) {
#pragma unroll
    for (int o = 1; o < 64; o <<= 1) v += __shfl_xor(v, o);
    return v;
}
__device__ __forceinline__ float sigmoidf_(float x) { return __builtin_amdgcn_rcpf(1.f + __builtin_amdgcn_exp2f(-1.4426950408889634f * x)); }

__device__ __forceinline__ int fresh_tid(int wave) { int l; asm volatile("v_mbcnt_lo_u32_b32 %0, -1, 0\n\tv_mbcnt_hi_u32_b32 %0, -1, %0" : "=v"(l)); return wave * 64 + l; }
#define XB_TMO      128
#define XB_XCNT(j)  (256  + 64 * (j))
#define XB_XSUB(j)  (1280 + 64 * (j))
#define XB_XGEN(j)  (2304 + 64 * (j))
#define XB_TOP      3328
#define XB_TOPGEN   3392
#define XCD_BAR_WORDS 3456
#define XB_SPIN_CAP (1u << 18)
__device__ __forceinline__ unsigned xb_ld(unsigned* p)              { return __hip_atomic_load(p, __ATOMIC_RELAXED, __HIP_MEMORY_SCOPE_AGENT); }
__device__ __forceinline__ unsigned xb_add(unsigned* p, unsigned v) { return __hip_atomic_fetch_add(p, v, __ATOMIC_RELAXED, __HIP_MEMORY_SCOPE_AGENT); }
__device__ __forceinline__ unsigned xb_xcc_id() { return (unsigned)__builtin_amdgcn_s_getreg((3 << 11) | 20) & 0xFu; }
#define XB_SPIN(cond, bar) do { unsigned _sp = 0; while (cond) { __builtin_amdgcn_s_sleep(1); \
    if ((++_sp & 255u) == 0u) { if (xb_ld(&(bar)[XB_TMO])) break; if (_sp > XB_SPIN_CAP) { atomicAdd(&(bar)[XB_TMO], 1u); break; } } } } while (0)
struct XcdBarrier { unsigned* bar; unsigned x; volatile LAS unsigned* st; int wave; };
__device__ __forceinline__ XcdBarrier xcd_barrier_post(unsigned* bar, volatile LAS unsigned* st, int wave) {
    XcdBarrier b; b.bar = bar; b.x = xb_xcc_id(); b.st = st; b.wave = wave;
    if (fresh_tid(wave) == 0) (void)xb_add(&bar[XB_XCNT(b.x)], 1u);
    return b;
}
__device__ __forceinline__ void xcd_barrier_complete(unsigned* bar, unsigned x, unsigned& nloc, unsigned& nx) {
    const unsigned G = gridDim.x * gridDim.y * gridDim.z;
    unsigned sum, cnt, mine, sp = 0u;
    for (;;) {
        sum = 0u; cnt = 0u; mine = 0u;
#pragma unroll
        for (unsigned j = 0; j < 16; ++j) { const unsigned c = xb_ld(&bar[XB_XCNT(j)]); sum += c; cnt += (c > 0u) ? 1u : 0u; mine = (j == x) ? c : mine; }
        if (sum == G) break;
        __builtin_amdgcn_s_sleep(1);
        if ((++sp & 255u) == 0u) { if (xb_ld(&bar[XB_TMO])) break; if (sp > XB_SPIN_CAP) { atomicAdd(&bar[XB_TMO], 1u); break; } }
    }
    nloc = mine > 0u ? mine : 1u; nx = cnt > 0u ? cnt : 1u;
}
__device__ __forceinline__ void xcd_barrier(const XcdBarrier& b) {
    asm volatile("s_waitcnt vmcnt(0)" ::: "memory");
    __syncthreads();
    if (fresh_tid(b.wave) == 0) {
        unsigned* bar = b.bar;
        __builtin_amdgcn_s_waitcnt(0);
        unsigned nloc = b.st[0], nx = b.st[1];
        if (nloc == 0u) { xcd_barrier_complete(bar, b.x, nloc, nx); b.st[0] = nloc; b.st[1] = nx; }
        const unsigned old = xb_add(&bar[XB_XSUB(b.x)], 1u);
        const unsigned gen = old / nloc;
        if (old + 1u == (gen + 1u) * nloc) {
            __builtin_amdgcn_fence(__ATOMIC_RELEASE, "agent");
            asm volatile("s_waitcnt vmcnt(0)" ::: "memory");
            const unsigned og = xb_add(&bar[XB_TOP], 1u);
            const unsigned tg = og / nx;
            if (og + 1u == (tg + 1u) * nx) xb_add(&bar[XB_TOPGEN], 1u);
            else XB_SPIN(xb_ld(&bar[XB_TOPGEN]) == tg, bar);
            __builtin_amdgcn_fence(__ATOMIC_ACQUIRE, "agent");
            xb_add(&bar[XB_XGEN(b.x)], 1u);
            asm volatile("s_waitcnt vmcnt(0)" ::: "memory");
        } else {
            XB_SPIN(xb_ld(&bar[XB_XGEN(b.x)]) == gen, bar);
            __builtin_amdgcn_fence(__ATOMIC_ACQUIRE, "agent");
            asm volatile("s_waitcnt vmcnt(0)" ::: "memory");
        }
    }
    __syncthreads();
}

__device__ __forceinline__ unsigned* bar_words(unsigned char* ws) { return (unsigned*)(ws + WS_CTL) + CW_BAR; }
namespace pg8 {
constexpr int BM = 256, BK = 64, HALF = 128, HTB = HALF * BK * 2, NXCD = 8, WGM = 8;
__host__ __device__ __forceinline__ int lds_byte(int r, int c) { const int st = (r >> 4) * 2 + (c >> 5), rr = r & 15, cc = c & 31, ob = rr * 64 + cc * 2; return st * 1024 + (ob ^ (((ob >> 9) & 1) << 5)); }
__host__ __device__ __forceinline__ void stage_rc(int b, int& R, int& C) { const int st = b / 1024, sb = b % 1024, swz = sb ^ (((sb >> 9) & 1) << 5); R = (st >> 1) * 16 + swz / 64; C = (st & 1) * 32 + (swz % 64) / 2; }
__host__ __device__ __forceinline__ int perm32(int rho) { const int n = rho >> 4, i = rho & 15; return 8 * (i >> 2) + 4 * n + (i & 3); }

typedef int i32x8 __attribute__((ext_vector_type(8)));
__device__ __forceinline__ i32x8 cat8(const bf16x8 lo, const bf16x8 hi) { const u32x4 a = __builtin_bit_cast(u32x4, lo), b = __builtin_bit_cast(u32x4, hi); return (i32x8){(int)a.x, (int)a.y, (int)a.z, (int)a.w, (int)b.x, (int)b.y, (int)b.z, (int)b.w}; }
__device__ __forceinline__ const char* uptr(const char* p) {
    const unsigned long long v = (unsigned long long)p; const unsigned lo = __builtin_amdgcn_readfirstlane((unsigned)v), hi = __builtin_amdgcn_readfirstlane((unsigned)(v >> 32));
    return (const char*)(((unsigned long long)hi << 32) | lo); }
template <bool FP8> struct Frag;
template <> struct Frag<false> { bf16x8 k[2]; };
template <> struct Frag<true> { i32x8 v; };
struct Unit { const char* a; const char* b; int nt; int pm, pn, aux; };

__device__ __forceinline__ void tile_of(int wgid, int nM, int nN, int& pm, int& pn) {
    const int nwg = nM * nN; { const int q = nwg / NXCD, r = nwg % NXCD, xcd = wgid % NXCD, off = wgid / NXCD; wgid = (xcd < r ? xcd * (q + 1) : r * (q + 1) + (xcd - r) * q) + off; }
    const int nig = WGM * nN, gid = wgid / nig, fm = gid * WGM, gsz = (nM - fm) < WGM ? (nM - fm) : WGM;
    pm = fm + ((wgid % nig) % gsz); pn = (wgid % nig) / gsz;
}

template <class Epi, class Sched, bool FP8 = false>
__device__ __forceinline__ void gemm_phase(LAS unsigned char* lds, const int wid, const int lda, const int ldb, const Sched& S, const Epi& E) {
    const int tid = fresh_tid(wid), lane = tid & 63, wr = wid >> 2, wc = wid & 3, fr = lane & 15, fq = lane >> 4;
    unsigned voffA[2], voffB[2];
#pragma unroll
    for (int i = 0; i < 2; ++i) { int R, C; stage_rc(tid * 16 + i * 8192, R, C); const int Rb = (R & ~31) + perm32(R & 31);
        voffA[i] = (unsigned)(R * lda + C) * 2u; voffB[i] = (unsigned)(Rb * ldb + C) * 2u; }
    const size_t kstep = (size_t)(BK * 2);
    const size_t hstepA = (size_t)HALF * lda * 2, hstepB = (size_t)HALF * ldb * 2;
    const unsigned ldsw = (unsigned)wid * 1024u;
    const int aoff = FP8 ? lds_byte(wr * 64 + fr, fq * 16) : lds_byte(wr * 64 + fr, fq * 8), boff = FP8 ? lds_byte(wc * 32 + fr, fq * 16) : lds_byte(wc * 32 + fr, fq * 8);
#define PG8_SA(b, h) (((b) * 2 + (h)) * HTB)
#define PG8_SB(b, h) ((4 + (b) * 2 + (h)) * HTB)
#define PG8_STAGE(bufoff, gbase, voff) do { _Pragma("unroll") for (int _i = 0; _i < 2; ++_i) \
        __builtin_amdgcn_global_load_lds((const unsigned*)((const char*)(gbase) + (voff)[_i]), (LAS unsigned*)(lds + (bufoff) + ldsw + _i * 8192), 16, 0, 0); } while (0)
#define PG8_LDA(dst, b, h) do { if constexpr (FP8) { _Pragma("unroll") for (int m = 0; m < 4; ++m) dst##8[m] = cat8(*(const LAS bf16x8*)(lds + PG8_SA(b, h) + aoff + m * 2048), *(const LAS bf16x8*)(lds + PG8_SA(b, h) + aoff + m * 2048 + 16)); } \
        else { _Pragma("unroll") for (int m = 0; m < 4; ++m) _Pragma("unroll") for (int k = 0; k < 2; ++k) dst[m][k] = *(const LAS bf16x8*)(lds + PG8_SA(b, h) + aoff + m * 2048 + k * 1024); } } while (0)
#define PG8_LDB(dst, b, h) do { if constexpr (FP8) { _Pragma("unroll") for (int n = 0; n < 2; ++n) dst##8[n] = cat8(*(const LAS bf16x8*)(lds + PG8_SB(b, h) + boff + n * 2048), *(const LAS bf16x8*)(lds + PG8_SB(b, h) + boff + n * 2048 + 16)); } \
        else { _Pragma("unroll") for (int n = 0; n < 2; ++n) _Pragma("unroll") for (int k = 0; k < 2; ++k) dst[n][k] = *(const LAS bf16x8*)(lds + PG8_SB(b, h) + boff + n * 2048 + k * 1024); } } while (0)
#define PG8_MMA(ai, bj, At, Bt) do { __builtin_amdgcn_s_setprio(1); if constexpr (FP8) { _Pragma("unroll") for (int m = 0; m < 4; ++m) _Pragma("unroll") for (int n = 0; n < 2; ++n) \
        asm volatile("v_mfma_scale_f32_16x16x128_f8f6f4 %0, %1, %2, %0, %3, %3 op_sel_hi:[0,0,0]" : "+v"(acc[ai][bj][m][n]) : "v"(Bt##8[n]), "v"(At##8[m]), "v"(one8)); } \
        else { _Pragma("unroll") for (int m = 0; m < 4; ++m) _Pragma("unroll") for (int n = 0; n < 2; ++n) _Pragma("unroll") for (int k = 0; k < 2; ++k) \
        acc[ai][bj][m][n] = __builtin_amdgcn_mfma_f32_16x16x32_bf16(Bt[n][k], At[m][k], acc[ai][bj][m][n], 0, 0, 0); } __builtin_amdgcn_s_setprio(0); } while (0)
#define PG8_WAIT_V(n) asm volatile("s_waitcnt vmcnt(" #n ")" ::: "memory")
#define PG8_WAIT_L(n) asm volatile("s_waitcnt lgkmcnt(" #n ")" ::: "memory")
#define PG8_BAR __builtin_amdgcn_s_barrier()
#define PG8_SCHED __builtin_amdgcn_sched_barrier(0)
    Unit cur, nxt; int ui = 0;
    if (!S.next(0, cur)) return;
    f32x4 acc[2][2][4][2];
#pragma unroll
    for (int a = 0; a < 2; ++a)
#pragma unroll
        for (int b = 0; b < 2; ++b)
#pragma unroll
            for (int m = 0; m < 4; ++m)
#pragma unroll
                for (int n = 0; n < 2; ++n) acc[a][b][m][n] = (f32x4){0.f, 0.f, 0.f, 0.f};
    bf16x8 At[4][2], B0[2][2], B1[2][2]; i32x8 At8[4], B08[2], B18[2];
    const int one8 = 0x7f7f7f7f;
    const char* cA = FP8 ? uptr(cur.a) : cur.a; const char* cB = FP8 ? uptr(cur.b) : cur.b;
    PG8_STAGE(PG8_SB(0, 0), cB, voffB); PG8_STAGE(PG8_SB(0, 1), cB + hstepB, voffB); PG8_STAGE(PG8_SA(0, 0), cA, voffA); PG8_STAGE(PG8_SA(0, 1), cA + hstepA, voffA);
    if (wr == 1) PG8_BAR;
    PG8_WAIT_V(2); PG8_BAR;
    PG8_STAGE(PG8_SB(1, 0), cB + kstep, voffB); PG8_STAGE(PG8_SA(1, 0), cA + kstep, voffA); PG8_STAGE(PG8_SB(1, 1), cB + hstepB + kstep, voffB);
    PG8_WAIT_V(6); PG8_BAR;
    for (;;) {
        const bool has_next = S.next(ui + 1, nxt);
        const char* nA = has_next ? nxt.a : cA; const char* nB = has_next ? nxt.b : cB; if constexpr (FP8) { nA = uptr(nA); nB = uptr(nB); }
        const int nt = cur.nt;
        for (int t = 0; t < nt; t += 2) {
            const bool last = (t == nt - 2);
            const char* a1 = cA + (size_t)(t + 1) * kstep;
            const char* a2 = last ? nA : cA + (size_t)(t + 2) * kstep; const char* b2 = last ? nB : cB + (size_t)(t + 2) * kstep;
            const char* a3 = a2 + kstep; const char* b3 = b2 + kstep;
            PG8_LDB(B0, 0, 0); PG8_LDB(B1, 0, 1); PG8_SCHED; PG8_LDA(At, 0, 0); PG8_STAGE(PG8_SA(1, 1), a1 + hstepA, voffA);
            PG8_WAIT_V(8); PG8_WAIT_L(0); PG8_BAR; PG8_MMA(0, 0, At, B0); PG8_MMA(0, 1, At, B1); PG8_BAR; PG8_SCHED;
            PG8_LDA(At, 0, 1); PG8_STAGE(PG8_SB(0, 0), b2, voffB); PG8_STAGE(PG8_SB(0, 1), b2 + hstepB, voffB); PG8_STAGE(PG8_SA(0, 0), a2, voffA);
            PG8_WAIT_V(8); PG8_WAIT_L(0); PG8_BAR; PG8_MMA(1, 0, At, B0); PG8_MMA(1, 1, At, B1); PG8_BAR; PG8_SCHED;
            PG8_LDB(B0, 1, 0); PG8_LDB(B1, 1, 1); PG8_SCHED; PG8_LDA(At, 1, 0); PG8_STAGE(PG8_SA(0, 1), a2 + hstepA, voffA);
            PG8_WAIT_V(8); PG8_WAIT_L(0); PG8_BAR; PG8_MMA(0, 0, At, B0); PG8_MMA(0, 1, At, B1); PG8_BAR; PG8_SCHED;
            PG8_LDA(At, 1, 1); PG8_STAGE(PG8_SB(1, 0), b3, voffB); PG8_STAGE(PG8_SB(1, 1), b3 + hstepB, voffB); PG8_STAGE(PG8_SA(1, 0), a3, voffA);
            PG8_WAIT_V(8); PG8_WAIT_L(0); PG8_BAR; PG8_MMA(1, 0, At, B0); PG8_MMA(1, 1, At, B1); PG8_BAR; PG8_SCHED;
        }
        if (wr == 0) PG8_BAR;
        if constexpr (FP8) asm volatile("s_nop 7\n\ts_nop 7\n\ts_nop 7" ::: "memory");
        const bool keep = E(acc, cur, wr, wc, fr, fq);
        if (!has_next) break;
        if (!keep) {
#pragma unroll
        for (int a = 0; a < 2; ++a)
#pragma unroll
            for (int b = 0; b < 2; ++b)
#pragma unroll
                for (int m = 0; m < 4; ++m)
#pragma unroll
                    for (int n = 0; n < 2; ++n) acc[a][b][m][n] = (f32x4){0.f, 0.f, 0.f, 0.f};
        }
        cur = nxt; cA = nA; cB = nB; ++ui;
        if (wr == 1) PG8_BAR;
    }
    PG8_WAIT_V(0);
    PG8_BAR;
#undef PG8_SA
#undef PG8_SB
#undef PG8_STAGE
#undef PG8_LDA
#undef PG8_LDB
#undef PG8_MMA
#undef PG8_WAIT_V
#undef PG8_WAIT_L
#undef PG8_BAR
#undef PG8_SCHED
}

struct GridSched {
    const char* A; const char* B; int nM, nN, nt, lda, ldb, G, c, pm0, aux;
    __device__ __forceinline__ bool next(int i, Unit& u) const {
        const int L = __builtin_amdgcn_readfirstlane(i * G + c); if (L >= nM * nN) return false;
        int pm, pn; tile_of(L, nM, nN, pm, pn);
        u.pm = pm0 + pm; u.pn = pn; u.aux = aux; u.nt = nt;
        u.a = A + (size_t)(pm0 + pm) * 256 * lda * 2; u.b = B + (size_t)pn * 256 * ldb * 2; return true;
    }
};
struct GateSched {
    const char* U; const char* W; int nM, G, c, dir;
    __device__ __forceinline__ bool next(int i, Unit& u) const {
        const int L = __builtin_amdgcn_readfirstlane(i * G + c); if (L >= nM * 8) return false;
        int pm, pn; tile_of(L, nM, 8, pm, pn);
        u.pm = pm; u.pn = pn; u.aux = dir; u.nt = 2;
        u.a = U + (size_t)pm * 256 * DM * 2 + (size_t)pn * 128 * 2; u.b = W + ((size_t)pn * 512 + (size_t)dir * 256) * 128 * 2; return true;
    }
};
struct FatSched {
    const char* dyn; const char* wl; int nM, G, c;
    __device__ __forceinline__ bool next(int i, Unit& u) const {
        const int seg = i % 3, L = __builtin_amdgcn_readfirstlane((i / 3) * G + c); if (L >= nM * 4) return false;
        int pm, pn; tile_of(L, nM, 4, pm, pn);
        u.pm = pm; u.pn = pn; u.aux = seg; u.nt = 16;
        const size_t oa = seg == 0 ? D_MP : (seg == 1 ? D_HF : D_AO), ob = seg == 0 ? WO_POOL : (seg == 1 ? WO_LRU : WO_MLA);
        u.a = dyn + oa + (size_t)pm * 256 * DM * 2; u.b = wl + ob + (size_t)pn * 256 * DM * 2; return true;
    }
};
struct MoeSched {
    const char* A; const char* B; int te[7]; size_t estride; int nM, nN, nt, lda, ldb, G, c, t0, arow0;
    __device__ __forceinline__ bool next(int i, Unit& u) const {
        const int L = __builtin_amdgcn_readfirstlane(i * G + c); if (L >= nM * nN) return false;
        int pm, pn; tile_of(L, nM, nN, pm, pn);
        const int tg = t0 + pm; int e = 0;
#pragma unroll
        for (int j = 0; j < 7; ++j) e += (tg >= te[j]) ? 1 : 0;
        u.pm = pm; u.pn = pn; u.aux = e; u.nt = nt;
        u.a = A + (size_t)(arow0 + pm) * 256 * lda * 2; u.b = B + (size_t)e * estride + (size_t)pn * 256 * ldb * 2; return true;
    }
};
struct PoolSched { const char* A; const char* B; int G, c;
    __device__ __forceinline__ bool next(int i, Unit& u) const { const int L = __builtin_amdgcn_readfirstlane(i * G + c); if (L >= 32) return false; const int l = L >> 4; u.pm = L & 3; u.pn = (L >> 2) & 3; u.aux = l; u.nt = 4;
        u.a = A + (size_t)l * DM * DM * 2 + (size_t)u.pm * 256 * DM * 2 + (size_t)u.pn * 256 * 2; u.b = B + ((size_t)l * 4 + u.pn) * 65536 * 2; return true; } };
__device__ __forceinline__ u32x4 pack8(const f32x4 v0, const f32x4 v1) { u32x4 w; w.x = cvtpk(v0[0], v0[1]); w.y = cvtpk(v0[2], v0[3]); w.z = cvtpk(v1[0], v1[1]); w.w = cvtpk(v1[2], v1[3]); return w; }
__device__ __forceinline__ void unpack8(const u32x4 w, f32x4& v0, f32x4& v1) { v0 = (f32x4){bf_lo(w.x), bf_hi(w.x), bf_lo(w.y), bf_hi(w.y)}; v1 = (f32x4){bf_lo(w.z), bf_hi(w.z), bf_lo(w.w), bf_hi(w.w)}; }
template <int ACT>
__device__ __forceinline__ void store_tile(const f32x4 (&acc)[2][2][4][2], bf16_t* base, int ldc, int row0, int col0, int wr, int wc, int fr, int fq, const float scale = 1.f) {
#pragma unroll
    for (int ai = 0; ai < 2; ++ai)
#pragma unroll
        for (int m = 0; m < 4; ++m) { bf16_t* rowp = base + (size_t)(row0 + ai * HALF + wr * 64 + m * 16 + fr) * ldc + col0 + wc * 32 + 8 * fq;
#pragma unroll
            for (int bj = 0; bj < 2; ++bj) { f32x4 v0 = acc[ai][bj][m][0] * scale, v1 = acc[ai][bj][m][1] * scale;
                if (ACT == 1) {
#pragma unroll
                    for (int j = 0; j < 4; ++j) { v0[j] = sigmoidf_(v0[j]); v1[j] = sigmoidf_(v1[j]); } }
                if (ACT == 2) {
#pragma unroll
                    for (int j = 0; j < 4; ++j) { v0[j] = v0[j] * sigmoidf_(1.5957691216057308f * (v0[j] + 0.044715f * v0[j] * v0[j] * v0[j])); v1[j] = v1[j] * sigmoidf_(1.5957691216057308f * (v1[j] + 0.044715f * v1[j] * v1[j] * v1[j])); } }
                *(u32x4*)(rowp + bj * HALF) = pack8(v0, v1); } }
}
struct EpiIn1 {
    bf16_t* LX; bf16_t* LG; bf16_t* Z2;
    __device__ __forceinline__ bool operator()(f32x4 (&acc)[2][2][4][2], const Unit& u, int wr, int wc, int fr, int fq) const {
        if (u.pn >= 4 && u.pn < 8) { store_tile<2>(acc, LG, DM, u.pm * 256, (u.pn - 4) * 256, wr, wc, fr, fq); return false; }
        bf16_t* base; int ldc, ct;
        if (u.pn < 4) { base = LX; ldc = DM; ct = u.pn * 256; } else { base = Z2; ldc = Z2LD; ct = (u.pn - 8) * 256; }
        store_tile<0>(acc, base, ldc, u.pm * 256, ct, wr, wc, fr, fq); return false;
    }
};
template <int ACT> struct EpiStore {
    bf16_t* O; int ldc; int rowoff; float scale = 1.f;
    __device__ __forceinline__ bool operator()(f32x4 (&acc)[2][2][4][2], const Unit& u, int wr, int wc, int fr, int fq) const {
        store_tile<ACT>(acc, O, ldc, rowoff + u.pm * 256, u.pn * 256, wr, wc, fr, fq, scale); return false;
    }
};
struct EpiPool {
    bf16_t* O;
    __device__ __forceinline__ bool operator()(f32x4 (&acc)[2][2][4][2], const Unit& u, int wr, int wc, int fr, int fq) const {
        store_tile<0>(acc, O + (size_t)u.aux * (WTS_LSTRIDE / 2), DM, u.pm * 256, u.pn * 256, wr, wc, fr, fq); return false;
    }
};
__device__ __forceinline__ u32x2 pack8_fp8(const f32x4 v0, const f32x4 v1) {
    int lo = 0, hi = 0; lo = __builtin_amdgcn_cvt_pk_fp8_f32(v0[0], v0[1], lo, false); lo = __builtin_amdgcn_cvt_pk_fp8_f32(v0[2], v0[3], lo, true);
    hi = __builtin_amdgcn_cvt_pk_fp8_f32(v1[0], v1[1], hi, false); hi = __builtin_amdgcn_cvt_pk_fp8_f32(v1[2], v1[3], hi, true); return (u32x2){(unsigned)lo, (unsigned)hi};
}
struct EpiSwiglu8 {
    unsigned char* O; int ldc; float sc = 0.03125f;
    __device__ __forceinline__ bool operator()(f32x4 (&acc)[2][2][4][2], const Unit& u, int wr, int wc, int fr, int fq) const {
#pragma unroll
        for (int ai = 0; ai < 2; ++ai)
#pragma unroll
            for (int m = 0; m < 4; ++m) { unsigned char* rowp = O + (size_t)(u.pm * 256 + ai * HALF + wr * 64 + m * 16 + fr) * ldc + u.pn * 128 + wc * 32 + 8 * fq;
                f32x4 v0, v1;
#pragma unroll
                for (int j = 0; j < 4; ++j) { const float a0 = acc[ai][0][m][0][j] * sc, a1 = acc[ai][0][m][1][j] * sc;
                    v0[j] = a0 * sigmoidf_(a0) * (acc[ai][1][m][0][j] * sc); v1[j] = a1 * sigmoidf_(a1) * (acc[ai][1][m][1][j] * sc); }
                *(u32x2*)rowp = pack8_fp8(v0, v1); }
        return false;
    }
};
struct EpiStoreS {
    bf16_t* O; int ldc; int rowoff; float scale;
    __device__ __forceinline__ bool operator()(f32x4 (&acc)[2][2][4][2], const Unit& u, int wr, int wc, int fr, int fq) const {
#pragma unroll
        for (int ai = 0; ai < 2; ++ai)
#pragma unroll
            for (int m = 0; m < 4; ++m) { bf16_t* rowp = O + (size_t)(rowoff + u.pm * 256 + ai * HALF + wr * 64 + m * 16 + fr) * ldc + u.pn * 256 + wc * 32 + 8 * fq;
#pragma unroll
                for (int bj = 0; bj < 2; ++bj) *(u32x4*)(rowp + bj * HALF) = pack8(acc[ai][bj][m][0] * scale, acc[ai][bj][m][1] * scale); }
        return false;
    }
};
struct EpiSwiglu {
    bf16_t* O; int ldc;
    __device__ __forceinline__ bool operator()(f32x4 (&acc)[2][2][4][2], const Unit& u, int wr, int wc, int fr, int fq) const {
#pragma unroll
        for (int ai = 0; ai < 2; ++ai)
#pragma unroll
            for (int m = 0; m < 4; ++m) { bf16_t* rowp = O + (size_t)(u.pm * 256 + ai * HALF + wr * 64 + m * 16 + fr) * ldc + u.pn * 128 + wc * 32 + 8 * fq;
                f32x4 v0, v1;
#pragma unroll
                for (int j = 0; j < 4; ++j) { const float a0 = acc[ai][0][m][0][j], a1 = acc[ai][0][m][1][j];
                    v0[j] = a0 * sigmoidf_(a0) * acc[ai][1][m][0][j]; v1[j] = a1 * sigmoidf_(a1) * acc[ai][1][m][1][j]; }
                *(u32x4*)rowp = pack8(v0, v1); }
        return false;
    }
};
struct EpiGates {
    bf16_t* LA; bf16_t* GX; const bf16_t* U; const float* ba; const float* bx; const float* sp8;
    __device__ __forceinline__ bool operator()(f32x4 (&acc)[2][2][4][2], const Unit& u, int wr, int wc, int fr, int fq) const {
        const int ch0 = u.pn * 128 + wc * 32 + 8 * fq;
        const f32x4 ba0 = *(const f32x4*)(ba + ch0), ba1 = *(const f32x4*)(ba + ch0 + 4), bx0 = *(const f32x4*)(bx + ch0), bx1 = *(const f32x4*)(bx + ch0 + 4);
        const f32x4 sp0 = *(const f32x4*)(sp8 + ch0), sp1 = *(const f32x4*)(sp8 + ch0 + 4);
#pragma unroll
        for (int ai = 0; ai < 2; ++ai)
#pragma unroll
            for (int m = 0; m < 4; ++m) { const size_t off = (size_t)(u.pm * 256 + ai * HALF + wr * 64 + m * 16 + fr) * DM + ch0;
                f32x4 u0, u1; unpack8(*(const u32x4*)(U + off), u0, u1);
                f32x4 l0, l1, g0, g1;
#pragma unroll
                for (int j = 0; j < 4; ++j) {
                    const float e0 = __builtin_amdgcn_exp2f(1.4426950408889634f * sp0[j] * sigmoidf_(acc[ai][0][m][0][j] + ba0[j])), e1 = __builtin_amdgcn_exp2f(1.4426950408889634f * sp1[j] * sigmoidf_(acc[ai][0][m][1][j] + ba1[j]));
                    l0[j] = 1.f - e0; l1[j] = 1.f - e1;
                    g0[j] = __builtin_amdgcn_sqrtf(fmaxf(1.f - e0 * e0, 0.f)) * (sigmoidf_(acc[ai][1][m][0][j] + bx0[j]) * u0[j]); g1[j] = __builtin_amdgcn_sqrtf(fmaxf(1.f - e1 * e1, 0.f)) * (sigmoidf_(acc[ai][1][m][1][j] + bx1[j]) * u1[j]); }
                *(u32x4*)(LA + off) = pack8(l0, l1); *(u32x4*)(GX + off) = pack8(g0, g1); }
        return false;
    }
};
struct EpiQ {
    unsigned char* Q; unsigned char* QC; const float* rstd; const f32x2* rope;
    __device__ __forceinline__ bool operator()(f32x4 (&acc)[2][2][4][2], const Unit& u, int wr, int wc, int fr, int fq) const {
#pragma unroll
        for (int ai = 0; ai < 2; ++ai)
#pragma unroll
            for (int m = 0; m < 4; ++m) { const int row = u.pm * 256 + ai * HALF + wr * 64 + m * 16 + fr; const float rs = rstd[row];
                int b, t, pos; unsigned char* base; int slen;
                if (row < MLAT) { b = row >> 13; t = row & (SEQ - 1); pos = t; base = Q; slen = SEQ; } else { const int rc = row - MLAT; b = rc >> 8; t = rc & (CTXL - 1); pos = SEQ; base = QC; slen = CTXL; }
#pragma unroll
                for (int bj = 0; bj < 2; ++bj) { const int c = u.pn * 256 + bj * HALF + wc * 32 + 8 * fq, h = c / DQK, dd = c - h * DQK;
                    f32x4 v0 = acc[ai][bj][m][0] * rs, v1 = acc[ai][bj][m][1] * rs;
                    if (dd >= 128) { const int p0 = dd - 128; const f32x2* tab = rope + (size_t)pos * 32 + (p0 >> 5) * 16 + ((p0 & 31) >> 1);
                        const f32x4 cs01 = *(const f32x4*)tab, cs23 = *(const f32x4*)(tab + 2);
                        f32x4 w0, w1;
                        w0[0] = v0[0] * cs01[0] - v0[1] * cs01[1]; w0[1] = v0[1] * cs01[0] + v0[0] * cs01[1];
                        w0[2] = v0[2] * cs01[2] - v0[3] * cs01[3]; w0[3] = v0[3] * cs01[2] + v0[2] * cs01[3];
                        w1[0] = v1[0] * cs23[0] - v1[1] * cs23[1]; w1[1] = v1[1] * cs23[0] + v1[0] * cs23[1];
                        w1[2] = v1[2] * cs23[2] - v1[3] * cs23[3]; w1[3] = v1[3] * cs23[2] + v1[2] * cs23[3];
                        v0 = w0; v1 = w1; }
                    *(u32x2*)(base + ((size_t)(b * NH + h) * slen + t) * DQK + dd) = pack8_fp8(v0, v1); } }
        return false;
    }
};
struct EpiK {
    unsigned char* K; const float* rstd;
    __device__ __forceinline__ bool operator()(f32x4 (&acc)[2][2][4][2], const Unit& u, int wr, int wc, int fr, int fq) const {
        const int cl = wc * 32 + 8 * fq;
#pragma unroll
        for (int ai = 0; ai < 2; ++ai)
#pragma unroll
            for (int m = 0; m < 4; ++m) { const int row = u.pm * 256 + ai * HALF + wr * 64 + m * 16 + fr; const float rs = rstd[row];
                int b, s; if (row < MLAT) { b = row >> 13; s = row & (SEQ - 1); } else { const int rc = row - MLAT; b = rc >> 8; s = SEQ + (rc & (CTXL - 1)); }
#pragma unroll
                for (int bj = 0; bj < 2; ++bj) { const size_t key = (size_t)(b * NH + 2 * u.pn + bj) * SKV + s;
                    *(u32x2*)(K + key * 128 + cl) = pack8_fp8(acc[ai][bj][m][0] * rs, acc[ai][bj][m][1] * rs); } }
        return false;
    }
};
struct EpiVT {
    unsigned char* VT; const float* rstd;
    __device__ __forceinline__ bool operator()(f32x4 (&acc)[2][2][4][2], const Unit& u, int wr, int wc, int fr, int fq) const {
#pragma unroll
        for (int bj = 0; bj < 2; ++bj) { const int tk = u.pn * 256 + bj * HALF + wc * 32 + 8 * fq;
            int b, s; if (tk < MLAT) { b = tk >> 13; s = tk & (SEQ - 1); } else { const int rc = tk - MLAT; b = rc >> 8; s = SEQ + (rc & (CTXL - 1)); }
            const f32x4 rs0 = *(const f32x4*)(rstd + tk), rs1 = *(const f32x4*)(rstd + tk + 4);
            const int kk = s & 63, pos = 16 * (kk >> 5) + 4 * ((kk >> 3) & 3);
#pragma unroll
            for (int ai = 0; ai < 2; ++ai)
#pragma unroll
                for (int m = 0; m < 4; ++m) { const int row = u.pm * 256 + ai * HALF + wr * 64 + m * 16 + fr, h = row >> 7, dv = row & 127;
                    unsigned char* base = VT + ((size_t)(b * NH + h) * (SKV / 64) + (s >> 6)) * 8192 + dv * 64 + pos;
                    const f32x4 v0 = acc[ai][bj][m][0] * rs0, v1 = acc[ai][bj][m][1] * rs1;
                    int w0 = 0, w1 = 0; w0 = __builtin_amdgcn_cvt_pk_fp8_f32(v0[0], v0[1], w0, false); w0 = __builtin_amdgcn_cvt_pk_fp8_f32(v0[2], v0[3], w0, true);
                    w1 = __builtin_amdgcn_cvt_pk_fp8_f32(v1[0], v1[1], w1, false); w1 = __builtin_amdgcn_cvt_pk_fp8_f32(v1[2], v1[3], w1, true);
                    *(int*)base = w0; *(int*)(base + 32) = w1; } }
        return false;
    }
};
struct EpiOut1 {
    const bf16_t* GT; bf16_t* MG;
    __device__ __forceinline__ bool operator()(f32x4 (&acc)[2][2][4][2], const Unit& u, int wr, int wc, int fr, int fq) const {
        const int seg = u.aux;
#pragma unroll
        for (int ai = 0; ai < 2; ++ai)
#pragma unroll
            for (int m = 0; m < 4; ++m) { const int row = u.pm * 256 + ai * HALF + wr * 64 + m * 16 + fr;
#pragma unroll
                for (int bj = 0; bj < 2; ++bj) { const int c = u.pn * 256 + bj * HALF + wc * 32 + 8 * fq;
                    f32x4 a0, a1; unpack8(*(const u32x4*)(GT + (size_t)row * 3072 + seg * DM + c), a0, a1);
                    if (seg < 2) { f32x4 b0, b1; unpack8(*(const u32x4*)(GT + (size_t)row * 3072 + (seg + 1) * DM + c), b0, b1);
#pragma unroll
                        for (int j = 0; j < 4; ++j) { a0[j] = a0[j] * __builtin_amdgcn_rcpf(b0[j]); a1[j] = a1[j] * __builtin_amdgcn_rcpf(b1[j]); } }
                    acc[ai][bj][m][0] *= a0; acc[ai][bj][m][1] *= a1;
                    if (seg == 2) *(u32x4*)(MG + (size_t)row * DM + c) = pack8(acc[ai][bj][m][0], acc[ai][bj][m][1]); }
                asm volatile("" ::: "memory"); }
        return seg < 2;
    }
};
}

namespace att {
constexpr int DK = 192, DV = 128, NW = 8, QBLK = 32, KVBLK = 64;
constexpr float SCALE = 0.07216878364870322f;
constexpr float THR = 3.f;
constexpr int SHM_V = KVBLK * DV, SHM_K = KVBLK * DK;
constexpr int SHM_ATTN = 3 * SHM_V + 2 * SHM_K + NW * 64 * 4;
static_assert(SHM_ATTN <= STAGE_BYTES, "attention LDS fits the stage region");
#define SBAR() __builtin_amdgcn_sched_barrier(0)
__device__ __forceinline__ int crow(int r, int hi) { return (r & 3) + 8 * (r >> 2) + 4 * hi; }
__device__ __forceinline__ int k_off(int row, int c24) { return (c24 >> 3) * 8192 + row * 128 + (((c24 & 7) ^ ((row >> 1) & 7)) << 4); }
__device__ __forceinline__ void partialSM(f32x16& p0, f32x16& p1, float& m_reg, float& mn, float& alpha) {
  constexpr float C = SCALE * 1.4426950408889634f;
  float pmax = p0[0];
#pragma unroll
  for (int r = 1; r < 16; ++r) pmax = fmaxf(pmax, p0[r]);
#pragma unroll
  for (int r = 0; r < 16; ++r) pmax = fmaxf(pmax, p1[r]);
  { auto rr = __builtin_amdgcn_permlane32_swap(__float_as_uint(pmax), __float_as_uint(pmax), false, false);
    pmax = fmaxf(__uint_as_float(rr[0]), __uint_as_float(rr[1])); }
  if (__builtin_expect(__all(pmax - m_reg <= THR / SCALE), 1)) { mn = m_reg; alpha = 1.f; }
  else { mn = fmaxf(m_reg, pmax); alpha = __builtin_amdgcn_exp2f((m_reg - mn) * C); m_reg = mn; }
  float mnC = 4.f - mn * C;
#pragma unroll
  for (int r = 0; r < 16; ++r) p0[r] = fmaf(p0[r], C, mnC);
#pragma unroll
  for (int r = 0; r < 16; ++r) p1[r] = fmaf(p1[r], C, mnC);
#pragma unroll
  for (int r = 0; r < 16; ++r) p0[r] = __builtin_amdgcn_exp2f(p0[r]);
}
__device__ __forceinline__ void finishSM(f32x16& p0, f32x16& p1, float alpha, float& l_reg, pg8::i32x8& P8) {
#pragma unroll
  for (int r = 0; r < 16; ++r) p1[r] = __builtin_amdgcn_exp2f(p1[r]);
  float ps = 0;
#pragma unroll
  for (int r = 0; r < 16; ++r) ps += p0[r];
#pragma unroll
  for (int r = 0; r < 16; ++r) ps += p1[r];
  { auto rr = __builtin_amdgcn_permlane32_swap(__float_as_uint(ps), __float_as_uint(ps), false, false);
    ps = __uint_as_float(rr[0]) + __uint_as_float(rr[1]); }
  l_reg = l_reg * alpha + ps;
#pragma unroll
  for (int q = 0; q < 4; ++q) { int w = 0, x = 0;
    w = __builtin_amdgcn_cvt_pk_fp8_f32(p0[4 * q], p0[4 * q + 1], w, false); w = __builtin_amdgcn_cvt_pk_fp8_f32(p0[4 * q + 2], p0[4 * q + 3], w, true);
    x = __builtin_amdgcn_cvt_pk_fp8_f32(p1[4 * q], p1[4 * q + 1], x, false); x = __builtin_amdgcn_cvt_pk_fp8_f32(p1[4 * q + 2], p1[4 * q + 3], x, true);
    P8[q] = w; P8[4 + q] = x; }
}
__device__ __forceinline__ void qkt(f32x16& p0, f32x16& p1, const LAS unsigned char* Ks, const pg8::i32x8* qf, int ko0, int ko1) {
  p0 = f32x16{}; p1 = f32x16{};
#pragma unroll
  for (int i = 0; i < 3; ++i) {
    const u32x4 a0 = *(const LAS u32x4*)(Ks + i * 4096 + ko0), a1 = *(const LAS u32x4*)(Ks + i * 4096 + ko1);
    const u32x4 b0 = *(const LAS u32x4*)(Ks + i * 4096 + 2048 + ko0), b1 = *(const LAS u32x4*)(Ks + i * 4096 + 2048 + ko1);
    const pg8::i32x8 ka = {(int)a0.x, (int)a0.y, (int)a0.z, (int)a0.w, (int)a1.x, (int)a1.y, (int)a1.z, (int)a1.w}, kb = {(int)b0.x, (int)b0.y, (int)b0.z, (int)b0.w, (int)b1.x, (int)b1.y, (int)b1.z, (int)b1.w};
    p0 = __builtin_amdgcn_mfma_scale_f32_32x32x64_f8f6f4(ka, qf[i], p0, 0, 0, 0, 0x7f7f7f7f, 0, 0x7f7f7f7f);
    p1 = __builtin_amdgcn_mfma_scale_f32_32x32x64_f8f6f4(kb, qf[i], p1, 0, 0, 0, 0x7f7f7f7f, 0, 0x7f7f7f7f); }
}
__device__ __forceinline__ void pv8(f32x16* o, const LAS unsigned char* Vs, const pg8::i32x8 P8, int ko0, int ko1) {
#pragma unroll
  for (int d0 = 0; d0 < 4; ++d0) { const u32x4 a = *(const LAS u32x4*)(Vs + d0 * 2048 + ko0), b = *(const LAS u32x4*)(Vs + d0 * 2048 + ko1);
    const pg8::i32x8 v = {(int)a.x, (int)a.y, (int)a.z, (int)a.w, (int)b.x, (int)b.y, (int)b.z, (int)b.w};
    o[d0] = __builtin_amdgcn_mfma_scale_f32_32x32x64_f8f6f4(P8, v, o[d0], 0, 0, 0, 0x7f7f7f7f, 0, 0x7f7f7f7f); }
}
__device__ __forceinline__ void attn_unit(const char* __restrict__ Qb, const char* __restrict__ Kh, const char* __restrict__ Kr, const char* __restrict__ Vh, char* __restrict__ Ob, int seq, LAS unsigned char* lds, const int wid) {
  const int tid = fresh_tid(wid), lane = tid & 63, r32 = lane & 31, hi = lane >> 5;
  LAS unsigned char* V_lds = lds; LAS unsigned char* K_lds = lds + 3 * SHM_V;
  LAS float* ws = (LAS float*)(lds + 3 * SHM_V + 2 * SHM_K) + wid * 64; LAS float* li_l = ws; LAS float* al_l = ws + 32;
  float m_reg = -1e30f, l_reg = 0; f32x16 o[4] = {}; pg8::i32x8 qf[3];
  const unsigned qoff = (unsigned)((wid * QBLK + r32) * DK + hi * 32);
#pragma unroll
  for (int i = 0; i < 3; ++i) { const u32x4 a = *reinterpret_cast<const u32x4*>(Qb + qoff + i * 64), b = *reinterpret_cast<const u32x4*>(Qb + qoff + i * 64 + 16);
    qf[i] = (pg8::i32x8){(int)a.x, (int)a.y, (int)a.z, (int)a.w, (int)b.x, (int)b.y, (int)b.z, (int)b.w}; }
  const int ko0 = r32 * 64 + 16 * ((2 * hi) ^ ((r32 >> 2) & 3)), ko1 = ko0 ^ 16;
  const unsigned kswz = (unsigned)(((lane & 3) ^ ((lane >> 4) & 3)) << 4), krow = (unsigned)(16 * (wid & 3) + (lane >> 2));
  const unsigned kgn = krow * 128 + 64 * (wid >> 2) + kswz, kgr = krow * 64 + kswz;
  LAS unsigned char* kdst = K_lds + (wid >> 2) * 4096 + (wid & 3) * 1024; LAS unsigned char* kdst2 = K_lds + 8192 + (wid & 3) * 1024;
  const unsigned vg = (unsigned)((16 * wid + (lane >> 2)) * 64) + kswz;
  LAS unsigned char* vdst = V_lds + wid * 1024;
#define SLOAD(k0, kb, vboff) do { \
    __builtin_amdgcn_global_load_lds((const unsigned*)(Vh + (size_t)(k0) * 128 + vg), (LAS unsigned*)(vdst + (vboff)), 16, 0, 0); \
    __builtin_amdgcn_global_load_lds((const unsigned*)(Kh + (size_t)(k0) * 128 + kgn), (LAS unsigned*)(kdst + (kb) * SHM_K), 16, 0, 0); \
    if (wid < 4) __builtin_amdgcn_global_load_lds((const unsigned*)(Kr + (size_t)(k0) * 64 + kgr), (LAS unsigned*)(kdst2 + (kb) * SHM_K), 16, 0, 0); } while (0)
#define TILE_SYNC() do { asm volatile("s_waitcnt vmcnt(0)" ::: "memory"); __syncthreads(); } while (0)
#define RESC(a) do { if (__any((a) < 1.f)) { if (hi == 0) al_l[r32] = (a); asm volatile("s_waitcnt lgkmcnt(0)" ::: "memory"); \
    _Pragma("unroll") for (int d = 0; d < 4; ++d) _Pragma("unroll") for (int r = 0; r < 16; ++r) o[d][r] *= al_l[crow(r, hi)]; } } while (0)
#define VROT(x) do { (x) += SHM_V; if ((x) == 3 * SHM_V) (x) = 0; } while (0)
  f32x16 pA0, pA1, pB0, pB1; float mnA, mnB, alA, alB; pg8::i32x8 P8; const int NT = seq / KVBLK;
  __syncthreads();
  SLOAD(0, 0, 0); TILE_SYNC();
  qkt(pA0, pA1, K_lds, qf, ko0, ko1); partialSM(pA0, pA1, m_reg, mnA, alA);
  SLOAD(KVBLK, 1, SHM_V); TILE_SYNC();
  int vrd = 0, vwr = 2 * SHM_V;
  if (wid >= 4) __builtin_amdgcn_s_setprio(1);
  for (int j = 1; j + 1 < NT; j += 2) {
    SBAR(); qkt(pB0, pB1, K_lds + SHM_K, qf, ko0, ko1);
    finishSM(pA0, pA1, alA, l_reg, P8); SBAR();
    SLOAD((j + 1) * KVBLK, 0, vwr); SBAR();
    pv8(o, V_lds + vrd, P8, ko0, ko1); partialSM(pB0, pB1, m_reg, mnB, alB);
    RESC(alB); VROT(vrd); VROT(vwr); TILE_SYNC();
    SBAR(); qkt(pA0, pA1, K_lds, qf, ko0, ko1);
    finishSM(pB0, pB1, alB, l_reg, P8); SBAR();
    SLOAD((j + 2) * KVBLK, 1, vwr); SBAR();
    pv8(o, V_lds + vrd, P8, ko0, ko1); partialSM(pA0, pA1, m_reg, mnA, alA);
    RESC(alA); VROT(vrd); VROT(vwr); TILE_SYNC();
  }
  SBAR(); qkt(pB0, pB1, K_lds + SHM_K, qf, ko0, ko1);
  finishSM(pA0, pA1, alA, l_reg, P8); SBAR();
  pv8(o, V_lds + vrd, P8, ko0, ko1); partialSM(pB0, pB1, m_reg, mnB, alB);
  RESC(alB); VROT(vrd);
  finishSM(pB0, pB1, alB, l_reg, P8); SBAR();
  pv8(o, V_lds + vrd, P8, ko0, ko1);
  __builtin_amdgcn_s_setprio(0);
  if (hi == 0) li_l[r32] = l_reg; asm volatile("s_waitcnt lgkmcnt(0)" ::: "memory");
  float rli[16];
#pragma unroll
  for (int r = 0; r < 16; ++r) rli[r] = __builtin_amdgcn_rcpf(li_l[crow(r, hi)]);
  const unsigned ob0 = (unsigned)((wid * QBLK + 4 * hi) * DM + r32) * 2u;
#pragma unroll
  for (int r = 0; r < 16; ++r) {
#pragma unroll
    for (int d0 = 0; d0 < 4; ++d0) *(bf16_t*)(Ob + ob0 + (unsigned)(((r & 3) + 8 * (r >> 2)) * DM + d0 * 32) * 2u) = (bf16_t)(cvtpk(o[d0][r] * rli[r], 0.f) & 0xffffu); }
#undef SLOAD
#undef TILE_SYNC
#undef RESC
#undef VROT
}
}

struct Args { const float* in[35]; float* out; unsigned char* ws; int ph_lo, ph_hi; };
enum { I_X = 0, I_C, I_CTX, I_CCTX, I_MODW, I_MODB, I_PREMIXG, I_POSTMIXG, I_PREFFNG, I_POSTFFNG, I_WIN, I_POOLW, I_POOLSCALE, I_POOLPROJ, I_CONVW, I_CONVB,
       I_GAW, I_GAB, I_GXW, I_GXB, I_LAMBDA, I_LRUPROJ, I_QNORMG, I_WUQ, I_KVNORMG, I_WUKV, I_MLAPROJ, I_WOUT, I_FFNW1, I_FFNW3, I_FFNW2, I_ROUTERW, I_MOEW1, I_MOEW3, I_MOEW2 };

typedef const __attribute__((address_space(4))) Args* ArgsP;
struct Frame {
    LAS unsigned char* lds; int G, c, ngw, wave;
    ArgsP A;
};
__device__ __forceinline__ ArgsP launder(ArgsP a) { asm volatile("" : "+s"(a)); return a; }
__device__ __forceinline__ Frame make_frame(ArgsP A0, int wave) {
    extern __shared__ __attribute__((aligned(16))) unsigned char lds_raw[];
    Frame F; F.A = launder(A0); F.lds = (LAS unsigned char*)lds_raw; F.G = gridDim.x; F.c = blockIdx.x; F.ngw = F.G * NWAVES; F.wave = wave; return F;
}
__device__ __forceinline__ bool in_range(ArgsP A0, int k) { ArgsP a = launder(A0); return a->ph_lo <= k && k < a->ph_hi; }
#define PHASE_IDS const int wave = F.wave, tid = fresh_tid(wave), lane = tid & 63, gw = F.c * NWAVES + wave; (void)lane; (void)gw
#define RCOL(j) (lane * 8 + 512 * ((j) >> 1) + 4 * ((j) & 1))
#define F_IN(i) (F.A->in[i])
#define F_WS (F.A->ws)
#define F_OUT (F.A->out)

template <class Src> __device__ __forceinline__ void wprep_job(const Frame& F, int& it0, int K, int N, bf16_t* dst, const Src& src) {
    PHASE_IDS;
    LAS float* scr = (LAS float*)(F.lds + wave * 16384);
    const int nblk = N / 32, nitems = (K / 64) * nblk;
    int first = it0 + (((gw - it0) % F.ngw) + F.ngw) % F.ngw;
    for (int it = first; it < it0 + nitems; it += F.ngw) {
        const int r = it - it0, kb = r / nblk, nb = r % nblk, k0 = 64 * kb, n0 = 32 * nb;
#pragma unroll 8
        for (int i = 0; i < 32; ++i) { const int kk = 2 * i + (lane >> 5); scr[kk * 33 + (lane & 31)] = src(k0 + kk, n0 + (lane & 31)); }
        LDS_WAIT(); asm volatile("" ::: "memory");
        const int cc = lane & 7;
#pragma unroll
        for (int j = 0; j < 4; ++j) { const int n = (lane >> 3) + 8 * j; const LAS float* s = scr + (8 * cc) * 33 + n;
            u32x4 o; o.x = cvtpk(s[0 * 33], s[1 * 33]); o.y = cvtpk(s[2 * 33], s[3 * 33]); o.z = cvtpk(s[4 * 33], s[5 * 33]); o.w = cvtpk(s[6 * 33], s[7 * 33]);
            *(u32x4*)(dst + (size_t)(n0 + n) * K + k0 + 8 * cc) = o; }
        LDS_WAIT(); asm volatile("" ::: "memory");
    }
    it0 += nitems;
}
template <class Src> __device__ __forceinline__ void wprep_fast(const Frame& F, int& it0, int K, int N, bf16_t* dst, const Src& src) {
    PHASE_IDS;
    LAS float* scr = (LAS float*)(F.lds + wave * 16384);
    const int nblk = N / 32, nitems = (K / 64) * nblk; const long ld = src.ld;
    int first = it0 + (((gw - it0) % F.ngw) + F.ngw) % F.ngw;
    for (int it = first; it < it0 + nitems; it += F.ngw) {
        const int r = it - it0, kb = r / nblk, nb = r % nblk, k0 = 64 * kb, n0 = 32 * nb;
        const float* p = src.at(n0 + (lane & 31)); float v[32];
        if (p) { p += (long)(k0 + (lane >> 5)) * ld;
#pragma unroll
            for (int i = 0; i < 32; ++i) v[i] = __builtin_nontemporal_load(p + (long)(2 * i) * ld); }
        else {
#pragma unroll
            for (int i = 0; i < 32; ++i) v[i] = 0.f; }
#pragma unroll
        for (int i = 0; i < 32; ++i) scr[(2 * i + (lane >> 5)) * 33 + (lane & 31)] = v[i];
        LDS_WAIT(); asm volatile("" ::: "memory");
        const int cc = lane & 7;
#pragma unroll
        for (int j = 0; j < 4; ++j) { const int n = (lane >> 3) + 8 * j; const LAS float* s = scr + (8 * cc) * 33 + n;
            u32x4 o; o.x = cvtpk(s[0 * 33], s[1 * 33]); o.y = cvtpk(s[2 * 33], s[3 * 33]); o.z = cvtpk(s[4 * 33], s[5 * 33]); o.w = cvtpk(s[6 * 33], s[7 * 33]);
            *(u32x4*)(dst + (size_t)(n0 + n) * K + k0 + 8 * cc) = o; }
        LDS_WAIT(); asm volatile("" ::: "memory");
    }
    it0 += nitems;
}
template <class Src> __device__ __forceinline__ void wprep_fast8(const Frame& F, int& it0, int K, int N, unsigned char* dst, const Src& src, float scale) {
    PHASE_IDS;
    LAS float* scr = (LAS float*)(F.lds + wave * 16384);
    const int nblk = N / 32, nitems = (K / 64) * nblk; const long ld = src.ld;
    int first = it0 + (((gw - it0) % F.ngw) + F.ngw) % F.ngw;
    for (int it = first; it < it0 + nitems; it += F.ngw) {
        const int r = it - it0, kb = r / nblk, nb = r % nblk, k0 = 64 * kb, n0 = 32 * nb;
        const float* p = src.at(n0 + (lane & 31)); float v[32];
        if (p) { p += (long)(k0 + (lane >> 5)) * ld;
#pragma unroll
            for (int i = 0; i < 32; ++i) v[i] = __builtin_nontemporal_load(p + (long)(2 * i) * ld); }
        else {
#pragma unroll
            for (int i = 0; i < 32; ++i) v[i] = 0.f; }
#pragma unroll
        for (int i = 0; i < 32; ++i) scr[(2 * i + (lane >> 5)) * 33 + (lane & 31)] = v[i] * scale;
        LDS_WAIT(); asm volatile("" ::: "memory");
        const int cc = lane & 7;
#pragma unroll
        for (int j = 0; j < 4; ++j) { const int n = (lane >> 3) + 8 * j; const LAS float* s = scr + (8 * cc) * 33 + n;
            const f32x4 a = {s[0 * 33], s[1 * 33], s[2 * 33], s[3 * 33]}, b = {s[4 * 33], s[5 * 33], s[6 * 33], s[7 * 33]};
            *(u32x2*)(dst + (size_t)(n0 + n) * K + k0 + 8 * cc) = pg8::pack8_fp8(a, b); }
        LDS_WAIT(); asm volatile("" ::: "memory");
    }
    it0 += nitems;
}
struct FastPlain { const float* W; int ld; __device__ __forceinline__ const float* at(int n) const { return W + n; } };
struct FastIn1 { const float* W; int ld;
    __device__ __forceinline__ const float* at(int n) const { int c; if (n < 1024) c = 1024 + n; else if (n < 2048) c = 2048 + (n - 1024); else if (n < 3072) c = n - 2048; else if (n < 3776) c = n; else return nullptr; return W + c; } };
struct FastW13 { const float* W1; long d31; int ld;
    __device__ __forceinline__ const float* at(int n) const { const int pn = n >> 8, bj = (n >> 7) & 1, jj = n & 127; return W1 + (long)bj * d31 + pn * 128 + jj; } };
struct SrcPlain { const float* W; int ld; __device__ __forceinline__ float operator()(int k, int n) const { return W[(size_t)k * ld + n]; } };
struct SrcPlainS { const float* W; int ld; float s; __device__ __forceinline__ float operator()(int k, int n) const { return W[(size_t)k * ld + n] * s; } };
struct SrcIn1 { const float* W;
    __device__ __forceinline__ float operator()(int k, int n) const {
        int c; if (n < 1024) c = 1024 + n; else if (n < 2048) c = 2048 + (n - 1024); else if (n < 3072) c = n - 2048; else if (n < 3776) c = n; else return 0.f;
        return W[(size_t)k * INCOLS + c]; } };
struct SrcGate { const float* Wa; long dxa; int nb;
    __device__ __forceinline__ float operator()(int k, int n) const { const int d = n >> 8, bj = (n >> 7) & 1, jj = n & 127;
        return Wa[(long)bj * dxa + (((long)d * 8 + nb) * 128 + k) * 128 + jj]; } };
struct SrcUQ { const float* W; const float* g;
    __device__ __forceinline__ float operator()(int k, int n) const { const int h = n / DQK, dd = n - h * DQK; int c = n;
        if (dd >= 128) { const int p = dd - 128, axis = p >> 5, f = (p & 31) >> 1, half = p & 1; c = h * DQK + 128 + axis * 32 + half * 16 + f; }
        return W[(size_t)k * 1536 + c] * g[k]; } };
struct SrcScaleK { const float* W; const float* g; int ld; __device__ __forceinline__ float operator()(int k, int n) const { return W[(size_t)k * ld + n] * g[k]; } };
struct SrcUKV { const float* W; const float* g;
    __device__ __forceinline__ float operator()(int k, int n) const { const int v = n >> 10, h = (n >> 7) & 7, j = n & 127; return W[(size_t)k * 2048 + h * 256 + v * 128 + j] * g[k]; } };
struct SrcW13 { const float* W1; long d31; int ld;
    __device__ __forceinline__ float operator()(int k, int n) const { const int pn = n >> 8, bj = (n >> 7) & 1, jj = n & 127; return W1[(long)bj * d31 + (long)k * ld + pn * 128 + jj]; } };
struct SrcPoolWS { const float* W; const float* sc;
    __device__ __forceinline__ float operator()(int k, int n) const { return W[(size_t)n * 256 + k] * sc[k]; } };

__device__ __forceinline__ void mod_partials(const Frame& F) {
    PHASE_IDS;
    const float* c = F_IN(I_C); const float* cc = F_IN(I_CCTX); const float* mw = F_IN(I_MODW); float* part = (float*)(F_WS + WS_MPART);
    for (int task = F.c; task < 2 * 12 * 32; task += F.G) {
        const int l = task / 384, r = task % 384, cb = r / 32, kc = r % 32, col = cb * 512 + tid;
        float a0 = 0, a1 = 0, a2 = 0, a3 = 0, a4 = 0;
#pragma unroll 8
        for (int kk = 0; kk < 32; ++kk) { const int k = kc * 32 + kk; const float w = mw[((size_t)l * 1024 + k) * 6144 + col];
            const float c0 = c[k], c1 = c[1024 + k], c2 = c[2048 + k], c3 = c[3072 + k], c4 = cc[k];
            a0 += c0 * sigmoidf_(c0) * w; a1 += c1 * sigmoidf_(c1) * w; a2 += c2 * sigmoidf_(c2) * w; a3 += c3 * sigmoidf_(c3) * w; a4 += c4 * sigmoidf_(c4) * w; }
        float* p = part + (((size_t)l * 32 + kc) * 5) * 6144 + col;
        p[0] = a0; p[6144] = a1; p[2 * 6144] = a2; p[3 * 6144] = a3; p[4 * 6144] = a4;
    }
}
__device__ __forceinline__ void mod_reduce(const Frame& F) {
    PHASE_IDS;
    const float* part = (const float*)(F_WS + WS_MPART); const float* mb = F_IN(I_MODB); float* mv = (float*)(F_WS + WS_MVEC);
    for (int i = F.c * NTHR + tid; i < 2 * 5 * 6144; i += F.G * NTHR) { const int l = i / 30720, r = (i % 30720) / 6144, col = i % 6144;
        float s = mb[l * 6144 + col];
        for (int kc = 0; kc < 32; ++kc) s += part[(((size_t)l * 32 + kc) * 5 + r) * 6144 + col];
        mv[i] = s; }
}
__device__ __forceinline__ void rope_and_consts(const Frame& F) {
    PHASE_IDS;
    f32x2* rope = (f32x2*)(F_WS + WS_ROPE);
    for (int i = F.c * NTHR + tid; i < 8193 * 32; i += F.G * NTHR) { const int pos = i >> 5, a = (i >> 4) & 1, f = i & 15;
        f32x2 v = {1.f, 0.f};
        if (pos < SEQ) { const float inv = __builtin_amdgcn_exp2f(-(float)f * (13.287712379549449f / 16.f));
            const float p = (float)(a == 0 ? (pos >> 6) : (pos & 63)); const float rev = (p * inv) * 0.15915494309189535f; const float fr = rev - rintf(rev);
            v.x = __builtin_amdgcn_cosf(fr); v.y = __builtin_amdgcn_sinf(fr); }
        rope[i] = v; }
    float* sp8 = (float*)(F_WS + WS_SP8); const float* lam = F_IN(I_LAMBDA);
    for (int i = F.c * NTHR + tid; i < 2 * 2 * 1024; i += F.G * NTHR) sp8[i] = -8.f * log1pf(expf(-lam[i]));
}

__device__ __forceinline__ void pool_weights_phase(const Frame& F) {
    PHASE_IDS;
    for (int tile = F.c; tile < 512; tile += F.G) {
        const int l = tile >> 8, g = (tile >> 6) & 3, n0 = ((tile >> 2) & 15) * 64, i0 = (tile & 3) * 64 + wave * 8;
        const float* PW = F_IN(I_POOLW) + (((size_t)l * 4 + g) * 256 + i0) * 256; const float* SC = F_IN(I_POOLSCALE) + l * 1024 + g * 256;
        const float* PP = F_IN(I_POOLPROJ) + ((size_t)l * 1024 + g * 256) * DM + n0 + lane;
        float acc[8] = {0.f, 0.f, 0.f, 0.f, 0.f, 0.f, 0.f, 0.f};
#pragma unroll 4
        for (int j = 0; j < 256; ++j) { const float p = PP[(size_t)j * DM] * SC[j];
#pragma unroll
            for (int ii = 0; ii < 8; ++ii) acc[ii] += PW[ii * 256 + j] * p; }
        u32x4 o; o.x = cvtpk(acc[0], acc[1]); o.y = cvtpk(acc[2], acc[3]); o.z = cvtpk(acc[4], acc[5]); o.w = cvtpk(acc[6], acc[7]);
        *(u32x4*)((bf16_t*)(F_WS + WS_WTS + (size_t)l * WTS_LSTRIDE + WO_POOL) + (size_t)(n0 + lane) * DM + g * 256 + i0) = o;
    }
}
__device__ __forceinline__ const float* mvec_row(const Frame& F, int l, int row) { return (const float*)(F_WS + WS_MVEC) + ((size_t)l * 5 + (row < MLAT ? (row >> 13) : 4)) * 6144; }
template <bool BF> __device__ __forceinline__ void ldx8(const void* base, size_t e, f32x4& a, f32x4& b) {
    if (BF) { const u32x4 w = *(const u32x4*)((const bf16_t*)base + e); a = (f32x4){bf_lo(w.x), bf_hi(w.x), bf_lo(w.y), bf_hi(w.y)}; b = (f32x4){bf_lo(w.z), bf_hi(w.z), bf_lo(w.w), bf_hi(w.w)}; }
    else { a = *(const f32x4*)((const float*)base + e); b = *(const f32x4*)((const float*)base + e + 4); }
}
template <bool BF> __device__ __forceinline__ void stx8(void* base, size_t e, const f32x4 a, const f32x4 b) {
    if (BF) { u32x4 w; w.x = cvtpk(a[0], a[1]); w.y = cvtpk(a[2], a[3]); w.z = cvtpk(b[0], b[1]); w.w = cvtpk(b[2], b[3]); *(u32x4*)((bf16_t*)base + e) = w; }
    else { *(f32x4*)((float*)base + e) = a; *(f32x4*)((float*)base + e + 4) = b; }
}
template <bool XBF> __device__ __forceinline__ void norm1_phase(const Frame& F, int l, const void* xlat, const float* xctx, bf16_t* H, unsigned char* H8, int nrows) {
    PHASE_IDS;
    const float* g = F_IN(I_PREMIXG) + l * DM;
    for (int row = gw; row < nrows; row += F.ngw) {
        const bool lat = row < MLAT; const float* mr = mvec_row(F, l, row);
        f32x4 v[4]; float ss = 0.f;
#pragma unroll
        for (int jp = 0; jp < 2; ++jp) { if (lat) ldx8<XBF>(xlat, (size_t)row * DM + lane * 8 + 512 * jp, v[2 * jp], v[2 * jp + 1]); else ldx8<false>(xctx, (size_t)(row - MLAT) * DM + lane * 8 + 512 * jp, v[2 * jp], v[2 * jp + 1]); }
#pragma unroll
        for (int j = 0; j < 4; ++j) ss += (v[j][0] * v[j][0] + v[j][1] * v[j][1]) + (v[j][2] * v[j][2] + v[j][3] * v[j][3]);
        const float rstd = rsqrtf(wave_sum(ss) * (1.f / DM) + RMS_EPS);
#pragma unroll
        for (int j = 0; j < 4; ++j) { const int col = RCOL(j); const f32x4 gg = *(const f32x4*)(g + col), sh = *(const f32x4*)(mr + col), sc = *(const f32x4*)(mr + DM + col);
            v[j] = v[j] * rstd * gg * (sc + 1.f) + sh; }
#pragma unroll
        for (int jp = 0; jp < 2; ++jp) { const f32x4 p = v[2 * jp], q = v[2 * jp + 1]; const size_t o = (size_t)row * DM + lane * 8 + 512 * jp;
            u32x4 w; w.x = cvtpk(p[0], p[1]); w.y = cvtpk(p[2], p[3]); w.z = cvtpk(q[0], q[1]); w.w = cvtpk(q[2], q[3]); *(u32x4*)(H + o) = w;
            *(u32x2*)(H8 + o) = pg8::pack8_fp8(p, q); }
    }
}
template <bool MOE, bool XIB, bool XOB> __device__ __forceinline__ void resid1_phase(const Frame& F, int l, const void* xlat, const float* xctx, void* olat, float* octx, const bf16_t* Y, bf16_t* H2, int nrows) {
    PHASE_IDS;
    const float* gpost = F_IN(I_POSTMIXG) + l * DM; const float* gpre = F_IN(I_PREFFNG) + l * DM;
    LAS float* rw = (LAS float*)F.lds;
    volatile LAS int* hist = (volatile LAS int*)(F.lds + 32768);
    if (MOE) { const float* rwg = F_IN(I_ROUTERW);
        for (int i = tid; i < 8192; i += NTHR) rw[(i & 7) * 1024 + (i >> 3)] = rwg[i];
        if (tid < 8) hist[tid] = 0;
        __syncthreads(); }
    for (int row = gw; row < nrows; row += F.ngw) {
        const bool lat = row < MLAT; const size_t ro = lat ? (size_t)row * DM : (size_t)(row - MLAT) * DM;
        const float* mr = mvec_row(F, l, row);
        f32x4 y[4], xv[4]; float ss = 0.f;
#pragma unroll
        for (int jp = 0; jp < 2; ++jp) { if (lat) ldx8<XIB>(xlat, ro + lane * 8 + 512 * jp, xv[2 * jp], xv[2 * jp + 1]); else ldx8<false>(xctx, ro + lane * 8 + 512 * jp, xv[2 * jp], xv[2 * jp + 1]); }
#pragma unroll
        for (int jp = 0; jp < 2; ++jp) { const u32x4 w = *(const u32x4*)(Y + (size_t)row * DM + lane * 8 + 512 * jp);
            y[2 * jp] = (f32x4){bf_lo(w.x), bf_hi(w.x), bf_lo(w.y), bf_hi(w.y)}; y[2 * jp + 1] = (f32x4){bf_lo(w.z), bf_hi(w.z), bf_lo(w.w), bf_hi(w.w)}; }
#pragma unroll
        for (int j = 0; j < 4; ++j) ss += (y[j][0] * y[j][0] + y[j][1] * y[j][1]) + (y[j][2] * y[j][2] + y[j][3] * y[j][3]);
        const float rs = rsqrtf(wave_sum(ss) * (1.f / DM) + RMS_EPS);
        f32x4 xn[4]; float s2 = 0.f;
#pragma unroll
        for (int j = 0; j < 4; ++j) { const int col = RCOL(j); const f32x4 gg = *(const f32x4*)(gpost + col), gate = *(const f32x4*)(mr + 2 * DM + col);
            xn[j] = xv[j] + gate * (y[j] * rs * gg);
            s2 += (xn[j][0] * xn[j][0] + xn[j][1] * xn[j][1]) + (xn[j][2] * xn[j][2] + xn[j][3] * xn[j][3]); }
#pragma unroll
        for (int jp = 0; jp < 2; ++jp) { if (lat) stx8<XOB>(olat, ro + lane * 8 + 512 * jp, xn[2 * jp], xn[2 * jp + 1]); else stx8<false>(octx, ro + lane * 8 + 512 * jp, xn[2 * jp], xn[2 * jp + 1]); }
        const float rs2 = rsqrtf(wave_sum(s2) * (1.f / DM) + RMS_EPS);
        f32x4 h2[4];
#pragma unroll
        for (int j = 0; j < 4; ++j) { const int col = RCOL(j); const f32x4 gg = *(const f32x4*)(gpre + col), sh = *(const f32x4*)(mr + 3 * DM + col), sc = *(const f32x4*)(mr + 4 * DM + col);
            h2[j] = xn[j] * rs2 * gg * (sc + 1.f) + sh; }
#pragma unroll
        for (int jp = 0; jp < 2; ++jp) { const f32x4 p = h2[2 * jp], q = h2[2 * jp + 1]; const size_t o = (size_t)row * DM + lane * 8 + 512 * jp;
            if (MOE) { *(u32x2*)((unsigned char*)H2 + o) = pg8::pack8_fp8(p, q); }
            else { u32x4 w; w.x = cvtpk(p[0], p[1]); w.y = cvtpk(p[2], p[3]); w.z = cvtpk(q[0], q[1]); w.w = cvtpk(q[2], q[3]); *(u32x4*)(H2 + o) = w; } }
        if (MOE) {
            float lg[8];
#pragma unroll
            for (int e = 0; e < 8; ++e) { float s = 0.f;
#pragma unroll
                for (int j = 0; j < 4; ++j) { const f32x4 w = *(const LAS f32x4*)(rw + e * 1024 + RCOL(j)); s += (h2[j][0] * w[0] + h2[j][1] * w[1]) + (h2[j][2] * w[2] + h2[j][3] * w[3]); }
                lg[e] = wave_sum(s); }
            int e1 = 0; float v1 = lg[0];
#pragma unroll
            for (int e = 1; e < 8; ++e) if (lg[e] > v1) { v1 = lg[e]; e1 = e; }
            int e2 = -1; float v2 = -3.0e38f;
#pragma unroll
            for (int e = 0; e < 8; ++e) if (e != e1 && lg[e] > v2) { v2 = lg[e]; e2 = e; }
            if (lane == 0) { ((int*)(F_WS + WS_E12))[row] = e1 | (e2 << 8); ((float*)(F_WS + WS_G1))[row] = 1.f / (1.f + expf(v2 - v1));
                atomicAdd((int*)&hist[e1], 1); atomicAdd((int*)&hist[e2], 1); }
        }
    }
    if (MOE) { __syncthreads(); if (tid < 8) atomicAdd((unsigned*)(F_WS + WS_CTL) + CW_CNT + 64 * tid, (unsigned)hist[tid]); }
}
template <bool MOE, bool XIB, bool XOB> __device__ __forceinline__ void resid2_phase(const Frame& F, int l, const void* xlat, const float* xctx, void* olat, float* octx, const bf16_t* Fb, int nrows) {
    PHASE_IDS;
    const float* gpost = F_IN(I_POSTFFNG) + l * DM;
    for (int row = gw; row < nrows; row += F.ngw) {
        const bool lat = row < MLAT; const size_t ro = lat ? (size_t)row * DM : (size_t)(row - MLAT) * DM;
        const float* mr = mvec_row(F, l, row);
        f32x4 f[4], xv[4]; float ss = 0.f;
#pragma unroll
        for (int jp = 0; jp < 2; ++jp) { if (lat) ldx8<XIB>(xlat, ro + lane * 8 + 512 * jp, xv[2 * jp], xv[2 * jp + 1]); else ldx8<false>(xctx, ro + lane * 8 + 512 * jp, xv[2 * jp], xv[2 * jp + 1]); }
        if (MOE) { const int d1 = ((const int*)(F_WS + WS_DEST))[2 * row], d2 = ((const int*)(F_WS + WS_DEST))[2 * row + 1]; const float g1 = ((const float*)(F_WS + WS_G1))[row], g2 = 1.f - g1;
#pragma unroll
            for (int jp = 0; jp < 2; ++jp) { const u32x4 a = *(const u32x4*)(Fb + (size_t)d1 * DM + lane * 8 + 512 * jp), b = *(const u32x4*)(Fb + (size_t)d2 * DM + lane * 8 + 512 * jp);
                f[2 * jp] = (f32x4){bf_lo(a.x), bf_hi(a.x), bf_lo(a.y), bf_hi(a.y)} * g1 + (f32x4){bf_lo(b.x), bf_hi(b.x), bf_lo(b.y), bf_hi(b.y)} * g2;
                f[2 * jp + 1] = (f32x4){bf_lo(a.z), bf_hi(a.z), bf_lo(a.w), bf_hi(a.w)} * g1 + (f32x4){bf_lo(b.z), bf_hi(b.z), bf_lo(b.w), bf_hi(b.w)} * g2; }
        } else {
#pragma unroll
            for (int jp = 0; jp < 2; ++jp) { const u32x4 a = *(const u32x4*)(Fb + (size_t)row * DM + lane * 8 + 512 * jp);
                f[2 * jp] = (f32x4){bf_lo(a.x), bf_hi(a.x), bf_lo(a.y), bf_hi(a.y)}; f[2 * jp + 1] = (f32x4){bf_lo(a.z), bf_hi(a.z), bf_lo(a.w), bf_hi(a.w)}; }
        }
#pragma unroll
        for (int j = 0; j < 4; ++j) ss += (f[j][0] * f[j][0] + f[j][1] * f[j][1]) + (f[j][2] * f[j][2] + f[j][3] * f[j][3]);
        const float rs = rsqrtf(wave_sum(ss) * (1.f / DM) + RMS_EPS);
#pragma unroll
        for (int j = 0; j < 4; ++j) { const int col = lane * 8 + 512 * (j >> 1) + 4 * (j & 1);
            const f32x4 gg = *(const f32x4*)(gpost + col), gate = *(const f32x4*)(mr + 5 * DM + col);
            xv[j] = xv[j] + gate * (f[j] * rs * gg); }
#pragma unroll
        for (int jp = 0; jp < 2; ++jp) { if (lat) stx8<XOB>(olat, ro + lane * 8 + 512 * jp, xv[2 * jp], xv[2 * jp + 1]); else stx8<false>(octx, ro + lane * 8 + 512 * jp, xv[2 * jp], xv[2 * jp + 1]); }
    }
}
__device__ __forceinline__ void conv_phase(const Frame& F, int l, const bf16_t* __restrict__ LX, bf16_t* __restrict__ U) {
    PHASE_IDS;
    const float* cw = F_IN(I_CONVW) + l * 4 * DM; const float* cb = F_IN(I_CONVB) + l * DM;
    const int gt = F.c * NTHR + tid, ch = (gt & 127) * 8, rstep = (F.G * NTHR) >> 7;
    f32x4 w0[4], w1[4];
#pragma unroll
    for (int k = 0; k < 4; ++k) { w0[k] = *(const f32x4*)(cw + k * DM + ch); w1[k] = *(const f32x4*)(cw + k * DM + ch + 4); }
    const f32x4 b0 = *(const f32x4*)(cb + ch), b1 = *(const f32x4*)(cb + ch + 4);
#pragma unroll 2
    for (int row = gt >> 7; row < MTOT; row += rstep) {
        int t, ls; if (row < MLAT) { t = row & (SEQ - 1); ls = SEQ; } else { t = (row - MLAT) & (CTXL - 1); ls = CTXL; }
        f32x4 a0 = b0, a1 = b1;
#pragma unroll
        for (int k = 0; k < 4; ++k) { const int tt = t + k - 2; if (tt >= 0 && tt < ls) { f32x4 x0, x1; pg8::unpack8(*(const u32x4*)(LX + (size_t)(row + k - 2) * DM + ch), x0, x1);
                a0 += x0 * w0[k]; a1 += x1 * w1[k]; } }
        *(u32x4*)(U + (size_t)row * DM + ch) = pg8::pack8(a0, a1);
    }
}
__device__ __forceinline__ void pool_phase(const Frame& F, const bf16_t* __restrict__ Z2, bf16_t* __restrict__ MP) {
    PHASE_IDS;
    for (int task = F.c * NTHR + tid; task < (MTOT / 33) * 128; task += F.G * NTHR) {
        const int c8 = task & 127, row0 = (task >> 7) * 33, ch = c8 * 8, hw = 1 << (c8 >> 5);
        f32x4 s0 = {0.f, 0.f, 0.f, 0.f}, s1 = {0.f, 0.f, 0.f, 0.f};
#pragma unroll 3
        for (int d = 0; d < 33; ++d) { const int row = row0 + d; int t, ls; if (row < MLAT) { t = row & (SEQ - 1); ls = SEQ; } else { t = (row - MLAT) & (CTXL - 1); ls = CTXL; }
            const bf16_t* z = Z2 + (size_t)row * Z2LD + ch;
            if (d == 0 || t == 0) { s0 = (f32x4){0.f, 0.f, 0.f, 0.f}; s1 = s0;
                for (int tt = max(t - hw, 0); tt < min(t + hw, ls); ++tt) { f32x4 x0, x1; pg8::unpack8(*(const u32x4*)(z + (long)(tt - t) * Z2LD), x0, x1); s0 += x0; s1 += x1; } }
            const int lo = max(t - hw, 0), hi = min(t + hw, ls);
            f32x4 u0, u1; pg8::unpack8(*(const u32x4*)z, u0, u1);
            const float inv = 1.f / (float)(hi - lo);
            *(u32x4*)(MP + (size_t)row * DM + ch) = pg8::pack8(s0 * inv - u0, s1 * inv - u1);
            if (t + hw < ls) { f32x4 x0, x1; pg8::unpack8(*(const u32x4*)(z + (long)hw * Z2LD), x0, x1); s0 += x0; s1 += x1; }
            if (t - hw >= 0) { f32x4 x0, x1; pg8::unpack8(*(const u32x4*)(z - (long)hw * Z2LD), x0, x1); s0 -= x0; s1 -= x1; } }
    }
}
__device__ __forceinline__ void mla_prep_phase(const Frame& F, const bf16_t* __restrict__ Z2, unsigned char* __restrict__ KR) {
    PHASE_IDS;
    float* rq = (float*)(F_WS + WS_RSTDQ); float* rkv = (float*)(F_WS + WS_RSTDKV); const f32x2* rope = (const f32x2*)(F_WS + WS_ROPE);
    const int i = lane & 15, g = lane >> 4;
    for (int r0 = gw * 4; r0 < MTOT; r0 += F.ngw * 4) { const int row = r0 + g;
        const bf16_t* zr = Z2 + (size_t)row * Z2LD + 1024 + 8 * i;
        float sq = 0.f, skv = 0.f; f32x4 k0 = {0.f, 0.f, 0.f, 0.f}, k1 = k0;
#pragma unroll
        for (int c = 0; c < 6; ++c) { if (c < 5 || i < 8) { f32x4 a0, a1; pg8::unpack8(*(const u32x4*)(zr + 128 * c), a0, a1);
                const float s = (a0[0] * a0[0] + a0[1] * a0[1]) + (a0[2] * a0[2] + a0[3] * a0[3]) + (a1[0] * a1[0] + a1[1] * a1[1]) + (a1[2] * a1[2] + a1[3] * a1[3]);
                if (c < 3) sq += s; else if (c < 5) skv += s; else { k0 = a0; k1 = a1; } } }
#pragma unroll
        for (int o = 1; o < 16; o <<= 1) { sq += __shfl_xor(sq, o); skv += __shfl_xor(skv, o); }
        if (i == 0) { rq[row] = rsqrtf(sq * (1.f / QLORA) + RMS_EPS); rkv[row] = rsqrtf(skv * (1.f / KVLORA) + RMS_EPS); }
        float xo[8], xp[8];
#pragma unroll
        for (int j = 0; j < 4; ++j) { xo[j] = k0[j]; xo[4 + j] = k1[j]; }
#pragma unroll
        for (int j = 0; j < 8; ++j) xp[j] = __shfl_xor(xo[j], 2);
        int b, s, pos; if (row < MLAT) { b = row >> 13; s = row & (SEQ - 1); pos = s; } else { const int rc = row - MLAT; b = rc >> 8; s = SEQ + (rc & (CTXL - 1)); pos = SEQ; }
        const int axis = (i >> 2) & 1, half = (i >> 1) & 1, f0 = 8 * (i & 1);
        float res[8];
#pragma unroll
        for (int j = 0; j < 8; ++j) { const f32x2 cs = rope[(size_t)pos * 32 + axis * 16 + f0 + j];
            const float x1 = half ? xp[j] : xo[j], x2 = half ? xo[j] : xp[j];
            res[j] = half ? (x2 * cs.x + x1 * cs.y) : (x1 * cs.x - x2 * cs.y); }
        float rp[8];
#pragma unroll
        for (int j = 0; j < 8; ++j) rp[j] = __shfl_xor(res[j], 2);
        if (i < 8 && half == 0) {
            int w[4];
#pragma unroll
            for (int q = 0; q < 4; ++q) { int v = 0; v = __builtin_amdgcn_cvt_pk_fp8_f32(res[2 * q], rp[2 * q], v, false); v = __builtin_amdgcn_cvt_pk_fp8_f32(res[2 * q + 1], rp[2 * q + 1], v, true); w[q] = v; }
            *(u32x4*)(KR + ((size_t)b * SKV + s) * 64 + axis * 32 + 2 * f0) = (u32x4){(unsigned)w[0], (unsigned)w[1], (unsigned)w[2], (unsigned)w[3]}; }
    }
}
__device__ __forceinline__ int scan_row(int b, int dir, int tau) {
    if (dir == 0) return tau < CTXL ? MLAT + b * CTXL + tau : b * SEQ + (tau - CTXL);
    return tau < CTXL ? MLAT + b * CTXL + (CTXL - 1 - tau) : b * SEQ + (SEQ - 1 - (tau - CTXL));
}
__device__ __forceinline__ void scan_coef(unsigned la, unsigned gx, f32x2& a, f32x2& bb) {
    a.x = __builtin_amdgcn_exp2f(1.4426950408889634f * bf_lo(la)); a.y = __builtin_amdgcn_exp2f(1.4426950408889634f * bf_hi(la));
    bb.x = __builtin_amdgcn_sqrtf(fmaxf(1.f - a.x * a.x, 0.f)) * bf_lo(gx); bb.y = __builtin_amdgcn_sqrtf(fmaxf(1.f - a.y * a.y, 0.f)) * bf_hi(gx);
}
__device__ __forceinline__ float gelu_tanh_(float g) {
    const float u = 0.7978845608028654f * (g + 0.044715f * g * g * g); return g * __builtin_amdgcn_rcpf(1.f + __builtin_amdgcn_exp2f(-2.8853900817779268f * u));
}
__device__ __forceinline__ void scan_coef8(const u32x4 om, const u32x4 bb, f32x4& a0, f32x4& a1, f32x4& b0, f32x4& b1) {
    f32x4 o0, o1; pg8::unpack8(om, o0, o1); pg8::unpack8(bb, b0, b1); a0 = 1.f - o0; a1 = 1.f - o1;
}
__device__ __forceinline__ void scan_a_phase(const Frame& F, int dir, const bf16_t* __restrict__ LA, const bf16_t* __restrict__ GX) {
    PHASE_IDS;
    float* SA = (float*)(F_WS + WS_SUMA); float* SB = (float*)(F_WS + WS_SUMB);
    for (int task = wave * F.G + F.c; task < NB * NCHUNK * 2; task += F.ngw) {
        const int cb = task & 1, j = (task >> 1) % NCHUNK, b = (task >> 1) / NCHUNK, ch = cb * 512 + 8 * lane;
        f32x4 A0 = {1.f, 1.f, 1.f, 1.f}, A1 = A0, B0 = {0.f, 0.f, 0.f, 0.f}, B1 = B0;
        long off = (long)scan_row(b, dir, j * 64) * DM + ch; const long STP = dir == 0 ? (long)DM : -(long)DM;
        u32x4 laA[8], gxA[8], laB[8], gxB[8];
#define SA_LOAD(la, gx, o0) do { _Pragma("unroll") for (int k = 0; k < 8; ++k) { la[k] = *(const u32x4*)(LA + (o0) + k * STP); gx[k] = *(const u32x4*)(GX + (o0) + k * STP); } } while (0)
#define SA_STEP(la, gx) do { _Pragma("unroll") for (int k = 0; k < 8; ++k) { f32x4 a0, a1, b0, b1; scan_coef8(la[k], gx[k], a0, a1, b0, b1); B0 = a0 * B0 + b0; B1 = a1 * B1 + b1; A0 = A0 * a0; A1 = A1 * a1; } } while (0)
        SA_LOAD(laA, gxA, off);
#pragma unroll 1
        for (int s0 = 0; s0 < 64; s0 += 16) {
            SA_LOAD(laB, gxB, off + 8 * STP);
            SA_STEP(laA, gxA);
            if (s0 + 16 < 64) SA_LOAD(laA, gxA, off + 16 * STP);
            SA_STEP(laB, gxB);
            off += 16 * STP;
        }
#undef SA_LOAD
#undef SA_STEP
        float* pa = SA + ((size_t)b * NCHUNK + j) * DM + ch; float* pb = SB + ((size_t)b * NCHUNK + j) * DM + ch;
        *(f32x4*)pa = A0; *(f32x4*)(pa + 4) = A1; *(f32x4*)pb = B0; *(f32x4*)(pb + 4) = B1;
    }
}
template <int DIR> __device__ __forceinline__ void scan_b_phase(const Frame& F, const bf16_t* __restrict__ LA, const bf16_t* __restrict__ GX, bf16_t* HF, const bf16_t* __restrict__ LG) {
    PHASE_IDS;
    const float* SA = (const float*)(F_WS + WS_SUMA); const float* SB = (const float*)(F_WS + WS_SUMB);
    for (int task = wave * F.G + F.c; task < NB * NCHUNK * 2; task += F.ngw) {
        const int cb = task & 1, j = (task >> 1) % NCHUNK, b = (task >> 1) / NCHUNK, ch = cb * 512 + 8 * lane;
        f32x4 h0 = {0.f, 0.f, 0.f, 0.f}, h1 = h0;
#pragma unroll 8
        for (int jj = 0; jj < j; ++jj) { const float* pa = SA + ((size_t)b * NCHUNK + jj) * DM + ch; const float* pb = SB + ((size_t)b * NCHUNK + jj) * DM + ch;
            h0 = *(const f32x4*)pa * h0 + *(const f32x4*)pb; h1 = *(const f32x4*)(pa + 4) * h1 + *(const f32x4*)(pb + 4); }
        long off = (long)scan_row(b, DIR, j * 64) * DM + ch; constexpr long STP = DIR == 0 ? (long)DM : -(long)DM;
        u32x4 laA[4], gxA[4], hfA[4], lgA[4], laB[4], gxB[4], hfB[4], lgB[4];
#define SB_LOAD(la, gx, hf, lg, o0) do { _Pragma("unroll") for (int k = 0; k < 4; ++k) { const long o = (o0) + k * STP; la[k] = *(const u32x4*)(LA + o); gx[k] = *(const u32x4*)(GX + o); \
            if (DIR == 1) { hf[k] = *(const u32x4*)(HF + o); lg[k] = *(const u32x4*)(LG + o); } } } while (0)
#define SB_STEP(la, gx, hf, lg, o0) do { _Pragma("unroll") for (int k = 0; k < 4; ++k) { f32x4 a0, a1, b0, b1; scan_coef8(la[k], gx[k], a0, a1, b0, b1); \
            h0 = a0 * h0 + b0; h1 = a1 * h1 + b1; \
            if (DIR == 0) hf[k] = pg8::pack8(h0, h1); \
            else { f32x4 f0, f1, g0, g1; pg8::unpack8(hf[k], f0, f1); pg8::unpack8(lg[k], g0, g1); \
                f0 = (f0 + h0) * g0; f1 = (f1 + h1) * g1; \
                hf[k] = pg8::pack8(f0, f1); } } \
        _Pragma("unroll") for (int k = 0; k < 4; ++k) *(u32x4*)(HF + (o0) + k * STP) = hf[k]; } while (0)
        SB_LOAD(laA, gxA, hfA, lgA, off);
#pragma unroll 1
        for (int s0 = 0; s0 < 64; s0 += 8) {
            SB_LOAD(laB, gxB, hfB, lgB, off + 4 * STP);
            SB_STEP(laA, gxA, hfA, lgA, off);
            if (s0 + 8 < 64) SB_LOAD(laA, gxA, hfA, lgA, off + 8 * STP);
            SB_STEP(laB, gxB, hfB, lgB, off + 4 * STP);
            off += 8 * STP;
        }
#undef SB_LOAD
#undef SB_STEP
    }
}
__device__ __forceinline__ void moe_tile_table(const Frame& F, volatile LAS int* tend) {
    PHASE_IDS;
    if (tid == 0) { const unsigned* cnt = (const unsigned*)(F_WS + WS_CTL) + CW_CNT; int acc = 0;
        for (int e = 0; e < 8; ++e) { acc += ((int)__hip_atomic_load(cnt + 64 * e, __ATOMIC_RELAXED, __HIP_MEMORY_SCOPE_AGENT) + 255) >> 8; tend[e] = acc; } }
    __syncthreads();
}
__device__ __forceinline__ void moe_gather_phase(const Frame& F, const unsigned char* __restrict__ H2, unsigned char* __restrict__ XG) {
    PHASE_IDS;
    volatile LAS int* tend = (volatile LAS int*)(F.lds + MISC_OFF + 64);
    volatile LAS int* hist = (volatile LAS int*)(F.lds + 0); volatile LAS int* lbase = (volatile LAS int*)(F.lds + 64); volatile LAS int* dl = (volatile LAS int*)(F.lds + 128);
    moe_tile_table(F, tend);
    const int* e12 = (const int*)(F_WS + WS_E12); int* dest = (int*)(F_WS + WS_DEST); unsigned* cur = (unsigned*)(F_WS + WS_CTL) + CW_CUR;
    for (int blk = F.c; blk < MLAT / 128; blk += F.G) {
        if (tid < 8) hist[tid] = 0;
        __syncthreads();
        int e1 = 0, e2 = 0, r1 = 0, r2 = 0; const int tok = blk * 128 + tid;
        if (tid < 128) { const int w = e12[tok]; e1 = w & 255; e2 = (w >> 8) & 255; r1 = atomicAdd((int*)&hist[e1], 1); r2 = atomicAdd((int*)&hist[e2], 1); }
        __syncthreads();
        if (tid < 8) { const int base = (int)atomicAdd(cur + 64 * tid, (unsigned)hist[tid]); lbase[tid] = (tid == 0 ? 0 : tend[tid - 1]) * 256 + base; }
        __syncthreads();
        if (tid < 128) { const int d1 = lbase[e1] + r1, d2 = lbase[e2] + r2; dest[2 * tok] = d1; dest[2 * tok + 1] = d2; dl[2 * tid] = d1; dl[2 * tid + 1] = d2; }
        __syncthreads();
        for (int a = wave; a < 256; a += NWAVES) { const int d = dl[a]; const unsigned char* src = H2 + (size_t)(blk * 128 + (a >> 1)) * DM; unsigned char* dst = XG + (size_t)d * DM;
            *(u32x4*)(dst + 16 * lane) = *(const u32x4*)(src + 16 * lane); }
        __syncthreads();
    }
}

constexpr int PH_PRO0 = 0, PH_PRO1 = 1, PH_L0 = 2;
constexpr int LP_NORM = 0, LP_IN1 = 1, LP_CONV = 2, LP_GATE0 = 3, LP_SCANA0 = 4, LP_SCANB0 = 5, LP_GATE1 = 6, LP_SCANA1 = 7, LP_SCANB1 = 8, LP_MID = 9, LP_ATTN = 10,
              LP_GT = 11, LP_OUT1 = 12, LP_OUT2 = 13, LP_RES1 = 14, LP_F0 = 15;
constexpr int L0_NPH = 18;
constexpr int PH_L1 = PH_L0 + L0_NPH;
constexpr int L1_NPH = 15 + 1 + 10 + 1;
constexpr int NPHASES = PH_L1 + L1_NPH;

#ifdef PH_ONLY
#define IN(k) ((k) == PH_ONLY && in_range(A0, (k)))
#else
#define IN(k) in_range(A0, (k))
#endif
#define FRAME const Frame F = make_frame(A0, wave0)
__device__ __forceinline__ void grid_bar(ArgsP A0, int wave0) {
    extern __shared__ __attribute__((aligned(16))) unsigned char lds_raw[];
    XcdBarrier b; b.bar = bar_words(launder(A0)->ws); b.x = xb_xcc_id(); b.st = (volatile LAS unsigned*)((LAS unsigned char*)lds_raw + MISC_OFF); b.wave = wave0;
    xcd_barrier(b);
}
#define SEAM(k) do { if (!MK_PER_PHASE && IN((k) + 1)) { grid_bar(A0, wave0); } } while (0)
#define DYNP(off) ((bf16_t*)(F_WS + WS_DYN + (off)))

template <int L> __device__ __forceinline__ void layer_phases(ArgsP A0, const int wave0) {
    constexpr int P = L == 0 ? PH_L0 : PH_L1;
    constexpr size_t WL = WS_WTS + L * WTS_LSTRIDE;
    constexpr int nrows = L == 0 ? MTOT : MLAT, nmt = nrows / 256;
#define X1 ((bf16_t*)F_OUT)
#define X2 ((bf16_t*)F_OUT + (size_t)MLAT * DM)
#define X3 DYNP(D_HF)
#define XCTX (L == 0 ? F_IN(I_CTX) : (const float*)(F_WS + WS_XC))
#define XCOUT ((float*)(F_WS + WS_XC))

    if (IN(P + LP_NORM)) { FRAME;
        if constexpr (L == 0) norm1_phase<false>(F, L, F_IN(I_X), XCTX, DYNP(D_H), (unsigned char*)DYNP(D_H8), MTOT);
        else norm1_phase<true>(F, L, X2, XCTX, DYNP(D_H), (unsigned char*)DYNP(D_H8), MTOT);
        SEAM(P + LP_NORM); }
    if (IN(P + LP_IN1)) { FRAME;
        pg8::GridSched S{(const char*)DYNP(D_H), (const char*)(F_WS + WL + WO_IN1), MTOT / 256, 15, 16, DM, DM, F.G, F.c, 0, 0};
        pg8::EpiIn1 E{DYNP(D_LX), DYNP(D_LG), DYNP(D_Z2)};
        pg8::gemm_phase(F.lds, F.wave, DM, DM, S, E);
        SEAM(P + LP_IN1);
    }
    if (IN(P + LP_CONV)) { FRAME; conv_phase(F, L, DYNP(D_LX), DYNP(D_U)); mla_prep_phase(F, DYNP(D_Z2), (unsigned char*)(F_WS + WS_KR)); SEAM(P + LP_CONV); }
#pragma unroll
    for (int d = 0; d < 2; ++d) {
        const int pg = P + (d == 0 ? LP_GATE0 : LP_GATE1);
        if (IN(pg)) { FRAME;
            pg8::GateSched S{(const char*)DYNP(D_U), (const char*)(F_WS + WL + WO_GATE), MTOT / 256, F.G, F.c, d};
            pg8::EpiGates E{DYNP(D_LA), DYNP(D_GX), DYNP(D_U), F_IN(I_GAB) + (L * 2 + d) * 1024, F_IN(I_GXB) + (L * 2 + d) * 1024, (const float*)(F_WS + WS_SP8) + (L * 2 + d) * 1024};
            pg8::gemm_phase(F.lds, F.wave, DM, 128, S, E);
            SEAM(pg);
        }
        if (IN(pg + 1)) { FRAME; scan_a_phase(F, d, DYNP(D_LA), DYNP(D_GX)); SEAM(pg + 1); }
        if (IN(pg + 2)) { FRAME; if (d == 0) scan_b_phase<0>(F, DYNP(D_LA), DYNP(D_GX), DYNP(D_HF), DYNP(D_LG)); else scan_b_phase<1>(F, DYNP(D_LA), DYNP(D_GX), DYNP(D_HF), DYNP(D_LG)); SEAM(pg + 2); }
    }
    if (IN(P + LP_MID)) { FRAME;
        pool_phase(F, DYNP(D_Z2), DYNP(D_MP));
        { pg8::GridSched S{(const char*)(DYNP(D_Z2) + 1024), (const char*)(F_WS + WL + WO_UQ), nmt, 6, 6, Z2LD, QLORA, F.G, F.c, 0, 0};
          pg8::EpiQ E{(unsigned char*)DYNP(D_Q), (unsigned char*)(F_WS + WS_QC), (const float*)(F_WS + WS_RSTDQ), (const f32x2*)(F_WS + WS_ROPE)};
          pg8::gemm_phase(F.lds, F.wave, Z2LD, QLORA, S, E); }
        { pg8::GridSched S{(const char*)(DYNP(D_Z2) + 1024 + QLORA), (const char*)(F_WS + WL + WO_UKV), MTOT / 256, 4, 4, Z2LD, KVLORA, F.G, (F.c + 128) % F.G, 0, 0};
          pg8::EpiK E{(unsigned char*)DYNP(D_K), (const float*)(F_WS + WS_RSTDKV)};
          pg8::gemm_phase(F.lds, F.wave, Z2LD, KVLORA, S, E); }
        { pg8::GridSched S{(const char*)(F_WS + WL + WO_UKV + 1024 * KVLORA * 2), (const char*)(DYNP(D_Z2) + 1024 + QLORA), 4, MTOT / 256, 4, KVLORA, Z2LD, F.G, (F.c + 64) % F.G, 0, 0};
          pg8::EpiVT E{(unsigned char*)DYNP(D_V), (const float*)(F_WS + WS_RSTDKV)};
          pg8::gemm_phase(F.lds, F.wave, KVLORA, Z2LD, S, E); }
        SEAM(P + LP_MID);
    }
    if (IN(P + LP_ATTN)) { FRAME;
        const char* Qb = (const char*)DYNP(D_Q); const char* Kb = (const char*)DYNP(D_K); const char* Vb = (const char*)DYNP(D_V); char* AO = (char*)DYNP(D_AO); const char* QC = (const char*)((bf16_t*)(F_WS + WS_QC));
#pragma unroll 1
        for (int t = F.c; t < 1024 + (L == 0 ? 32 : 0); t += F.G) {
            const bool lat = t < 1024; const int cc = t & 255, bh = lat ? (t >> 8) * 8 + (cc & 7) : t - 1024, qb = cc >> 3, b = bh >> 3, h = bh & 7;
            const char* q = lat ? Qb + ((size_t)bh * SEQ + qb * 256) * DQK : QC + (size_t)bh * CTXL * DQK;
            const size_t k0 = (size_t)bh * SKV + (lat ? 0 : SEQ), kr0 = (size_t)b * SKV + (lat ? 0 : SEQ);
            char* o = AO + ((size_t)(lat ? b * SEQ + qb * 256 : MLAT + b * CTXL) * DM + h * DVH) * 2;
            att::attn_unit(q, Kb + k0 * 128, (const char*)(F_WS + WS_KR) + kr0 * 64, Vb + k0 * 128, o, lat ? SKV : CTXL, F.lds, F.wave);
        }
        __syncthreads();
        SEAM(P + LP_ATTN);
    }
    if (IN(P + LP_GT)) { FRAME;
        pg8::GridSched S{(const char*)DYNP(D_H8), (const char*)(F_WS + WL + WO_GT), nmt, 12, 8, DM / 2, DM / 2, F.G, F.c, 0, 0};
        pg8::EpiStore<1> E{DYNP(D_GT), 3072, 0, 1.f / 32.f};
        pg8::gemm_phase<pg8::EpiStore<1>, pg8::GridSched, true>(F.lds, F.wave, DM / 2, DM / 2, S, E);
        SEAM(P + LP_GT);
    }
    if (IN(P + LP_OUT1)) { FRAME;
        pg8::FatSched S{(const char*)(F_WS + WS_DYN), (const char*)(F_WS + WL), nmt, F.G, F.c};
        pg8::EpiOut1 E{DYNP(D_GT), DYNP(D_MG)};
        pg8::gemm_phase(F.lds, F.wave, DM, DM, S, E);
        SEAM(P + LP_OUT1);
    }
    if (IN(P + LP_OUT2)) { FRAME;
        pg8::GridSched S{(const char*)DYNP(D_MG), (const char*)(F_WS + WL + WO_OUT), nmt, 4, 16, DM, DM, F.G, F.c, 0, 0};
        pg8::EpiStore<0> E{DYNP(D_Y), DM, 0};
        pg8::gemm_phase(F.lds, F.wave, DM, DM, S, E);
        SEAM(P + LP_OUT2);
    }
    if constexpr (L == 0) {
        if (IN(P + LP_RES1)) { FRAME; resid1_phase<false, false, true>(F, L, F_IN(I_X), XCTX, X1, XCOUT, DYNP(D_Y), DYNP(D_H2), nrows); SEAM(P + LP_RES1); }
        if (IN(P + LP_F0)) { FRAME;
            pg8::GridSched S{(const char*)DYNP(D_H2), (const char*)(F_WS + WS_W13), nmt, 22, 16, DM, DM, F.G, F.c, 0, 0};
            pg8::EpiSwiglu8 E{(unsigned char*)DYNP(D_HID), DFF, 1.f};
            pg8::gemm_phase(F.lds, F.wave, DM, DM, S, E);
            SEAM(P + LP_F0);
        }
        if (IN(P + LP_F0 + 1)) { FRAME;
            pg8::GridSched S{(const char*)DYNP(D_HID), (const char*)(F_WS + WS_W2), nmt, 4, 22, DFF / 2, DFF / 2, F.G, F.c, 0, 0};
            pg8::EpiStoreS E{DYNP(D_F), DM, 0, 1.f / 64.f};
            pg8::gemm_phase<pg8::EpiStoreS, pg8::GridSched, true>(F.lds, F.wave, DFF / 2, DFF / 2, S, E);
            SEAM(P + LP_F0 + 1);
        }
        if (IN(P + LP_F0 + 2)) { FRAME; resid2_phase<false, true, true>(F, L, X1, XCOUT, X2, XCOUT, DYNP(D_F), nrows); SEAM(P + LP_F0 + 2); }
    } else {
        if (IN(P + LP_RES1)) { FRAME;
            resid1_phase<true, true, true>(F, L, X2, XCTX, X3, XCOUT, DYNP(D_Y), DYNP(D_H2), nrows);
            __syncthreads();
            int it0 = 0;
#pragma unroll 1
            for (int e = 0; e < NEXP; ++e) {
                wprep_fast8(F, it0, 1024, 7168, (unsigned char*)DYNP(D_WM13) + (size_t)e * 7168 * 1024, FastW13{F_IN(I_MOEW1) + (size_t)e * DM * EFF, (long)(F_IN(I_MOEW3) - F_IN(I_MOEW1)), EFF}, 32.f);
                wprep_fast8(F, it0, 3584, 1024, (unsigned char*)DYNP(D_WM2) + (size_t)e * 1024 * 3584, FastPlain{F_IN(I_MOEW2) + (size_t)e * EFF * DM, DM}, 64.f);
            }
            SEAM(P + LP_RES1);
        }
        if (IN(P + LP_F0)) { FRAME; moe_gather_phase(F, (const unsigned char*)DYNP(D_H2), (unsigned char*)DYNP(D_XG)); SEAM(P + LP_F0); }
        volatile LAS int* tend; { FRAME; tend = (volatile LAS int*)(F.lds + MISC_OFF + 64); }
#pragma unroll 1
        for (int g = 0; g < 5; ++g) {
            const int p13 = P + LP_F0 + 1 + 2 * g;
            if (!(IN(p13) || IN(p13 + 1))) continue;
            { FRAME; moe_tile_table(F, tend); }
#define TE(j) __builtin_amdgcn_readfirstlane(tend[j])
            const int ntiles = TE(7), t0 = g * 64, nM = min(64, ntiles - t0);
            if (IN(p13)) { FRAME;
                if (nM > 0) { pg8::MoeSched S{(const char*)DYNP(D_XG), (const char*)DYNP(D_WM13), {TE(0), TE(1), TE(2), TE(3), TE(4), TE(5), TE(6)}, (size_t)7168 * 1024, nM, 28, 8, DM / 2, DM / 2, F.G, F.c, t0, t0};
                    pg8::EpiSwiglu8 E{(unsigned char*)DYNP(D_HIDG), EFF};
                    pg8::gemm_phase<pg8::EpiSwiglu8, pg8::MoeSched, true>(F.lds, F.wave, DM / 2, DM / 2, S, E); }
                SEAM(p13);
            }
            if (IN(p13 + 1)) { FRAME;
                if (nM > 0) { pg8::MoeSched S{(const char*)DYNP(D_HIDG), (const char*)DYNP(D_WM2), {TE(0), TE(1), TE(2), TE(3), TE(4), TE(5), TE(6)}, (size_t)1024 * 3584, nM, 4, 28, EFF / 2, EFF / 2, F.G, F.c, t0, 0};
                    pg8::EpiStoreS E{DYNP(D_YR), DM, t0 * 256, 1.f / 64.f};
                    pg8::gemm_phase<pg8::EpiStoreS, pg8::MoeSched, true>(F.lds, F.wave, EFF / 2, EFF / 2, S, E); }
                SEAM(p13 + 1);
            }
        }
        if (IN(P + LP_F0 + 11)) { FRAME; resid2_phase<true, true, false>(F, L, X3, XCOUT, F_OUT, XCOUT, DYNP(D_YR), nrows); }
    }
#undef X1
#undef X2
#undef X3
#undef XCTX
#undef XCOUT
}

__global__ void __launch_bounds__(NTHR, 2) mega_fwd(Args args) {
    ArgsP A0 = (ArgsP)__builtin_amdgcn_kernarg_segment_ptr();
    (void)args;
    const int wave0 = __builtin_amdgcn_readfirstlane((int)threadIdx.x >> 6);
    { FRAME;
      volatile LAS unsigned* MISC = (volatile LAS unsigned*)(F.lds + MISC_OFF);
      const int tid0 = fresh_tid(F.wave); for (int u = tid0; u < (LDS_BYTES - MISC_OFF) / 4; u += NTHR) MISC[u] = 0u;
      __syncthreads();
      if (!MK_PER_PHASE) (void)xcd_barrier_post(bar_words(F_WS), MISC, F.wave);
    }

    if (IN(PH_PRO0)) { FRAME;
        mod_partials(F);
        rope_and_consts(F);
        int it0 = 0;
#pragma unroll 1
        for (int l = 0; l < 2; ++l) {
            unsigned char* wl = F_WS + WS_WTS + l * WTS_LSTRIDE;
            wprep_fast(F, it0, 1024, 3840, (bf16_t*)(wl + WO_IN1), FastIn1{F_IN(I_WIN) + (size_t)l * DM * INCOLS, INCOLS});
            wprep_fast8(F, it0, 1024, 3072, (unsigned char*)(wl + WO_GT), FastPlain{F_IN(I_WIN) + (size_t)l * DM * INCOLS + 3776, INCOLS}, 32.f);
#pragma unroll 1
            for (int nb = 0; nb < 8; ++nb)
                wprep_job(F, it0, 128, 512, (bf16_t*)(wl + WO_GATE) + (size_t)nb * 512 * 128, SrcGate{F_IN(I_GAW) + (size_t)l * 2 * 8 * 128 * 128, (long)(F_IN(I_GXW) - F_IN(I_GAW)), nb});
            wprep_job(F, it0, 1024, 1024, (bf16_t*)(wl + WO_LRU), SrcPlainS{F_IN(I_LRUPROJ) + (size_t)l * DM * DM, DM, ((ABL & 2) && ((ABL_L >> l) & 1)) ? 0.f : 1.f});
            wprep_job(F, it0, 384, 1536, (bf16_t*)(wl + WO_UQ), SrcUQ{F_IN(I_WUQ) + (size_t)l * 384 * 1536, F_IN(I_QNORMG) + l * 384});
            wprep_job(F, it0, 256, 2048, (bf16_t*)(wl + WO_UKV), SrcUKV{F_IN(I_WUKV) + (size_t)l * 256 * 2048, F_IN(I_KVNORMG) + l * 256});
            wprep_job(F, it0, 1024, 1024, (bf16_t*)(wl + WO_MLA), SrcPlainS{F_IN(I_MLAPROJ) + (size_t)l * DM * DM, DM, ((ABL & 4) && ((ABL_L >> l) & 1)) ? 0.f : 1.f});
            wprep_fast(F, it0, 1024, 1024, (bf16_t*)(wl + WO_OUT), FastPlain{F_IN(I_WOUT) + (size_t)l * DM * DM, DM});
        }
        wprep_fast(F, it0, 1024, 5632, (bf16_t*)(F_WS + WS_W13), FastW13{F_IN(I_FFNW1), (long)(F_IN(I_FFNW3) - F_IN(I_FFNW1)), DFF});
        wprep_fast8(F, it0, 2816, 1024, (unsigned char*)(F_WS + WS_W2), FastPlain{F_IN(I_FFNW2), DM}, 64.f);
        SEAM(PH_PRO0);
    }
    if (IN(PH_PRO1)) { FRAME;
        mod_reduce(F);
        pool_weights_phase(F);
        SEAM(PH_PRO1);
    }
    layer_phases<0>(A0, wave0);
    layer_phases<1>(A0, wave0);
}
#undef IN
#undef SEAM

extern "C" void kernel_launch(void* const* d_in, const int* in_sizes, int n_in, void* d_out, int out_size, void* d_ws, size_t ws_size, hipStream_t stream) {
    static int grid = 0;
    if (grid == 0) {
        if (n_in != 35 || out_size != MLAT * DM || ws_size < WS_END) { fprintf(stderr, "kernel_launch: unexpected shapes (n_in %d, out %d, ws %zu < %zu)\n", n_in, out_size, ws_size, (size_t)WS_END); grid = -1; return; }
        int dev = 0, cus = 0;
        if (hipGetDevice(&dev) != hipSuccess || hipDeviceGetAttribute(&cus, hipDeviceAttributeMultiprocessorCount, dev) != hipSuccess) { grid = -1; return; }
        if (hipFuncSetAttribute((const void*)mega_fwd, hipFuncAttributeMaxDynamicSharedMemorySize, LDS_BYTES) != hipSuccess) { fprintf(stderr, "kernel_launch: hipFuncSetAttribute failed\n"); grid = -1; return; }
        int per_cu = 0;
        if (hipOccupancyMaxActiveBlocksPerMultiprocessor(&per_cu, (const void*)mega_fwd, NTHR, LDS_BYTES) != hipSuccess || per_cu < 1) { fprintf(stderr, "kernel_launch: occupancy query says %d\n", per_cu); }
        (void)hipGetLastError();
        grid = cus;
    }
    if (grid < 0) return;
    (void)hipMemsetAsync((char*)d_ws + WS_CTL, 0, CTL_BYTES, stream);
    Args a{};
    for (int i = 0; i < 35; ++i) a.in[i] = (const float*)d_in[i];
    a.out = (float*)d_out; a.ws = (unsigned char*)d_ws;
#if MK_PER_PHASE
    for (int p = 0; p < NPHASES; ++p) { a.ph_lo = p; a.ph_hi = p + 1; hipLaunchKernelGGL(mega_fwd, dim3(grid), dim3(NTHR), LDS_BYTES, stream, a); }
#else
    a.ph_lo = 0; a.ph_hi = NPHASES;
    hipLaunchKernelGGL(mega_fwd, dim3(grid), dim3(NTHR), LDS_BYTES, stream, a);
#endif
}
```

```cpp
#include <hip/hip_runtime.h>
#include <stdint.h>
#include <stdio.h>

#ifndef ABL
#define ABL 0
#endif
#ifndef ABL_L
#define ABL_L 3
#endif
#ifndef MK_PER_PHASE
#define MK_PER_PHASE 0
#endif

#define LAS __attribute__((address_space(3)))
typedef unsigned short bf16_t;
typedef short bf16x8 __attribute__((ext_vector_type(8)));
typedef short s16x4 __attribute__((ext_vector_type(4)));
typedef float f32x4 __attribute__((ext_vector_type(4)));
typedef float f32x2 __attribute__((ext_vector_type(2)));
typedef float f32x16 __attribute__((ext_vector_type(16)));
typedef unsigned u32x4 __attribute__((ext_vector_type(4)));
typedef unsigned u32x2 __attribute__((ext_vector_type(2)));

constexpr int DM = 1024, NB = 4, SEQ = 8192, CTXL = 256, MLAT = NB * SEQ, MCTX = NB * CTXL, MTOT = MLAT + MCTX;
constexpr int INCOLS = 6848, NH = 8, DQK = 192, DVH = 128, SKV = SEQ + CTXL;
constexpr int QLORA = 384, KVLORA = 256, DFF = 2816, NEXP = 8, EFF = 3584;
constexpr float RMS_EPS = 1e-6f;
constexpr int Z2LD = 1792;
constexpr int NCHUNK = SKV / 64;

constexpr size_t MiB = 1u << 20;
constexpr size_t WS_CTL = 0, CTL_BYTES = 1 * MiB;
constexpr size_t WS_MVEC = 1 * MiB;
constexpr size_t WS_MPART = 2 * MiB;
constexpr size_t WS_KR = 2 * MiB;
constexpr size_t WS_ROPE = 10 * MiB;
constexpr size_t WS_SP8 = 12 * MiB + 512 * 1024;
constexpr size_t WS_RSTDQ = 13 * MiB, WS_RSTDKV = 13 * MiB + 256 * 1024;
constexpr size_t WS_SUMA = 14 * MiB, WS_SUMB = 16 * MiB + 512 * 1024;
constexpr size_t WS_E12 = 19 * MiB, WS_G1 = 19 * MiB + 128 * 1024, WS_DEST = 19 * MiB + 256 * 1024;
constexpr size_t WS_XC = 20 * MiB;
constexpr size_t WS_WTS = 25 * MiB, WTS_LSTRIDE = 25 * MiB;
constexpr size_t WO_IN1 = 0, WO_GT = 7 * MiB + 512 * 1024, WO_POOL = 13 * MiB + 512 * 1024, WO_GATE = 15 * MiB + 512 * 1024, WO_LRU = 16 * MiB + 512 * 1024,
                 WO_UQ = 18 * MiB + 512 * 1024, WO_UKV = 19 * MiB + 640 * 1024, WO_MLA = 20 * MiB + 640 * 1024, WO_OUT = 22 * MiB + 640 * 1024;
constexpr size_t WS_W13 = 75 * MiB, WS_W2 = 86 * MiB, WS_PPT = 91 * MiB + 512 * 1024  , WS_PWS = 95 * MiB + 512 * 1024  ;
constexpr size_t WS_DYN = 97 * MiB;
constexpr size_t SLAB = 66 * MiB;
constexpr size_t HM = 512 * 1024;
constexpr size_t D_H8 = 0  , D_H = 33 * MiB, D_Z2 = 99 * MiB, D_LX = 214 * MiB + HM, D_LA = 214 * MiB + HM, D_LG = 280 * MiB + HM, D_U = 346 * MiB + HM, D_GX = 412 * MiB + HM, D_HF = 478 * MiB + HM;
constexpr size_t D_MP = 33 * MiB, D_K = 214 * MiB + HM, D_V = 280 * MiB + HM, D_Q = 346 * MiB + HM  , D_AO = 99 * MiB;
constexpr size_t D_GT = 214 * MiB + HM, D_MG = 412 * MiB + HM, D_Y = 214 * MiB + HM, D_H2 = 280 * MiB + HM, D_HID = 0, D_F = 346 * MiB + HM;
constexpr size_t D_WM13 = 0, D_WM2 = 56 * MiB, D_XG = 84 * MiB, D_HIDG = 150 * MiB, D_YR = 346 * MiB + HM;
constexpr size_t WS_QC = 6 * MiB + HM;
constexpr size_t WS_END = WS_DYN + 544 * MiB + HM;
constexpr int CW_BAR = 4096, CW_CNT = 8192, CW_CUR = 8192 + 512;

constexpr int STAGE_BYTES = 131072, MISC_OFF = STAGE_BYTES, LDS_BYTES = STAGE_BYTES + 1024;
constexpr int NWAVES = 8, NTHR = 512;

#define LDS_WAIT() asm volatile("s_waitcnt lgkmcnt(0)" ::: "memory")
#define VM_WAIT() asm volatile("s_waitcnt vmcnt(0)" ::: "memory")
typedef __bf16 bf16x2_t __attribute__((ext_vector_type(2)));
__device__ __forceinline__ unsigned cvtpk(float lo, float hi) { const f32x2 v = {lo, hi}; return __builtin_bit_cast(unsigned, __builtin_convertvector(v, bf16x2_t)); }
__device__ __forceinline__ float bf_lo(unsigned w) { return __uint_as_float(w << 16); }
__device__ __forceinline__ float bf_hi(unsigned w) { return __uint_as_float(w & 0xffff0000u); }
__device__ __forceinline__ float bf2f(bf16_t b) { return __uint_as_float(((unsigned)b) << 16); }
__device__ __forceinline__ float wave_sum(float v) {
#pragma unroll
    for (int o = 1; o < 64; o <<= 1) v += __shfl_xor(v, o);
    return v;
}
__device__ __forceinline__ float sigmoidf_(float x) { return __builtin_amdgcn_rcpf(1.f + __builtin_amdgcn_exp2f(-1.4426950408889634f * x)); }

__device__ __forceinline__ int fresh_tid(int wave) { int l; asm volatile("v_mbcnt_lo_u32_b32 %0, -1, 0\n\tv_mbcnt_hi_u32_b32 %0, -1, %0" : "=v"(l)); return wave * 64 + l; }
#define XB_TMO      128
#define XB_XCNT(j)  (256  + 64 * (j))
#define XB_XSUB(j)  (1280 + 64 * (j))
#define XB_XGEN(j)  (2304 + 64 * (j))
#define XB_TOP      3328
#define XB_TOPGEN   3392
#define XCD_BAR_WORDS 3456
#define XB_SPIN_CAP (1u << 18)
__device__ __forceinline__ unsigned xb_ld(unsigned* p)              { return __hip_atomic_load(p, __ATOMIC_RELAXED, __HIP_MEMORY_SCOPE_AGENT); }
__device__ __forceinline__ unsigned xb_add(unsigned* p, unsigned v) { return __hip_atomic_fetch_add(p, v, __ATOMIC_RELAXED, __HIP_MEMORY_SCOPE_AGENT); }
__device__ __forceinline__ unsigned xb_xcc_id() { return (unsigned)__builtin_amdgcn_s_getreg((3 << 11) | 20) & 0xFu; }
#define XB_SPIN(cond, bar) do { unsigned _sp = 0; while (cond) { __builtin_amdgcn_s_sleep(1); \
    if ((++_sp & 255u) == 0u) { if (xb_ld(&(bar)[XB_TMO])) break; if (_sp > XB_SPIN_CAP) { atomicAdd(&(bar)[XB_TMO], 1u); break; } } } } while (0)
struct XcdBarrier { unsigned* bar; unsigned x; volatile LAS unsigned* st; int wave; };
__device__ __forceinline__ XcdBarrier xcd_barrier_post(unsigned* bar, volatile LAS unsigned* st, int wave) {
    XcdBarrier b; b.bar = bar; b.x = xb_xcc_id(); b.st = st; b.wave = wave;
    if (fresh_tid(wave) == 0) (void)xb_add(&bar[XB_XCNT(b.x)], 1u);
    return b;
}
__device__ __forceinline__ void xcd_barrier_complete(unsigned* bar, unsigned x, unsigned& nloc, unsigned& nx) {
    const unsigned G = gridDim.x * gridDim.y * gridDim.z;
    unsigned sum, cnt, mine, sp = 0u;
    for (;;) {
        sum = 0u; cnt = 0u; mine = 0u;
#pragma unroll
        for (unsigned j = 0; j < 16; ++j) { const unsigned c = xb_ld(&bar[XB_XCNT(j)]); sum += c; cnt += (c > 0u) ? 1u : 0u; mine = (j == x) ? c : mine; }
        if (sum == G) break;
        __builtin_amdgcn_s_sleep(1);
        if ((++sp & 255u) == 0u) { if (xb_ld(&bar[XB_TMO])) break; if (sp > XB_SPIN_CAP) { atomicAdd(&bar[XB_TMO], 1u); break; } }
    }
    nloc = mine > 0u ? mine : 1u; nx = cnt > 0u ? cnt : 1u;
}
__device__ __forceinline__ void xcd_barrier(const XcdBarrier& b) {
    asm volatile("s_waitcnt vmcnt(0)" ::: "memory");
    __syncthreads();
    if (fresh_tid(b.wave) == 0) {
        unsigned* bar = b.bar;
        __builtin_amdgcn_s_waitcnt(0);
        unsigned nloc = b.st[0], nx = b.st[1];
        if (nloc == 0u) { xcd_barrier_complete(bar, b.x, nloc, nx); b.st[0] = nloc; b.st[1] = nx; }
        const unsigned old = xb_add(&bar[XB_XSUB(b.x)], 1u);
        const unsigned gen = old / nloc;
        if (old + 1u == (gen + 1u) * nloc) {
            __builtin_amdgcn_fence(__ATOMIC_RELEASE, "agent");
            asm volatile("s_waitcnt vmcnt(0)" ::: "memory");
            const unsigned og = xb_add(&bar[XB_TOP], 1u);
            const unsigned tg = og / nx;
            if (og + 1u == (tg + 1u) * nx) xb_add(&bar[XB_TOPGEN], 1u);
            else XB_SPIN(xb_ld(&bar[XB_TOPGEN]) == tg, bar);
            __builtin_amdgcn_fence(__ATOMIC_ACQUIRE, "agent");
            xb_add(&bar[XB_XGEN(b.x)], 1u);
            asm volatile("s_waitcnt vmcnt(0)" ::: "memory");
        } else {
            XB_SPIN(xb_ld(&bar[XB_XGEN(b.x)]) == gen, bar);
            __builtin_amdgcn_fence(__ATOMIC_ACQUIRE, "agent");
            asm volatile("s_waitcnt vmcnt(0)" ::: "memory");
        }
    }
    __syncthreads();
}

__device__ __forceinline__ unsigned* bar_words(unsigned char* ws) { return (unsigned*)(ws + WS_CTL) + CW_BAR; }
namespace pg8 {
constexpr int BM = 256, BK = 64, HALF = 128, HTB = HALF * BK * 2, NXCD = 8, WGM = 8;
__host__ __device__ __forceinline__ int lds_byte(int r, int c) { const int st = (r >> 4) * 2 + (c >> 5), rr = r & 15, cc = c & 31, ob = rr * 64 + cc * 2; return st * 1024 + (ob ^ (((ob >> 9) & 1) << 5)); }
__host__ __device__ __forceinline__ void stage_rc(int b, int& R, int& C) { const int st = b / 1024, sb = b % 1024, swz = sb ^ (((sb >> 9) & 1) << 5); R = (st >> 1) * 16 + swz / 64; C = (st & 1) * 32 + (swz % 64) / 2; }
__host__ __device__ __forceinline__ int perm32(int rho) { const int n = rho >> 4, i = rho & 15; return 8 * (i >> 2) + 4 * n + (i & 3); }

typedef int i32x8 __attribute__((ext_vector_type(8)));
__device__ __forceinline__ i32x8 cat8(const bf16x8 lo, const bf16x8 hi) { const u32x4 a = __builtin_bit_cast(u32x4, lo), b = __builtin_bit_cast(u32x4, hi); return (i32x8){(int)a.x, (int)a.y, (int)a.z, (int)a.w, (int)b.x, (int)b.y, (int)b.z, (int)b.w}; }
__device__ __forceinline__ const char* uptr(const char* p) {
    const unsigned long long v = (unsigned long long)p; const unsigned lo = __builtin_amdgcn_readfirstlane((unsigned)v), hi = __builtin_amdgcn_readfirstlane((unsigned)(v >> 32));
    return (const char*)(((unsigned long long)hi << 32) | lo); }
template <bool FP8> struct Frag;
template <> struct Frag<false> { bf16x8 k[2]; };
template <> struct Frag<true> { i32x8 v; };
struct Unit { const char* a; const char* b; int nt; int pm, pn, aux; };

__device__ __forceinline__ void tile_of(int wgid, int nM, int nN, int& pm, int& pn) {
    const int nwg = nM * nN; { const int q = nwg / NXCD, r = nwg % NXCD, xcd = wgid % NXCD, off = wgid / NXCD; wgid = (xcd < r ? xcd * (q + 1) : r * (q + 1) + (xcd - r) * q) + off; }
    const int nig = WGM * nN, gid = wgid / nig, fm = gid * WGM, gsz = (nM - fm) < WGM ? (nM - fm) : WGM;
    pm = fm + ((wgid % nig) % gsz); pn = (wgid % nig) / gsz;
}

template <class Epi, class Sched, bool FP8 = false>
__device__ __forceinline__ void gemm_phase(LAS unsigned char* lds, const int wid, const int lda, const int ldb, const Sched& S, const Epi& E) {
    const int tid = fresh_tid(wid), lane = tid & 63, wr = wid >> 2, wc = wid & 3, fr = lane & 15, fq = lane >> 4;
    unsigned voffA[2], voffB[2];
#pragma unroll
    for (int i = 0; i < 2; ++i) { int R, C; stage_rc(tid * 16 + i * 8192, R, C); const int Rb = (R & ~31) + perm32(R & 31);
        voffA[i] = (unsigned)(R * lda + C) * 2u; voffB[i] = (unsigned)(Rb * ldb + C) * 2u; }
    const size_t kstep = (size_t)(BK * 2);
    const size_t hstepA = (size_t)HALF * lda * 2, hstepB = (size_t)HALF * ldb * 2;
    const unsigned ldsw = (unsigned)wid * 1024u;
    const int aoff = FP8 ? lds_byte(wr * 64 + fr, fq * 16) : lds_byte(wr * 64 + fr, fq * 8), boff = FP8 ? lds_byte(wc * 32 + fr, fq * 16) : lds_byte(wc * 32 + fr, fq * 8);
#define PG8_SA(b, h) (((b) * 2 + (h)) * HTB)
#define PG8_SB(b, h) ((4 + (b) * 2 + (h)) * HTB)
#define PG8_STAGE(bufoff, gbase, voff) do { _Pragma("unroll") for (int _i = 0; _i < 2; ++_i) \
        __builtin_amdgcn_global_load_lds((const unsigned*)((const char*)(gbase) + (voff)[_i]), (LAS unsigned*)(lds + (bufoff) + ldsw + _i * 8192), 16, 0, 0); } while (0)
#define PG8_LDA(dst, b, h) do { if constexpr (FP8) { _Pragma("unroll") for (int m = 0; m < 4; ++m) dst##8[m] = cat8(*(const LAS bf16x8*)(lds + PG8_SA(b, h) + aoff + m * 2048), *(const LAS bf16x8*)(lds + PG8_SA(b, h) + aoff + m * 2048 + 16)); } \
        else { _Pragma("unroll") for (int m = 0; m < 4; ++m) _Pragma("unroll") for (int k = 0; k < 2; ++k) dst[m][k] = *(const LAS bf16x8*)(lds + PG8_SA(b, h) + aoff + m * 2048 + k * 1024); } } while (0)
#define PG8_LDB(dst, b, h) do { if constexpr (FP8) { _Pragma("unroll") for (int n = 0; n < 2; ++n) dst##8[n] = cat8(*(const LAS bf16x8*)(lds + PG8_SB(b, h) + boff + n * 2048), *(const LAS bf16x8*)(lds + PG8_SB(b, h) + boff + n * 2048 + 16)); } \
        else { _Pragma("unroll") for (int n = 0; n < 2; ++n) _Pragma("unroll") for (int k = 0; k < 2; ++k) dst[n][k] = *(const LAS bf16x8*)(lds + PG8_SB(b, h) + boff + n * 2048 + k * 1024); } } while (0)
#define PG8_MMA(ai, bj, At, Bt) do { __builtin_amdgcn_s_setprio(1); if constexpr (FP8) { _Pragma("unroll") for (int m = 0; m < 4; ++m) _Pragma("unroll") for (int n = 0; n < 2; ++n) \
        asm volatile("v_mfma_scale_f32_16x16x128_f8f6f4 %0, %1, %2, %0, %3, %3 op_sel_hi:[0,0,0]" : "+v"(acc[ai][bj][m][n]) : "v"(Bt##8[n]), "v"(At##8[m]), "v"(one8)); } \
        else { _Pragma("unroll") for (int m = 0; m < 4; ++m) _Pragma("unroll") for (int n = 0; n < 2; ++n) _Pragma("unroll") for (int k = 0; k < 2; ++k) \
        acc[ai][bj][m][n] = __builtin_amdgcn_mfma_f32_16x16x32_bf16(Bt[n][k], At[m][k], acc[ai][bj][m][n], 0, 0, 0); } __builtin_amdgcn_s_setprio(0); } while (0)
#define PG8_WAIT_V(n) asm volatile("s_waitcnt vmcnt(" #n ")" ::: "memory")
#define PG8_WAIT_L(n) asm volatile("s_waitcnt lgkmcnt(" #n ")" ::: "memory")
#define PG8_BAR __builtin_amdgcn_s_barrier()
#define PG8_SCHED __builtin_amdgcn_sched_barrier(0)
    Unit cur, nxt; int ui = 0;
    if (!S.next(0, cur)) return;
    f32x4 acc[2][2][4][2];
#pragma unroll
    for (int a = 0; a < 2; ++a)
#pragma unroll
        for (int b = 0; b < 2; ++b)
#pragma unroll
            for (int m = 0; m < 4; ++m)
#pragma unroll
                for (int n = 0; n < 2; ++n) acc[a][b][m][n] = (f32x4){0.f, 0.f, 0.f, 0.f};
    bf16x8 At[4][2], B0[2][2], B1[2][2]; i32x8 At8[4], B08[2], B18[2];
    const int one8 = 0x7f7f7f7f;
    const char* cA = FP8 ? uptr(cur.a) : cur.a; const char* cB = FP8 ? uptr(cur.b) : cur.b;
    PG8_STAGE(PG8_SB(0, 0), cB, voffB); PG8_STAGE(PG8_SB(0, 1), cB + hstepB, voffB); PG8_STAGE(PG8_SA(0, 0), cA, voffA); PG8_STAGE(PG8_SA(0, 1), cA + hstepA, voffA);
    if (wr == 1) PG8_BAR;
    PG8_WAIT_V(2); PG8_BAR;
    PG8_STAGE(PG8_SB(1, 0), cB + kstep, voffB); PG8_STAGE(PG8_SA(1, 0), cA + kstep, voffA); PG8_STAGE(PG8_SB(1, 1), cB + hstepB + kstep, voffB);
    PG8_WAIT_V(6); PG8_BAR;
    for (;;) {
        const bool has_next = S.next(ui + 1, nxt);
        const char* nA = has_next ? nxt.a : cA; const char* nB = has_next ? nxt.b : cB; if constexpr (FP8) { nA = uptr(nA); nB = uptr(nB); }
        const int nt = cur.nt;
        for (int t = 0; t < nt; t += 2) {
            const bool last = (t == nt - 2);
            const char* a1 = cA + (size_t)(t + 1) * kstep;
            const char* a2 = last ? nA : cA + (size_t)(t + 2) * kstep; const char* b2 = last ? nB : cB + (size_t)(t + 2) * kstep;
            const char* a3 = a2 + kstep; const char* b3 = b2 + kstep;
            PG8_LDB(B0, 0, 0); PG8_LDB(B1, 0, 1); PG8_SCHED; PG8_LDA(At, 0, 0); PG8_STAGE(PG8_SA(1, 1), a1 + hstepA, voffA);
            PG8_WAIT_V(8); PG8_WAIT_L(0); PG8_BAR; PG8_MMA(0, 0, At, B0); PG8_MMA(0, 1, At, B1); PG8_BAR; PG8_SCHED;
            PG8_LDA(At, 0, 1); PG8_STAGE(PG8_SB(0, 0), b2, voffB); PG8_STAGE(PG8_SB(0, 1), b2 + hstepB, voffB); PG8_STAGE(PG8_SA(0, 0), a2, voffA);
            PG8_WAIT_V(8); PG8_WAIT_L(0); PG8_BAR; PG8_MMA(1, 0, At, B0); PG8_MMA(1, 1, At, B1); PG8_BAR; PG8_SCHED;
            PG8_LDB(B0, 1, 0); PG8_LDB(B1, 1, 1); PG8_SCHED; PG8_LDA(At, 1, 0); PG8_STAGE(PG8_SA(0, 1), a2 + hstepA, voffA);
            PG8_WAIT_V(8); PG8_WAIT_L(0); PG8_BAR; PG8_MMA(0, 0, At, B0); PG8_MMA(0, 1, At, B1); PG8_BAR; PG8_SCHED;
            PG8_LDA(At, 1, 1); PG8_STAGE(PG8_SB(1, 0), b3, voffB); PG8_STAGE(PG8_SB(1, 1), b3 + hstepB, voffB); PG8_STAGE(PG8_SA(1, 0), a3, voffA);
            PG8_WAIT_V(8); PG8_WAIT_L(0); PG8_BAR; PG8_MMA(1, 0, At, B0); PG8_MMA(1, 1, At, B1); PG8_BAR; PG8_SCHED;
        }
        if (wr == 0) PG8_BAR;
        if constexpr (FP8) asm volatile("s_nop 7\n\ts_nop 7\n\ts_nop 7" ::: "memory");
        const bool keep = E(acc, cur, wr, wc, fr, fq);
        if (!has_next) break;
        if (!keep) {
#pragma unroll
        for (int a = 0; a < 2; ++a)
#pragma unroll
            for (int b = 0; b < 2; ++b)
#pragma unroll
                for (int m = 0; m < 4; ++m)
#pragma unroll
                    for (int n = 0; n < 2; ++n) acc[a][b][m][n] = (f32x4){0.f, 0.f, 0.f, 0.f};
        }
        cur = nxt; cA = nA; cB = nB; ++ui;
        if (wr == 1) PG8_BAR;
    }
    PG8_WAIT_V(0);
    PG8_BAR;
#undef PG8_SA
#undef PG8_SB
#undef PG8_STAGE
#undef PG8_LDA
#undef PG8_LDB
#undef PG8_MMA
#undef PG8_WAIT_V
#undef PG8_WAIT_L
#undef PG8_BAR
#undef PG8_SCHED
}

struct GridSched {
    const char* A; const char* B; int nM, nN, nt, lda, ldb, G, c, pm0, aux;
    __device__ __forceinline__ bool next(int i, Unit& u) const {
        const int L = __builtin_amdgcn_readfirstlane(i * G + c); if (L >= nM * nN) return false;
        int pm, pn; tile_of(L, nM, nN, pm, pn);
        u.pm = pm0 + pm; u.pn = pn; u.aux = aux; u.nt = nt;
        u.a = A + (size_t)(pm0 + pm) * 256 * lda * 2; u.b = B + (size_t)pn * 256 * ldb * 2; return true;
    }
};
struct GateSched {
    const char* U; const char* W; int nM, G, c, dir;
    __device__ __forceinline__ bool next(int i, Unit& u) const {
        const int L = __builtin_amdgcn_readfirstlane(i * G + c); if (L >= nM * 8) return false;
        int pm, pn; tile_of(L, nM, 8, pm, pn);
        u.pm = pm; u.pn = pn; u.aux = dir; u.nt = 2;
        u.a = U + (size_t)pm * 256 * DM * 2 + (size_t)pn * 128 * 2; u.b = W + ((size_t)pn * 512 + (size_t)dir * 256) * 128 * 2; return true;
    }
};
struct FatSched {
    const char* dyn; const char* wl; int nM, G, c;
    __device__ __forceinline__ bool next(int i, Unit& u) const {
        const int seg = i % 3, L = __builtin_amdgcn_readfirstlane((i / 3) * G + c); if (L >= nM * 4) return false;
        int pm, pn; tile_of(L, nM, 4, pm, pn);
        u.pm = pm; u.pn = pn; u.aux = seg; u.nt = 16;
        const size_t oa = seg == 0 ? D_MP : (seg == 1 ? D_HF : D_AO), ob = seg == 0 ? WO_POOL : (seg == 1 ? WO_LRU : WO_MLA);
        u.a = dyn + oa + (size_t)pm * 256 * DM * 2; u.b = wl + ob + (size_t)pn * 256 * DM * 2; return true;
    }
};
struct MoeSched {
    const char* A; const char* B; int te[7]; size_t estride; int nM, nN, nt, lda, ldb, G, c, t0, arow0;
    __device__ __forceinline__ bool next(int i, Unit& u) const {
        const int L = __builtin_amdgcn_readfirstlane(i * G + c); if (L >= nM * nN) return false;
        int pm, pn; tile_of(L, nM, nN, pm, pn);
        const int tg = t0 + pm; int e = 0;
#pragma unroll
        for (int j = 0; j < 7; ++j) e += (tg >= te[j]) ? 1 : 0;
        u.pm = pm; u.pn = pn; u.aux = e; u.nt = nt;
        u.a = A + (size_t)(arow0 + pm) * 256 * lda * 2; u.b = B + (size_t)e * estride + (size_t)pn * 256 * ldb * 2; return true;
    }
};
struct PoolSched { const char* A; const char* B; int G, c;
    __device__ __forceinline__ bool next(int i, Unit& u) const { const int L = __builtin_amdgcn_readfirstlane(i * G + c); if (L >= 32) return false; const int l = L >> 4; u.pm = L & 3; u.pn = (L >> 2) & 3; u.aux = l; u.nt = 4;
        u.a = A + (size_t)l * DM * DM * 2 + (size_t)u.pm * 256 * DM * 2 + (size_t)u.pn * 256 * 2; u.b = B + ((size_t)l * 4 + u.pn) * 65536 * 2; return true; } };
__device__ __forceinline__ u32x4 pack8(const f32x4 v0, const f32x4 v1) { u32x4 w; w.x = cvtpk(v0[0], v0[1]); w.y = cvtpk(v0[2], v0[3]); w.z = cvtpk(v1[0], v1[1]); w.w = cvtpk(v1[2], v1[3]); return w; }
__device__ __forceinline__ void unpack8(const u32x4 w, f32x4& v0, f32x4& v1) { v0 = (f32x4){bf_lo(w.x), bf_hi(w.x), bf_lo(w.y), bf_hi(w.y)}; v1 = (f32x4){bf_lo(w.z), bf_hi(w.z), bf_lo(w.w), bf_hi(w.w)}; }
template <int ACT>
__device__ __forceinline__ void store_tile(const f32x4 (&acc)[2][2][4][2], bf16_t* base, int ldc, int row0, int col0, int wr, int wc, int fr, int fq, const float scale = 1.f) {
#pragma unroll
    for (int ai = 0; ai < 2; ++ai)
#pragma unroll
        for (int m = 0; m < 4; ++m) { bf16_t* rowp = base + (size_t)(row0 + ai * HALF + wr * 64 + m * 16 + fr) * ldc + col0 + wc * 32 + 8 * fq;
#pragma unroll
            for (int bj = 0; bj < 2; ++bj) { f32x4 v0 = acc[ai][bj][m][0] * scale, v1 = acc[ai][bj][m][1] * scale;
                if (ACT == 1) {
#pragma unroll
                    for (int j = 0; j < 4; ++j) { v0[j] = sigmoidf_(v0[j]); v1[j] = sigmoidf_(v1[j]); } }
                if (ACT == 2) {
#pragma unroll
                    for (int j = 0; j < 4; ++j) { v0[j] = v0[j] * sigmoidf_(1.5957691216057308f * (v0[j] + 0.044715f * v0[j] * v0[j] * v0[j])); v1[j] = v1[j] * sigmoidf_(1.5957691216057308f * (v1[j] + 0.044715f * v1[j] * v1[j] * v1[j])); } }
                *(u32x4*)(rowp + bj * HALF) = pack8(v0, v1); } }
}
struct EpiIn1 {
    bf16_t* LX; bf16_t* LG; bf16_t* Z2;
    __device__ __forceinline__ bool operator()(f32x4 (&acc)[2][2][4][2], const Unit& u, int wr, int wc, int fr, int fq) const {
        if (u.pn >= 4 && u.pn < 8) { store_tile<2>(acc, LG, DM, u.pm * 256, (u.pn - 4) * 256, wr, wc, fr, fq); return false; }
        bf16_t* base; int ldc, ct;
        if (u.pn < 4) { base = LX; ldc = DM; ct = u.pn * 256; } else { base = Z2; ldc = Z2LD; ct = (u.pn - 8) * 256; }
        store_tile<0>(acc, base, ldc, u.pm * 256, ct, wr, wc, fr, fq); return false;
    }
};
template <int ACT> struct EpiStore {
    bf16_t* O; int ldc; int rowoff; float scale = 1.f;
    __device__ __forceinline__ bool operator()(f32x4 (&acc)[2][2][4][2], const Unit& u, int wr, int wc, int fr, int fq) const {
        store_tile<ACT>(acc, O, ldc, rowoff + u.pm * 256, u.pn * 256, wr, wc, fr, fq, scale); return false;
    }
};
struct EpiPool {
    bf16_t* O;
    __device__ __forceinline__ bool operator()(f32x4 (&acc)[2][2][4][2], const Unit& u, int wr, int wc, int fr, int fq) const {
        store_tile<0>(acc, O + (size_t)u.aux * (WTS_LSTRIDE / 2), DM, u.pm * 256, u.pn * 256, wr, wc, fr, fq); return false;
    }
};
__device__ __forceinline__ u32x2 pack8_fp8(const f32x4 v0, const f32x4 v1) {
    int lo = 0, hi = 0; lo = __builtin_amdgcn_cvt_pk_fp8_f32(v0[0], v0[1], lo, false); lo = __builtin_amdgcn_cvt_pk_fp8_f32(v0[2], v0[3], lo, true);
    hi = __builtin_amdgcn_cvt_pk_fp8_f32(v1[0], v1[1], hi, false); hi = __builtin_amdgcn_cvt_pk_fp8_f32(v1[2], v1[3], hi, true); return (u32x2){(unsigned)lo, (unsigned)hi};
}
struct EpiSwiglu8 {
    unsigned char* O; int ldc; float sc = 0.03125f;
    __device__ __forceinline__ bool operator()(f32x4 (&acc)[2][2][4][2], const Unit& u, int wr, int wc, int fr, int fq) const {
#pragma unroll
        for (int ai = 0; ai < 2; ++ai)
#pragma unroll
            for (int m = 0; m < 4; ++m) { unsigned char* rowp = O + (size_t)(u.pm * 256 + ai * HALF + wr * 64 + m * 16 + fr) * ldc + u.pn * 128 + wc * 32 + 8 * fq;
                f32x4 v0, v1;
#pragma unroll
                for (int j = 0; j < 4; ++j) { const float a0 = acc[ai][0][m][0][j] * sc, a1 = acc[ai][0][m][1][j] * sc;
                    v0[j] = a0 * sigmoidf_(a0) * (acc[ai][1][m][0][j] * sc); v1[j] = a1 * sigmoidf_(a1) * (acc[ai][1][m][1][j] * sc); }
                *(u32x2*)rowp = pack8_fp8(v0, v1); }
        return false;
    }
};
struct EpiStoreS {
    bf16_t* O; int ldc; int rowoff; float scale;
    __device__ __forceinline__ bool operator()(f32x4 (&acc)[2][2][4][2], const Unit& u, int wr, int wc, int fr, int fq) const {
#pragma unroll
        for (int ai = 0; ai < 2; ++ai)
#pragma unroll
            for (int m = 0; m < 4; ++m) { bf16_t* rowp = O + (size_t)(rowoff + u.pm * 256 + ai * HALF + wr * 64 + m * 16 + fr) * ldc + u.pn * 256 + wc * 32 + 8 * fq;
#pragma unroll
                for (int bj = 0; bj < 2; ++bj) *(u32x4*)(rowp + bj * HALF) = pack8(acc[ai][bj][m][0] * scale, acc[ai][bj][m][1] * scale); }
        return false;
    }
};
struct EpiSwiglu {
    bf16_t* O; int ldc;
    __device__ __forceinline__ bool operator()(f32x4 (&acc)[2][2][4][2], const Unit& u, int wr, int wc, int fr, int fq) const {
#pragma unroll
        for (int ai = 0; ai < 2; ++ai)
#pragma unroll
            for (int m = 0; m < 4; ++m) { bf16_t* rowp = O + (size_t)(u.pm * 256 + ai * HALF + wr * 64 + m * 16 + fr) * ldc + u.pn * 128 + wc * 32 + 8 * fq;
                f32x4 v0, v1;
#pragma unroll
                for (int j = 0; j < 4; ++j) { const float a0 = acc[ai][0][m][0][j], a1 = acc[ai][0][m][1][j];
                    v0[j] = a0 * sigmoidf_(a0) * acc[ai][1][m][0][j]; v1[j] = a1 * sigmoidf_(a1) * acc[ai][1][m][1][j]; }
                *(u32x4*)rowp = pack8(v0, v1); }
        return false;
    }
};
struct EpiGates {
    bf16_t* LA; bf16_t* GX; const bf16_t* U; const float* ba; const float* bx; const float* sp8;
    __device__ __forceinline__ bool operator()(f32x4 (&acc)[2][2][4][2], const Unit& u, int wr, int wc, int fr, int fq) const {
        const int ch0 = u.pn * 128 + wc * 32 + 8 * fq;
        const f32x4 ba0 = *(const f32x4*)(ba + ch0), ba1 = *(const f32x4*)(ba + ch0 + 4), bx0 = *(const f32x4*)(bx + ch0), bx1 = *(const f32x4*)(bx + ch0 + 4);
        const f32x4 sp0 = *(const f32x4*)(sp8 + ch0), sp1 = *(const f32x4*)(sp8 + ch0 + 4);
#pragma unroll
        for (int ai = 0; ai < 2; ++ai)
#pragma unroll
            for (int m = 0; m < 4; ++m) { const size_t off = (size_t)(u.pm * 256 + ai * HALF + wr * 64 + m * 16 + fr) * DM + ch0;
                f32x4 u0, u1; unpack8(*(const u32x4*)(U + off), u0, u1);
                f32x4 l0, l1, g0, g1;
#pragma unroll
                for (int j = 0; j < 4; ++j) {
                    const float e0 = __builtin_amdgcn_exp2f(1.4426950408889634f * sp0[j] * sigmoidf_(acc[ai][0][m][0][j] + ba0[j])), e1 = __builtin_amdgcn_exp2f(1.4426950408889634f * sp1[j] * sigmoidf_(acc[ai][0][m][1][j] + ba1[j]));
                    l0[j] = 1.f - e0; l1[j] = 1.f - e1;
                    g0[j] = __builtin_amdgcn_sqrtf(fmaxf(1.f - e0 * e0, 0.f)) * (sigmoidf_(acc[ai][1][m][0][j] + bx0[j]) * u0[j]); g1[j] = __builtin_amdgcn_sqrtf(fmaxf(1.f - e1 * e1, 0.f)) * (sigmoidf_(acc[ai][1][m][1][j] + bx1[j]) * u1[j]); }
                *(u32x4*)(LA + off) = pack8(l0, l1); *(u32x4*)(GX + off) = pack8(g0, g1); }
        return false;
    }
};
struct EpiQ {
    unsigned char* Q; unsigned char* QC; const float* rstd; const f32x2* rope;
    __device__ __forceinline__ bool operator()(f32x4 (&acc)[2][2][4][2], const Unit& u, int wr, int wc, int fr, int fq) const {
#pragma unroll
        for (int ai = 0; ai < 2; ++ai)
#pragma unroll
            for (int m = 0; m < 4; ++m) { const int row = u.pm * 256 + ai * HALF + wr * 64 + m * 16 + fr; const float rs = rstd[row];
                int b, t, pos; unsigned char* base; int slen;
                if (row < MLAT) { b = row >> 13; t = row & (SEQ - 1); pos = t; base = Q; slen = SEQ; } else { const int rc = row - MLAT; b = rc >> 8; t = rc & (CTXL - 1); pos = SEQ; base = QC; slen = CTXL; }
#pragma unroll
                for (int bj = 0; bj < 2; ++bj) { const int c = u.pn * 256 + bj * HALF + wc * 32 + 8 * fq, h = c / DQK, dd = c - h * DQK;
                    const float rq = rs * (0.07216878364870322f * 1.4426950408889634f);
                    f32x4 v0 = acc[ai][bj][m][0] * rq, v1 = acc[ai][bj][m][1] * rq;
                    if (dd >= 128) { const int p0 = dd - 128; const f32x2* tab = rope + (size_t)pos * 32 + (p0 >> 5) * 16 + ((p0 & 31) >> 1);
                        const f32x4 cs01 = *(const f32x4*)tab, cs23 = *(const f32x4*)(tab + 2);
                        f32x4 w0, w1;
                        w0[0] = v0[0] * cs01[0] - v0[1] * cs01[1]; w0[1] = v0[1] * cs01[0] + v0[0] * cs01[1];
                        w0[2] = v0[2] * cs01[2] - v0[3] * cs01[3]; w0[3] = v0[3] * cs01[2] + v0[2] * cs01[3];
                        w1[0] = v1[0] * cs23[0] - v1[1] * cs23[1]; w1[1] = v1[1] * cs23[0] + v1[0] * cs23[1];
                        w1[2] = v1[2] * cs23[2] - v1[3] * cs23[3]; w1[3] = v1[3] * cs23[2] + v1[2] * cs23[3];
                        v0 = w0; v1 = w1; }
                    *(u32x2*)(base + ((size_t)(b * NH + h) * slen + t) * DQK + dd) = pack8_fp8(v0, v1); } }
        return false;
    }
};
struct EpiK {
    unsigned char* K; const float* rstd;
    __device__ __forceinline__ bool operator()(f32x4 (&acc)[2][2][4][2], const Unit& u, int wr, int wc, int fr, int fq) const {
        const int cl = wc * 32 + 8 * fq;
#pragma unroll
        for (int ai = 0; ai < 2; ++ai)
#pragma unroll
            for (int m = 0; m < 4; ++m) { const int row = u.pm * 256 + ai * HALF + wr * 64 + m * 16 + fr; const float rs = rstd[row];
                int b, s; if (row < MLAT) { b = row >> 13; s = row & (SEQ - 1); } else { const int rc = row - MLAT; b = rc >> 8; s = SEQ + (rc & (CTXL - 1)); }
#pragma unroll
                for (int bj = 0; bj < 2; ++bj) { const size_t key = (size_t)(b * NH + 2 * u.pn + bj) * SKV + s;
                    *(u32x2*)(K + key * 128 + cl) = pack8_fp8(acc[ai][bj][m][0] * rs, acc[ai][bj][m][1] * rs); } }
        return false;
    }
};
struct EpiVT {
    unsigned char* VT; const float* rstd;
    __device__ __forceinline__ bool operator()(f32x4 (&acc)[2][2][4][2], const Unit& u, int wr, int wc, int fr, int fq) const {
#pragma unroll
        for (int bj = 0; bj < 2; ++bj) { const int tk = u.pn * 256 + bj * HALF + wc * 32 + 8 * fq;
            int b, s; if (tk < MLAT) { b = tk >> 13; s = tk & (SEQ - 1); } else { const int rc = tk - MLAT; b = rc >> 8; s = SEQ + (rc & (CTXL - 1)); }
            const f32x4 rs0 = *(const f32x4*)(rstd + tk), rs1 = *(const f32x4*)(rstd + tk + 4);
            const int kk = s & 63, pos = 16 * (kk >> 5) + 4 * ((kk >> 3) & 3);
#pragma unroll
            for (int ai = 0; ai < 2; ++ai)
#pragma unroll
                for (int m = 0; m < 4; ++m) { const int row = u.pm * 256 + ai * HALF + wr * 64 + m * 16 + fr, h = row >> 7, dv = row & 127;
                    unsigned char* base = VT + ((size_t)(b * NH + h) * (SKV / 64) + (s >> 6)) * 8192 + dv * 64 + pos;
                    const f32x4 v0 = acc[ai][bj][m][0] * rs0, v1 = acc[ai][bj][m][1] * rs1;
                    int w0 = 0, w1 = 0; w0 = __builtin_amdgcn_cvt_pk_fp8_f32(v0[0], v0[1], w0, false); w0 = __builtin_amdgcn_cvt_pk_fp8_f32(v0[2], v0[3], w0, true);
                    w1 = __builtin_amdgcn_cvt_pk_fp8_f32(v1[0], v1[1], w1, false); w1 = __builtin_amdgcn_cvt_pk_fp8_f32(v1[2], v1[3], w1, true);
                    *(int*)base = w0; *(int*)(base + 32) = w1; } }
        return false;
    }
};
struct EpiOut1 {
    const bf16_t* GT; bf16_t* MG;
    __device__ __forceinline__ bool operator()(f32x4 (&acc)[2][2][4][2], const Unit& u, int wr, int wc, int fr, int fq) const {
        const int seg = u.aux;
#pragma unroll
        for (int ai = 0; ai < 2; ++ai)
#pragma unroll
            for (int m = 0; m < 4; ++m) { const int row = u.pm * 256 + ai * HALF + wr * 64 + m * 16 + fr;
#pragma unroll
                for (int bj = 0; bj < 2; ++bj) { const int c = u.pn * 256 + bj * HALF + wc * 32 + 8 * fq;
                    f32x4 a0, a1; unpack8(*(const u32x4*)(GT + (size_t)row * 3072 + seg * DM + c), a0, a1);
                    if (seg < 2) { f32x4 b0, b1; unpack8(*(const u32x4*)(GT + (size_t)row * 3072 + (seg + 1) * DM + c), b0, b1);
#pragma unroll
                        for (int j = 0; j < 4; ++j) { a0[j] = a0[j] * __builtin_amdgcn_rcpf(b0[j]); a1[j] = a1[j] * __builtin_amdgcn_rcpf(b1[j]); } }
                    acc[ai][bj][m][0] *= a0; acc[ai][bj][m][1] *= a1;
                    if (seg == 2) *(u32x4*)(MG + (size_t)row * DM + c) = pack8(acc[ai][bj][m][0], acc[ai][bj][m][1]); }
                asm volatile("" ::: "memory"); }
        return seg < 2;
    }
};
}

namespace att {
constexpr int DK = 192, DV = 128, NW = 8, QBLK = 32, KVBLK = 64;
constexpr float SCALE = 0.07216878364870322f;
constexpr float THR = 3.f;
constexpr int SHM_V = KVBLK * DV, SHM_K = KVBLK * DK;
constexpr int SHM_ATTN = 3 * SHM_V + 2 * SHM_K + NW * 64 * 4;
static_assert(SHM_ATTN <= STAGE_BYTES, "attention LDS fits the stage region");
#define SBAR() __builtin_amdgcn_sched_barrier(0)
__device__ __forceinline__ int crow(int r, int hi) { return (r & 3) + 8 * (r >> 2) + 4 * hi; }
__device__ __forceinline__ int k_off(int row, int c24) { return (c24 >> 3) * 8192 + row * 128 + (((c24 & 7) ^ ((row >> 1) & 7)) << 4); }
template <bool FIRST> __device__ __forceinline__ void partialSM(f32x16& p0, f32x16& p1, f32x16& negM, float& alpha) {
  constexpr float T2 = 4.f + THR * 1.4426950408889634f;
  float pmax = p0[0];
#pragma unroll
  for (int r = 1; r < 16; ++r) pmax = fmaxf(pmax, p0[r]);
#pragma unroll
  for (int r = 0; r < 16; ++r) pmax = fmaxf(pmax, p1[r]);
  { auto rr = __builtin_amdgcn_permlane32_swap(__float_as_uint(pmax), __float_as_uint(pmax), false, false);
    pmax = fmaxf(__uint_as_float(rr[0]), __uint_as_float(rr[1])); }
  if (!FIRST && __builtin_expect(__all(pmax <= T2), 1)) { alpha = 1.f; }
  else { const float delta = FIRST ? pmax - 4.f : fmaxf(pmax - 4.f, 0.f); alpha = FIRST ? 1.f : __builtin_amdgcn_exp2f(-delta);
#pragma unroll
    for (int r = 0; r < 16; ++r) { negM[r] -= delta; p0[r] -= delta; p1[r] -= delta; } }
#pragma unroll
  for (int r = 0; r < 16; ++r) p0[r] = __builtin_amdgcn_exp2f(p0[r]);
}
__device__ __forceinline__ void finishSM(f32x16& p0, f32x16& p1, float alpha, float& l_reg, pg8::i32x8& P8) {
#pragma unroll
  for (int r = 0; r < 16; ++r) p1[r] = __builtin_amdgcn_exp2f(p1[r]);
  float ps = 0;
#pragma unroll
  for (int r = 0; r < 16; ++r) ps += p0[r];
#pragma unroll
  for (int r = 0; r < 16; ++r) ps += p1[r];
  { auto rr = __builtin_amdgcn_permlane32_swap(__float_as_uint(ps), __float_as_uint(ps), false, false);
    ps = __uint_as_float(rr[0]) + __uint_as_float(rr[1]); }
  l_reg = l_reg * alpha + ps;
#pragma unroll
  for (int q = 0; q < 4; ++q) { int w = 0, x = 0;
    w = __builtin_amdgcn_cvt_pk_fp8_f32(p0[4 * q], p0[4 * q + 1], w, false); w = __builtin_amdgcn_cvt_pk_fp8_f32(p0[4 * q + 2], p0[4 * q + 3], w, true);
    x = __builtin_amdgcn_cvt_pk_fp8_f32(p1[4 * q], p1[4 * q + 1], x, false); x = __builtin_amdgcn_cvt_pk_fp8_f32(p1[4 * q + 2], p1[4 * q + 3], x, true);
    P8[q] = w; P8[4 + q] = x; }
}
__device__ __forceinline__ void qkt(f32x16& p0, f32x16& p1, const LAS unsigned char* Ks, const pg8::i32x8* qf, int ko0, int ko1, const f32x16& negM) {
  p0 = negM; p1 = negM;
#pragma unroll
  for (int i = 0; i < 3; ++i) {
    const u32x4 a0 = *(const LAS u32x4*)(Ks + i * 4096 + ko0), a1 = *(const LAS u32x4*)(Ks + i * 4096 + ko1);
    const u32x4 b0 = *(const LAS u32x4*)(Ks + i * 4096 + 2048 + ko0), b1 = *(const LAS u32x4*)(Ks + i * 4096 + 2048 + ko1);
    const pg8::i32x8 ka = {(int)a0.x, (int)a0.y, (int)a0.z, (int)a0.w, (int)a1.x, (int)a1.y, (int)a1.z, (int)a1.w}, kb = {(int)b0.x, (int)b0.y, (int)b0.z, (int)b0.w, (int)b1.x, (int)b1.y, (int)b1.z, (int)b1.w};
    p0 = __builtin_amdgcn_mfma_scale_f32_32x32x64_f8f6f4(ka, qf[i], p0, 0, 0, 0, 0x7f7f7f7f, 0, 0x7f7f7f7f);
    p1 = __builtin_amdgcn_mfma_scale_f32_32x32x64_f8f6f4(kb, qf[i], p1, 0, 0, 0, 0x7f7f7f7f, 0, 0x7f7f7f7f); }
}
__device__ __forceinline__ void pv8(f32x16* o, const LAS unsigned char* Vs, const pg8::i32x8 P8, int ko0, int ko1) {
#pragma unroll
  for (int d0 = 0; d0 < 4; ++d0) { const u32x4 a = *(const LAS u32x4*)(Vs + d0 * 2048 + ko0), b = *(const LAS u32x4*)(Vs + d0 * 2048 + ko1);
    const pg8::i32x8 v = {(int)a.x, (int)a.y, (int)a.z, (int)a.w, (int)b.x, (int)b.y, (int)b.z, (int)b.w};
    o[d0] = __builtin_amdgcn_mfma_scale_f32_32x32x64_f8f6f4(P8, v, o[d0], 0, 0, 0, 0x7f7f7f7f, 0, 0x7f7f7f7f); }
}
__device__ __forceinline__ void attn_unit(const char* __restrict__ Qb, const char* __restrict__ Kh, const char* __restrict__ Kr, const char* __restrict__ Vh, char* __restrict__ Ob, int seq, LAS unsigned char* lds, const int wid) {
  const int tid = fresh_tid(wid), lane = tid & 63, r32 = lane & 31, hi = lane >> 5;
  LAS unsigned char* V_lds = lds; LAS unsigned char* K_lds = lds + 3 * SHM_V;
  LAS float* ws = (LAS float*)(lds + 3 * SHM_V + 2 * SHM_K) + wid * 64; LAS float* li_l = ws; LAS float* al_l = ws + 32;
  float l_reg = 0; f32x16 o[4] = {}, negM = {}; pg8::i32x8 qf[3];
  const unsigned qoff = (unsigned)((wid * QBLK + r32) * DK + hi * 32);
#pragma unroll
  for (int i = 0; i < 3; ++i) { const u32x4 a = *reinterpret_cast<const u32x4*>(Qb + qoff + i * 64), b = *reinterpret_cast<const u32x4*>(Qb + qoff + i * 64 + 16);
    qf[i] = (pg8::i32x8){(int)a.x, (int)a.y, (int)a.z, (int)a.w, (int)b.x, (int)b.y, (int)b.z, (int)b.w}; }
  const int ko0 = r32 * 64 + 16 * ((2 * hi) ^ ((r32 >> 2) & 3)), ko1 = ko0 ^ 16;
  const unsigned kswz = (unsigned)(((lane & 3) ^ ((lane >> 4) & 3)) << 4), krow = (unsigned)(16 * (wid & 3) + (lane >> 2));
  const unsigned kgn = krow * 128 + 64 * (wid >> 2) + kswz, kgr = krow * 64 + kswz;
  LAS unsigned char* kdst = K_lds + (wid >> 2) * 4096 + (wid & 3) * 1024; LAS unsigned char* kdst2 = K_lds + 8192 + (wid & 3) * 1024;
  const unsigned vg = (unsigned)((16 * wid + (lane >> 2)) * 64) + kswz;
  LAS unsigned char* vdst = V_lds + wid * 1024;
#define SLOAD(k0, kb, vboff) do { \
    __builtin_amdgcn_global_load_lds((const unsigned*)(Vh + (size_t)(k0) * 128 + vg), (LAS unsigned*)(vdst + (vboff)), 16, 0, 0); \
    __builtin_amdgcn_global_load_lds((const unsigned*)(Kh + (size_t)(k0) * 128 + kgn), (LAS unsigned*)(kdst + (kb) * SHM_K), 16, 0, 0); \
    if (wid < 4) __builtin_amdgcn_global_load_lds((const unsigned*)(Kr + (size_t)(k0) * 64 + kgr), (LAS unsigned*)(kdst2 + (kb) * SHM_K), 16, 0, 0); } while (0)
#define TILE_SYNC() do { asm volatile("s_waitcnt vmcnt(0)" ::: "memory"); __syncthreads(); } while (0)
#define RESC(a) do { if (__any((a) < 1.f)) { if (hi == 0) al_l[r32] = (a); asm volatile("s_waitcnt lgkmcnt(0)" ::: "memory"); \
    _Pragma("unroll") for (int d = 0; d < 4; ++d) _Pragma("unroll") for (int r = 0; r < 16; ++r) o[d][r] *= al_l[crow(r, hi)]; } } while (0)
#define VROT(x) do { (x) += SHM_V; if ((x) == 3 * SHM_V) (x) = 0; } while (0)
  f32x16 pA0, pA1, pB0, pB1; float alA, alB; pg8::i32x8 P8; const int NT = seq / KVBLK;
  __syncthreads();
  SLOAD(0, 0, 0); TILE_SYNC();
  qkt(pA0, pA1, K_lds, qf, ko0, ko1, negM); partialSM<true>(pA0, pA1, negM, alA);
  SLOAD(KVBLK, 1, SHM_V); TILE_SYNC();
  int vrd = 0, vwr = 2 * SHM_V;
  for (int j = 1; j + 1 < NT; j += 2) {
    SBAR(); qkt(pB0, pB1, K_lds + SHM_K, qf, ko0, ko1, negM);
    finishSM(pA0, pA1, alA, l_reg, P8); SBAR();
    SLOAD((j + 1) * KVBLK, 0, vwr); SBAR();
    pv8(o, V_lds + vrd, P8, ko0, ko1); partialSM<false>(pB0, pB1, negM, alB);
    RESC(alB); VROT(vrd); VROT(vwr); TILE_SYNC();
    SBAR(); qkt(pA0, pA1, K_lds, qf, ko0, ko1, negM);
    finishSM(pB0, pB1, alB, l_reg, P8); SBAR();
    SLOAD((j + 2) * KVBLK, 1, vwr); SBAR();
    pv8(o, V_lds + vrd, P8, ko0, ko1); partialSM<false>(pA0, pA1, negM, alA);
    RESC(alA); VROT(vrd); VROT(vwr); TILE_SYNC();
  }
  SBAR(); qkt(pB0, pB1, K_lds + SHM_K, qf, ko0, ko1, negM);
  finishSM(pA0, pA1, alA, l_reg, P8); SBAR();
  pv8(o, V_lds + vrd, P8, ko0, ko1); partialSM<false>(pB0, pB1, negM, alB);
  RESC(alB); VROT(vrd);
  finishSM(pB0, pB1, alB, l_reg, P8); SBAR();
  pv8(o, V_lds + vrd, P8, ko0, ko1);
  if (hi == 0) li_l[r32] = l_reg; asm volatile("s_waitcnt lgkmcnt(0)" ::: "memory");
  float rli[16];
#pragma unroll
  for (int r = 0; r < 16; ++r) rli[r] = __builtin_amdgcn_rcpf(li_l[crow(r, hi)]);
  const unsigned ob0 = (unsigned)((wid * QBLK + 4 * hi) * DM + r32) * 2u;
#pragma unroll
  for (int r = 0; r < 16; ++r) {
#pragma unroll
    for (int d0 = 0; d0 < 4; ++d0) *(bf16_t*)(Ob + ob0 + (unsigned)(((r & 3) + 8 * (r >> 2)) * DM + d0 * 32) * 2u) = (bf16_t)(cvtpk(o[d0][r] * rli[r], 0.f) & 0xffffu); }
#undef SLOAD
#undef TILE_SYNC
#undef RESC
#undef VROT
}
}

struct Args { const float* in[35]; float* out; unsigned char* ws; int ph_lo, ph_hi; };
enum { I_X = 0, I_C, I_CTX, I_CCTX, I_MODW, I_MODB, I_PREMIXG, I_POSTMIXG, I_PREFFNG, I_POSTFFNG, I_WIN, I_POOLW, I_POOLSCALE, I_POOLPROJ, I_CONVW, I_CONVB,
       I_GAW, I_GAB, I_GXW, I_GXB, I_LAMBDA, I_LRUPROJ, I_QNORMG, I_WUQ, I_KVNORMG, I_WUKV, I_MLAPROJ, I_WOUT, I_FFNW1, I_FFNW3, I_FFNW2, I_ROUTERW, I_MOEW1, I_MOEW3, I_MOEW2 };

typedef const __attribute__((address_space(4))) Args* ArgsP;
struct Frame {
    LAS unsigned char* lds; int G, c, ngw, wave;
    ArgsP A;
};
__device__ __forceinline__ ArgsP launder(ArgsP a) { asm volatile("" : "+s"(a)); return a; }
__device__ __forceinline__ Frame make_frame(ArgsP A0, int wave) {
    extern __shared__ __attribute__((aligned(16))) unsigned char lds_raw[];
    Frame F; F.A = launder(A0); F.lds = (LAS unsigned char*)lds_raw; F.G = gridDim.x; F.c = blockIdx.x; F.ngw = F.G * NWAVES; F.wave = wave; return F;
}
__device__ __forceinline__ bool in_range(ArgsP A0, int k) { ArgsP a = launder(A0); return a->ph_lo <= k && k < a->ph_hi; }
#define PHASE_IDS const int wave = F.wave, tid = fresh_tid(wave), lane = tid & 63, gw = F.c * NWAVES + wave; (void)lane; (void)gw
#define RCOL(j) (lane * 8 + 512 * ((j) >> 1) + 4 * ((j) & 1))
#define F_IN(i) (F.A->in[i])
#define F_WS (F.A->ws)
#define F_OUT (F.A->out)

template <class Src> __device__ __forceinline__ void wprep_job(const Frame& F, int& it0, int K, int N, bf16_t* dst, const Src& src) {
    PHASE_IDS;
    LAS float* scr = (LAS float*)(F.lds + wave * 16384);
    const int nblk = N / 32, nitems = (K / 64) * nblk;
    int first = it0 + (((gw - it0) % F.ngw) + F.ngw) % F.ngw;
    for (int it = first; it < it0 + nitems; it += F.ngw) {
        const int r = it - it0, kb = r / nblk, nb = r % nblk, k0 = 64 * kb, n0 = 32 * nb;
#pragma unroll 8
        for (int i = 0; i < 32; ++i) { const int kk = 2 * i + (lane >> 5); scr[kk * 33 + (lane & 31)] = src(k0 + kk, n0 + (lane & 31)); }
        LDS_WAIT(); asm volatile("" ::: "memory");
        const int cc = lane & 7;
#pragma unroll
        for (int j = 0; j < 4; ++j) { const int n = (lane >> 3) + 8 * j; const LAS float* s = scr + (8 * cc) * 33 + n;
            u32x4 o; o.x = cvtpk(s[0 * 33], s[1 * 33]); o.y = cvtpk(s[2 * 33], s[3 * 33]); o.z = cvtpk(s[4 * 33], s[5 * 33]); o.w = cvtpk(s[6 * 33], s[7 * 33]);
            *(u32x4*)(dst + (size_t)(n0 + n) * K + k0 + 8 * cc) = o; }
        LDS_WAIT(); asm volatile("" ::: "memory");
    }
    it0 += nitems;
}
template <class Src> __device__ __forceinline__ void wprep_fast(const Frame& F, int& it0, int K, int N, bf16_t* dst, const Src& src) {
    PHASE_IDS;
    LAS float* scr = (LAS float*)(F.lds + wave * 16384);
    const int nblk = N / 32, nitems = (K / 64) * nblk; const long ld = src.ld;
    int first = it0 + (((gw - it0) % F.ngw) + F.ngw) % F.ngw;
    for (int it = first; it < it0 + nitems; it += F.ngw) {
        const int r = it - it0, kb = r / nblk, nb = r % nblk, k0 = 64 * kb, n0 = 32 * nb;
        const float* p = src.at(n0 + (lane & 31)); float v[32];
        if (p) { p += (long)(k0 + (lane >> 5)) * ld;
#pragma unroll
            for (int i = 0; i < 32; ++i) v[i] = __builtin_nontemporal_load(p + (long)(2 * i) * ld); }
        else {
#pragma unroll
            for (int i = 0; i < 32; ++i) v[i] = 0.f; }
#pragma unroll
        for (int i = 0; i < 32; ++i) scr[(2 * i + (lane >> 5)) * 33 + (lane & 31)] = v[i];
        LDS_WAIT(); asm volatile("" ::: "memory");
        const int cc = lane & 7;
#pragma unroll
        for (int j = 0; j < 4; ++j) { const int n = (lane >> 3) + 8 * j; const LAS float* s = scr + (8 * cc) * 33 + n;
            u32x4 o; o.x = cvtpk(s[0 * 33], s[1 * 33]); o.y = cvtpk(s[2 * 33], s[3 * 33]); o.z = cvtpk(s[4 * 33], s[5 * 33]); o.w = cvtpk(s[6 * 33], s[7 * 33]);
            *(u32x4*)(dst + (size_t)(n0 + n) * K + k0 + 8 * cc) = o; }
        LDS_WAIT(); asm volatile("" ::: "memory");
    }
    it0 += nitems;
}
template <class Src> __device__ __forceinline__ void wprep_fast8(const Frame& F, int& it0, int K, int N, unsigned char* dst, const Src& src, float scale) {
    PHASE_IDS;
    LAS float* scr = (LAS float*)(F.lds + wave * 16384);
    const int nblk = N / 32, nitems = (K / 64) * nblk; const long ld = src.ld;
    int first = it0 + (((gw - it0) % F.ngw) + F.ngw) % F.ngw;
    for (int it = first; it < it0 + nitems; it += F.ngw) {
        const int r = it - it0, kb = r / nblk, nb = r % nblk, k0 = 64 * kb, n0 = 32 * nb;
        const float* p = src.at(n0 + (lane & 31)); float v[32];
        if (p) { p += (long)(k0 + (lane >> 5)) * ld;
#pragma unroll
            for (int i = 0; i < 32; ++i) v[i] = __builtin_nontemporal_load(p + (long)(2 * i) * ld); }
        else {
#pragma unroll
            for (int i = 0; i < 32; ++i) v[i] = 0.f; }
#pragma unroll
        for (int i = 0; i < 32; ++i) scr[(2 * i + (lane >> 5)) * 33 + (lane & 31)] = v[i] * scale;
        LDS_WAIT(); asm volatile("" ::: "memory");
        const int cc = lane & 7;
#pragma unroll
        for (int j = 0; j < 4; ++j) { const int n = (lane >> 3) + 8 * j; const LAS float* s = scr + (8 * cc) * 33 + n;
            const f32x4 a = {s[0 * 33], s[1 * 33], s[2 * 33], s[3 * 33]}, b = {s[4 * 33], s[5 * 33], s[6 * 33], s[7 * 33]};
            *(u32x2*)(dst + (size_t)(n0 + n) * K + k0 + 8 * cc) = pg8::pack8_fp8(a, b); }
        LDS_WAIT(); asm volatile("" ::: "memory");
    }
    it0 += nitems;
}
struct FastPlain { const float* W; int ld; __device__ __forceinline__ const float* at(int n) const { return W + n; } };
struct FastIn1 { const float* W; int ld;
    __device__ __forceinline__ const float* at(int n) const { int c; if (n < 1024) c = 1024 + n; else if (n < 2048) c = 2048 + (n - 1024); else if (n < 3072) c = n - 2048; else if (n < 3776) c = n; else return nullptr; return W + c; } };
struct FastW13 { const float* W1; long d31; int ld;
    __device__ __forceinline__ const float* at(int n) const { const int pn = n >> 8, bj = (n >> 7) & 1, jj = n & 127; return W1 + (long)bj * d31 + pn * 128 + jj; } };
struct SrcPlain { const float* W; int ld; __device__ __forceinline__ float operator()(int k, int n) const { return W[(size_t)k * ld + n]; } };
struct SrcPlainS { const float* W; int ld; float s; __device__ __forceinline__ float operator()(int k, int n) const { return W[(size_t)k * ld + n] * s; } };
struct SrcIn1 { const float* W;
    __device__ __forceinline__ float operator()(int k, int n) const {
        int c; if (n < 1024) c = 1024 + n; else if (n < 2048) c = 2048 + (n - 1024); else if (n < 3072) c = n - 2048; else if (n < 3776) c = n; else return 0.f;
        return W[(size_t)k * INCOLS + c]; } };
struct SrcGate { const float* Wa; long dxa; int nb;
    __device__ __forceinline__ float operator()(int k, int n) const { const int d = n >> 8, bj = (n >> 7) & 1, jj = n & 127;
        return Wa[(long)bj * dxa + (((long)d * 8 + nb) * 128 + k) * 128 + jj]; } };
struct SrcUQ { const float* W; const float* g;
    __device__ __forceinline__ float operator()(int k, int n) const { const int h = n / DQK, dd = n - h * DQK; int c = n;
        if (dd >= 128) { const int p = dd - 128, axis = p >> 5, f = (p & 31) >> 1, half = p & 1; c = h * DQK + 128 + axis * 32 + half * 16 + f; }
        return W[(size_t)k * 1536 + c] * g[k]; } };
struct SrcScaleK { const float* W; const float* g; int ld; __device__ __forceinline__ float operator()(int k, int n) const { return W[(size_t)k * ld + n] * g[k]; } };
struct SrcUKV { const float* W; const float* g;
    __device__ __forceinline__ float operator()(int k, int n) const { const int v = n >> 10, h = (n >> 7) & 7, j = n & 127; return W[(size_t)k * 2048 + h * 256 + v * 128 + j] * g[k]; } };
struct SrcW13 { const float* W1; long d31; int ld;
    __device__ __forceinline__ float operator()(int k, int n) const { const int pn = n >> 8, bj = (n >> 7) & 1, jj = n & 127; return W1[(long)bj * d31 + (long)k * ld + pn * 128 + jj]; } };
struct SrcPoolWS { const float* W; const float* sc;
    __device__ __forceinline__ float operator()(int k, int n) const { return W[(size_t)n * 256 + k] * sc[k]; } };

__device__ __forceinline__ void mod_partials(const Frame& F) {
    PHASE_IDS;
    const float* c = F_IN(I_C); const float* cc = F_IN(I_CCTX); const float* mw = F_IN(I_MODW); float* part = (float*)(F_WS + WS_MPART);
    for (int task = F.c; task < 2 * 12 * 32; task += F.G) {
        const int l = task / 384, r = task % 384, cb = r / 32, kc = r % 32, col = cb * 512 + tid;
        float a0 = 0, a1 = 0, a2 = 0, a3 = 0, a4 = 0;
#pragma unroll 8
        for (int kk = 0; kk < 32; ++kk) { const int k = kc * 32 + kk; const float w = mw[((size_t)l * 1024 + k) * 6144 + col];
            const float c0 = c[k], c1 = c[1024 + k], c2 = c[2048 + k], c3 = c[3072 + k], c4 = cc[k];
            a0 += c0 * sigmoidf_(c0) * w; a1 += c1 * sigmoidf_(c1) * w; a2 += c2 * sigmoidf_(c2) * w; a3 += c3 * sigmoidf_(c3) * w; a4 += c4 * sigmoidf_(c4) * w; }
        float* p = part + (((size_t)l * 32 + kc) * 5) * 6144 + col;
        p[0] = a0; p[6144] = a1; p[2 * 6144] = a2; p[3 * 6144] = a3; p[4 * 6144] = a4;
    }
}
__device__ __forceinline__ void mod_reduce(const Frame& F) {
    PHASE_IDS;
    const float* part = (const float*)(F_WS + WS_MPART); const float* mb = F_IN(I_MODB); float* mv = (float*)(F_WS + WS_MVEC);
    for (int i = F.c * NTHR + tid; i < 2 * 5 * 6144; i += F.G * NTHR) { const int l = i / 30720, r = (i % 30720) / 6144, col = i % 6144;
        float s = mb[l * 6144 + col];
        for (int kc = 0; kc < 32; ++kc) s += part[(((size_t)l * 32 + kc) * 5 + r) * 6144 + col];
        mv[i] = s; }
}
__device__ __forceinline__ void rope_and_consts(const Frame& F) {
    PHASE_IDS;
    f32x2* rope = (f32x2*)(F_WS + WS_ROPE);
    for (int i = F.c * NTHR + tid; i < 8193 * 32; i += F.G * NTHR) { const int pos = i >> 5, a = (i >> 4) & 1, f = i & 15;
        f32x2 v = {1.f, 0.f};
        if (pos < SEQ) { const float inv = __builtin_amdgcn_exp2f(-(float)f * (13.287712379549449f / 16.f));
            const float p = (float)(a == 0 ? (pos >> 6) : (pos & 63)); const float rev = (p * inv) * 0.15915494309189535f; const float fr = rev - rintf(rev);
            v.x = __builtin_amdgcn_cosf(fr); v.y = __builtin_amdgcn_sinf(fr); }
        rope[i] = v; }
    float* sp8 = (float*)(F_WS + WS_SP8); const float* lam = F_IN(I_LAMBDA);
    for (int i = F.c * NTHR + tid; i < 2 * 2 * 1024; i += F.G * NTHR) sp8[i] = -8.f * log1pf(expf(-lam[i]));
}

__device__ __forceinline__ void pool_weights_phase(const Frame& F) {
    PHASE_IDS;
    for (int tile = F.c; tile < 512; tile += F.G) {
        const int l = tile >> 8, g = (tile >> 6) & 3, n0 = ((tile >> 2) & 15) * 64, i0 = (tile & 3) * 64 + wave * 8;
        const float* PW = F_IN(I_POOLW) + (((size_t)l * 4 + g) * 256 + i0) * 256; const float* SC = F_IN(I_POOLSCALE) + l * 1024 + g * 256;
        const float* PP = F_IN(I_POOLPROJ) + ((size_t)l * 1024 + g * 256) * DM + n0 + lane;
        float acc[8] = {0.f, 0.f, 0.f, 0.f, 0.f, 0.f, 0.f, 0.f};
#pragma unroll 4
        for (int j = 0; j < 256; ++j) { const float p = PP[(size_t)j * DM] * SC[j];
#pragma unroll
            for (int ii = 0; ii < 8; ++ii) acc[ii] += PW[ii * 256 + j] * p; }
        u32x4 o; o.x = cvtpk(acc[0], acc[1]); o.y = cvtpk(acc[2], acc[3]); o.z = cvtpk(acc[4], acc[5]); o.w = cvtpk(acc[6], acc[7]);
        *(u32x4*)((bf16_t*)(F_WS + WS_WTS + (size_t)l * WTS_LSTRIDE + WO_POOL) + (size_t)(n0 + lane) * DM + g * 256 + i0) = o;
    }
}
__device__ __forceinline__ const float* mvec_row(const Frame& F, int l, int row) { return (const float*)(F_WS + WS_MVEC) + ((size_t)l * 5 + (row < MLAT ? (row >> 13) : 4)) * 6144; }
template <bool BF> __device__ __forceinline__ void ldx8(const void* base, size_t e, f32x4& a, f32x4& b) {
    if (BF) { const u32x4 w = *(const u32x4*)((const bf16_t*)base + e); a = (f32x4){bf_lo(w.x), bf_hi(w.x), bf_lo(w.y), bf_hi(w.y)}; b = (f32x4){bf_lo(w.z), bf_hi(w.z), bf_lo(w.w), bf_hi(w.w)}; }
    else { a = *(const f32x4*)((const float*)base + e); b = *(const f32x4*)((const float*)base + e + 4); }
}
template <bool BF> __device__ __forceinline__ void stx8(void* base, size_t e, const f32x4 a, const f32x4 b) {
    if (BF) { u32x4 w; w.x = cvtpk(a[0], a[1]); w.y = cvtpk(a[2], a[3]); w.z = cvtpk(b[0], b[1]); w.w = cvtpk(b[2], b[3]); *(u32x4*)((bf16_t*)base + e) = w; }
    else { *(f32x4*)((float*)base + e) = a; *(f32x4*)((float*)base + e + 4) = b; }
}
template <bool XBF> __device__ __forceinline__ void norm1_phase(const Frame& F, int l, const void* xlat, const float* xctx, bf16_t* H, unsigned char* H8, int nrows) {
    PHASE_IDS;
    const float* g = F_IN(I_PREMIXG) + l * DM;
    for (int row = gw; row < nrows; row += F.ngw) {
        const bool lat = row < MLAT; const float* mr = mvec_row(F, l, row);
        f32x4 v[4]; float ss = 0.f;
#pragma unroll
        for (int jp = 0; jp < 2; ++jp) { if (lat) ldx8<XBF>(xlat, (size_t)row * DM + lane * 8 + 512 * jp, v[2 * jp], v[2 * jp + 1]); else ldx8<false>(xctx, (size_t)(row - MLAT) * DM + lane * 8 + 512 * jp, v[2 * jp], v[2 * jp + 1]); }
#pragma unroll
        for (int j = 0; j < 4; ++j) ss += (v[j][0] * v[j][0] + v[j][1] * v[j][1]) + (v[j][2] * v[j][2] + v[j][3] * v[j][3]);
        const float rstd = rsqrtf(wave_sum(ss) * (1.f / DM) + RMS_EPS);
#pragma unroll
        for (int j = 0; j < 4; ++j) { const int col = RCOL(j); const f32x4 gg = *(const f32x4*)(g + col), sh = *(const f32x4*)(mr + col), sc = *(const f32x4*)(mr + DM + col);
            v[j] = v[j] * rstd * gg * (sc + 1.f) + sh; }
#pragma unroll
        for (int jp = 0; jp < 2; ++jp) { const f32x4 p = v[2 * jp], q = v[2 * jp + 1]; const size_t o = (size_t)row * DM + lane * 8 + 512 * jp;
            u32x4 w; w.x = cvtpk(p[0], p[1]); w.y = cvtpk(p[2], p[3]); w.z = cvtpk(q[0], q[1]); w.w = cvtpk(q[2], q[3]); *(u32x4*)(H + o) = w;
            *(u32x2*)(H8 + o) = pg8::pack8_fp8(p, q); }
    }
}
template <bool MOE, bool XIB, bool XOB> __device__ __forceinline__ void resid1_phase(const Frame& F, int l, const void* xlat, const float* xctx, void* olat, float* octx, const bf16_t* Y, bf16_t* H2, int nrows) {
    PHASE_IDS;
    const float* gpost = F_IN(I_POSTMIXG) + l * DM; const float* gpre = F_IN(I_PREFFNG) + l * DM;
    LAS float* rw = (LAS float*)F.lds;
    volatile LAS int* hist = (volatile LAS int*)(F.lds + 32768);
    if (MOE) { const float* rwg = F_IN(I_ROUTERW);
        for (int i = tid; i < 8192; i += NTHR) rw[(i & 7) * 1024 + (i >> 3)] = rwg[i];
        if (tid < 8) hist[tid] = 0;
        __syncthreads(); }
    for (int row = gw; row < nrows; row += F.ngw) {
        const bool lat = row < MLAT; const size_t ro = lat ? (size_t)row * DM : (size_t)(row - MLAT) * DM;
        const float* mr = mvec_row(F, l, row);
        f32x4 y[4], xv[4]; float ss = 0.f;
#pragma unroll
        for (int jp = 0; jp < 2; ++jp) { if (lat) ldx8<XIB>(xlat, ro + lane * 8 + 512 * jp, xv[2 * jp], xv[2 * jp + 1]); else ldx8<false>(xctx, ro + lane * 8 + 512 * jp, xv[2 * jp], xv[2 * jp + 1]); }
#pragma unroll
        for (int jp = 0; jp < 2; ++jp) { const u32x4 w = *(const u32x4*)(Y + (size_t)row * DM + lane * 8 + 512 * jp);
            y[2 * jp] = (f32x4){bf_lo(w.x), bf_hi(w.x), bf_lo(w.y), bf_hi(w.y)}; y[2 * jp + 1] = (f32x4){bf_lo(w.z), bf_hi(w.z), bf_lo(w.w), bf_hi(w.w)}; }
#pragma unroll
        for (int j = 0; j < 4; ++j) ss += (y[j][0] * y[j][0] + y[j][1] * y[j][1]) + (y[j][2] * y[j][2] + y[j][3] * y[j][3]);
        const float rs = rsqrtf(wave_sum(ss) * (1.f / DM) + RMS_EPS);
        f32x4 xn[4]; float s2 = 0.f;
#pragma unroll
        for (int j = 0; j < 4; ++j) { const int col = RCOL(j); const f32x4 gg = *(const f32x4*)(gpost + col), gate = *(const f32x4*)(mr + 2 * DM + col);
            xn[j] = xv[j] + gate * (y[j] * rs * gg);
            s2 += (xn[j][0] * xn[j][0] + xn[j][1] * xn[j][1]) + (xn[j][2] * xn[j][2] + xn[j][3] * xn[j][3]); }
#pragma unroll
        for (int jp = 0; jp < 2; ++jp) { if (lat) stx8<XOB>(olat, ro + lane * 8 + 512 * jp, xn[2 * jp], xn[2 * jp + 1]); else stx8<false>(octx, ro + lane * 8 + 512 * jp, xn[2 * jp], xn[2 * jp + 1]); }
        const float rs2 = rsqrtf(wave_sum(s2) * (1.f / DM) + RMS_EPS);
        f32x4 h2[4];
#pragma unroll
        for (int j = 0; j < 4; ++j) { const int col = RCOL(j); const f32x4 gg = *(const f32x4*)(gpre + col), sh = *(const f32x4*)(mr + 3 * DM + col), sc = *(const f32x4*)(mr + 4 * DM + col);
            h2[j] = xn[j] * rs2 * gg * (sc + 1.f) + sh; }
#pragma unroll
        for (int jp = 0; jp < 2; ++jp) { const f32x4 p = h2[2 * jp], q = h2[2 * jp + 1]; const size_t o = (size_t)row * DM + lane * 8 + 512 * jp;
            if (MOE) { *(u32x2*)((unsigned char*)H2 + o) = pg8::pack8_fp8(p, q); }
            else { u32x4 w; w.x = cvtpk(p[0], p[1]); w.y = cvtpk(p[2], p[3]); w.z = cvtpk(q[0], q[1]); w.w = cvtpk(q[2], q[3]); *(u32x4*)(H2 + o) = w; } }
        if (MOE) {
            float lg[8];
#pragma unroll
            for (int e = 0; e < 8; ++e) { float s = 0.f;
#pragma unroll
                for (int j = 0; j < 4; ++j) { const f32x4 w = *(const LAS f32x4*)(rw + e * 1024 + RCOL(j)); s += (h2[j][0] * w[0] + h2[j][1] * w[1]) + (h2[j][2] * w[2] + h2[j][3] * w[3]); }
                lg[e] = wave_sum(s); }
            int e1 = 0; float v1 = lg[0];
#pragma unroll
            for (int e = 1; e < 8; ++e) if (lg[e] > v1) { v1 = lg[e]; e1 = e; }
            int e2 = -1; float v2 = -3.0e38f;
#pragma unroll
            for (int e = 0; e < 8; ++e) if (e != e1 && lg[e] > v2) { v2 = lg[e]; e2 = e; }
            if (lane == 0) { ((int*)(F_WS + WS_E12))[row] = e1 | (e2 << 8); ((float*)(F_WS + WS_G1))[row] = 1.f / (1.f + expf(v2 - v1));
                atomicAdd((int*)&hist[e1], 1); atomicAdd((int*)&hist[e2], 1); }
        }
    }
    if (MOE) { __syncthreads(); if (tid < 8) atomicAdd((unsigned*)(F_WS + WS_CTL) + CW_CNT + 64 * tid, (unsigned)hist[tid]); }
}
template <bool MOE, bool XIB, bool XOB> __device__ __forceinline__ void resid2_phase(const Frame& F, int l, const void* xlat, const float* xctx, void* olat, float* octx, const bf16_t* Fb, int nrows) {
    PHASE_IDS;
    const float* gpost = F_IN(I_POSTFFNG) + l * DM;
    for (int row = gw; row < nrows; row += F.ngw) {
        const bool lat = row < MLAT; const size_t ro = lat ? (size_t)row * DM : (size_t)(row - MLAT) * DM;
        const float* mr = mvec_row(F, l, row);
        f32x4 f[4], xv[4]; float ss = 0.f;
#pragma unroll
        for (int jp = 0; jp < 2; ++jp) { if (lat) ldx8<XIB>(xlat, ro + lane * 8 + 512 * jp, xv[2 * jp], xv[2 * jp + 1]); else ldx8<false>(xctx, ro + lane * 8 + 512 * jp, xv[2 * jp], xv[2 * jp + 1]); }
        if (MOE) { const int d1 = ((const int*)(F_WS + WS_DEST))[2 * row], d2 = ((const int*)(F_WS + WS_DEST))[2 * row + 1]; const float g1 = ((const float*)(F_WS + WS_G1))[row], g2 = 1.f - g1;
#pragma unroll
            for (int jp = 0; jp < 2; ++jp) { const u32x4 a = *(const u32x4*)(Fb + (size_t)d1 * DM + lane * 8 + 512 * jp), b = *(const u32x4*)(Fb + (size_t)d2 * DM + lane * 8 + 512 * jp);
                f[2 * jp] = (f32x4){bf_lo(a.x), bf_hi(a.x), bf_lo(a.y), bf_hi(a.y)} * g1 + (f32x4){bf_lo(b.x), bf_hi(b.x), bf_lo(b.y), bf_hi(b.y)} * g2;
                f[2 * jp + 1] = (f32x4){bf_lo(a.z), bf_hi(a.z), bf_lo(a.w), bf_hi(a.w)} * g1 + (f32x4){bf_lo(b.z), bf_hi(b.z), bf_lo(b.w), bf_hi(b.w)} * g2; }
        } else {
#pragma unroll
            for (int jp = 0; jp < 2; ++jp) { const u32x4 a = *(const u32x4*)(Fb + (size_t)row * DM + lane * 8 + 512 * jp);
                f[2 * jp] = (f32x4){bf_lo(a.x), bf_hi(a.x), bf_lo(a.y), bf_hi(a.y)}; f[2 * jp + 1] = (f32x4){bf_lo(a.z), bf_hi(a.z), bf_lo(a.w), bf_hi(a.w)}; }
        }
#pragma unroll
        for (int j = 0; j < 4; ++j) ss += (f[j][0] * f[j][0] + f[j][1] * f[j][1]) + (f[j][2] * f[j][2] + f[j][3] * f[j][3]);
        const float rs = rsqrtf(wave_sum(ss) * (1.f / DM) + RMS_EPS);
#pragma unroll
        for (int j = 0; j < 4; ++j) { const int col = lane * 8 + 512 * (j >> 1) + 4 * (j & 1);
            const f32x4 gg = *(const f32x4*)(gpost + col), gate = *(const f32x4*)(mr + 5 * DM + col);
            xv[j] = xv[j] + gate * (f[j] * rs * gg); }
#pragma unroll
        for (int jp = 0; jp < 2; ++jp) { if (lat) stx8<XOB>(olat, ro + lane * 8 + 512 * jp, xv[2 * jp], xv[2 * jp + 1]); else stx8<false>(octx, ro + lane * 8 + 512 * jp, xv[2 * jp], xv[2 * jp + 1]); }
    }
}
__device__ __forceinline__ void conv_phase(const Frame& F, int l, const bf16_t* __restrict__ LX, bf16_t* __restrict__ U) {
    PHASE_IDS;
    const float* cw = F_IN(I_CONVW) + l * 4 * DM; const float* cb = F_IN(I_CONVB) + l * DM;
    const int gt = F.c * NTHR + tid, ch = (gt & 127) * 8, rstep = (F.G * NTHR) >> 7;
    f32x4 w0[4], w1[4];
#pragma unroll
    for (int k = 0; k < 4; ++k) { w0[k] = *(const f32x4*)(cw + k * DM + ch); w1[k] = *(const f32x4*)(cw + k * DM + ch + 4); }
    const f32x4 b0 = *(const f32x4*)(cb + ch), b1 = *(const f32x4*)(cb + ch + 4);
#pragma unroll 2
    for (int row = gt >> 7; row < MTOT; row += rstep) {
        int t, ls; if (row < MLAT) { t = row & (SEQ - 1); ls = SEQ; } else { t = (row - MLAT) & (CTXL - 1); ls = CTXL; }
        f32x4 a0 = b0, a1 = b1;
#pragma unroll
        for (int k = 0; k < 4; ++k) { const int tt = t + k - 2; if (tt >= 0 && tt < ls) { f32x4 x0, x1; pg8::unpack8(*(const u32x4*)(LX + (size_t)(row + k - 2) * DM + ch), x0, x1);
                a0 += x0 * w0[k]; a1 += x1 * w1[k]; } }
        *(u32x4*)(U + (size_t)row * DM + ch) = pg8::pack8(a0, a1);
    }
}
__device__ __forceinline__ void pool_phase(const Frame& F, const bf16_t* __restrict__ Z2, bf16_t* __restrict__ MP) {
    PHASE_IDS;
    for (int task = F.c * NTHR + tid; task < (MTOT / 33) * 128; task += F.G * NTHR) {
        const int c8 = task & 127, row0 = (task >> 7) * 33, ch = c8 * 8, hw = 1 << (c8 >> 5);
        f32x4 s0 = {0.f, 0.f, 0.f, 0.f}, s1 = {0.f, 0.f, 0.f, 0.f};
#pragma unroll 3
        for (int d = 0; d < 33; ++d) { const int row = row0 + d; int t, ls; if (row < MLAT) { t = row & (SEQ - 1); ls = SEQ; } else { t = (row - MLAT) & (CTXL - 1); ls = CTXL; }
            const bf16_t* z = Z2 + (size_t)row * Z2LD + ch;
            if (d == 0 || t == 0) { s0 = (f32x4){0.f, 0.f, 0.f, 0.f}; s1 = s0;
                for (int tt = max(t - hw, 0); tt < min(t + hw, ls); ++tt) { f32x4 x0, x1; pg8::unpack8(*(const u32x4*)(z + (long)(tt - t) * Z2LD), x0, x1); s0 += x0; s1 += x1; } }
            const int lo = max(t - hw, 0), hi = min(t + hw, ls);
            f32x4 u0, u1; pg8::unpack8(*(const u32x4*)z, u0, u1);
            const float inv = 1.f / (float)(hi - lo);
            *(u32x4*)(MP + (size_t)row * DM + ch) = pg8::pack8(s0 * inv - u0, s1 * inv - u1);
            if (t + hw < ls) { f32x4 x0, x1; pg8::unpack8(*(const u32x4*)(z + (long)hw * Z2LD), x0, x1); s0 += x0; s1 += x1; }
            if (t - hw >= 0) { f32x4 x0, x1; pg8::unpack8(*(const u32x4*)(z - (long)hw * Z2LD), x0, x1); s0 -= x0; s1 -= x1; } }
    }
}
__device__ __forceinline__ void mla_prep_phase(const Frame& F, const bf16_t* __restrict__ Z2, unsigned char* __restrict__ KR) {
    PHASE_IDS;
    float* rq = (float*)(F_WS + WS_RSTDQ); float* rkv = (float*)(F_WS + WS_RSTDKV); const f32x2* rope = (const f32x2*)(F_WS + WS_ROPE);
    const int i = lane & 15, g = lane >> 4;
    for (int r0 = gw * 4; r0 < MTOT; r0 += F.ngw * 4) { const int row = r0 + g;
        const bf16_t* zr = Z2 + (size_t)row * Z2LD + 1024 + 8 * i;
        float sq = 0.f, skv = 0.f; f32x4 k0 = {0.f, 0.f, 0.f, 0.f}, k1 = k0;
#pragma unroll
        for (int c = 0; c < 6; ++c) { if (c < 5 || i < 8) { f32x4 a0, a1; pg8::unpack8(*(const u32x4*)(zr + 128 * c), a0, a1);
                const float s = (a0[0] * a0[0] + a0[1] * a0[1]) + (a0[2] * a0[2] + a0[3] * a0[3]) + (a1[0] * a1[0] + a1[1] * a1[1]) + (a1[2] * a1[2] + a1[3] * a1[3]);
                if (c < 3) sq += s; else if (c < 5) skv += s; else { k0 = a0; k1 = a1; } } }
#pragma unroll
        for (int o = 1; o < 16; o <<= 1) { sq += __shfl_xor(sq, o); skv += __shfl_xor(skv, o); }
        if (i == 0) { rq[row] = rsqrtf(sq * (1.f / QLORA) + RMS_EPS); rkv[row] = rsqrtf(skv * (1.f / KVLORA) + RMS_EPS); }
        float xo[8], xp[8];
#pragma unroll
        for (int j = 0; j < 4; ++j) { xo[j] = k0[j]; xo[4 + j] = k1[j]; }
#pragma unroll
        for (int j = 0; j < 8; ++j) xp[j] = __shfl_xor(xo[j], 2);
        int b, s, pos; if (row < MLAT) { b = row >> 13; s = row & (SEQ - 1); pos = s; } else { const int rc = row - MLAT; b = rc >> 8; s = SEQ + (rc & (CTXL - 1)); pos = SEQ; }
        const int axis = (i >> 2) & 1, half = (i >> 1) & 1, f0 = 8 * (i & 1);
        float res[8];
#pragma unroll
        for (int j = 0; j < 8; ++j) { const f32x2 cs = rope[(size_t)pos * 32 + axis * 16 + f0 + j];
            const float x1 = half ? xp[j] : xo[j], x2 = half ? xo[j] : xp[j];
            res[j] = half ? (x2 * cs.x + x1 * cs.y) : (x1 * cs.x - x2 * cs.y); }
        float rp[8];
#pragma unroll
        for (int j = 0; j < 8; ++j) rp[j] = __shfl_xor(res[j], 2);
        if (i < 8 && half == 0) {
            int w[4];
#pragma unroll
            for (int q = 0; q < 4; ++q) { int v = 0; v = __builtin_amdgcn_cvt_pk_fp8_f32(res[2 * q], rp[2 * q], v, false); v = __builtin_amdgcn_cvt_pk_fp8_f32(res[2 * q + 1], rp[2 * q + 1], v, true); w[q] = v; }
            *(u32x4*)(KR + ((size_t)b * SKV + s) * 64 + axis * 32 + 2 * f0) = (u32x4){(unsigned)w[0], (unsigned)w[1], (unsigned)w[2], (unsigned)w[3]}; }
    }
}
__device__ __forceinline__ int scan_row(int b, int dir, int tau) {
    if (dir == 0) return tau < CTXL ? MLAT + b * CTXL + tau : b * SEQ + (tau - CTXL);
    return tau < CTXL ? MLAT + b * CTXL + (CTXL - 1 - tau) : b * SEQ + (SEQ - 1 - (tau - CTXL));
}
__device__ __forceinline__ void scan_coef(unsigned la, unsigned gx, f32x2& a, f32x2& bb) {
    a.x = __builtin_amdgcn_exp2f(1.4426950408889634f * bf_lo(la)); a.y = __builtin_amdgcn_exp2f(1.4426950408889634f * bf_hi(la));
    bb.x = __builtin_amdgcn_sqrtf(fmaxf(1.f - a.x * a.x, 0.f)) * bf_lo(gx); bb.y = __builtin_amdgcn_sqrtf(fmaxf(1.f - a.y * a.y, 0.f)) * bf_hi(gx);
}
__device__ __forceinline__ float gelu_tanh_(float g) {
    const float u = 0.7978845608028654f * (g + 0.044715f * g * g * g); return g * __builtin_amdgcn_rcpf(1.f + __builtin_amdgcn_exp2f(-2.8853900817779268f * u));
}
__device__ __forceinline__ void scan_coef8(const u32x4 om, const u32x4 bb, f32x4& a0, f32x4& a1, f32x4& b0, f32x4& b1) {
    f32x4 o0, o1; pg8::unpack8(om, o0, o1); pg8::unpack8(bb, b0, b1); a0 = 1.f - o0; a1 = 1.f - o1;
}
__device__ __forceinline__ void scan_a_phase(const Frame& F, int dir, const bf16_t* __restrict__ LA, const bf16_t* __restrict__ GX) {
    PHASE_IDS;
    float* SA = (float*)(F_WS + WS_SUMA); float* SB = (float*)(F_WS + WS_SUMB);
    for (int task = wave * F.G + F.c; task < NB * NCHUNK * 2; task += F.ngw) {
        const int cb = task & 1, j = (task >> 1) % NCHUNK, b = (task >> 1) / NCHUNK, ch = cb * 512 + 8 * lane;
        f32x4 A0 = {1.f, 1.f, 1.f, 1.f}, A1 = A0, B0 = {0.f, 0.f, 0.f, 0.f}, B1 = B0;
        long off = (long)scan_row(b, dir, j * 64) * DM + ch; const long STP = dir == 0 ? (long)DM : -(long)DM;
        u32x4 laA[8], gxA[8], laB[8], gxB[8];
#define SA_LOAD(la, gx, o0) do { _Pragma("unroll") for (int k = 0; k < 8; ++k) { la[k] = *(const u32x4*)(LA + (o0) + k * STP); gx[k] = *(const u32x4*)(GX + (o0) + k * STP); } } while (0)
#define SA_STEP(la, gx) do { _Pragma("unroll") for (int k = 0; k < 8; ++k) { f32x4 a0, a1, b0, b1; scan_coef8(la[k], gx[k], a0, a1, b0, b1); B0 = a0 * B0 + b0; B1 = a1 * B1 + b1; A0 = A0 * a0; A1 = A1 * a1; } } while (0)
        SA_LOAD(laA, gxA, off);
#pragma unroll 1
        for (int s0 = 0; s0 < 64; s0 += 16) {
            SA_LOAD(laB, gxB, off + 8 * STP);
            SA_STEP(laA, gxA);
            if (s0 + 16 < 64) SA_LOAD(laA, gxA, off + 16 * STP);
            SA_STEP(laB, gxB);
            off += 16 * STP;
        }
#undef SA_LOAD
#undef SA_STEP
        float* pa = SA + ((size_t)b * NCHUNK + j) * DM + ch; float* pb = SB + ((size_t)b * NCHUNK + j) * DM + ch;
        *(f32x4*)pa = A0; *(f32x4*)(pa + 4) = A1; *(f32x4*)pb = B0; *(f32x4*)(pb + 4) = B1;
    }
}
template <int DIR> __device__ __forceinline__ void scan_b_phase(const Frame& F, const bf16_t* __restrict__ LA, const bf16_t* __restrict__ GX, bf16_t* HF, const bf16_t* __restrict__ LG) {
    PHASE_IDS;
    const float* SA = (const float*)(F_WS + WS_SUMA); const float* SB = (const float*)(F_WS + WS_SUMB);
    for (int task = wave * F.G + F.c; task < NB * NCHUNK * 2; task += F.ngw) {
        const int cb = task & 1, j = (task >> 1) % NCHUNK, b = (task >> 1) / NCHUNK, ch = cb * 512 + 8 * lane;
        f32x4 h0 = {0.f, 0.f, 0.f, 0.f}, h1 = h0;
#pragma unroll 8
        for (int jj = 0; jj < j; ++jj) { const float* pa = SA + ((size_t)b * NCHUNK + jj) * DM + ch; const float* pb = SB + ((size_t)b * NCHUNK + jj) * DM + ch;
            h0 = *(const f32x4*)pa * h0 + *(const f32x4*)pb; h1 = *(const f32x4*)(pa + 4) * h1 + *(const f32x4*)(pb + 4); }
        long off = (long)scan_row(b, DIR, j * 64) * DM + ch; constexpr long STP = DIR == 0 ? (long)DM : -(long)DM;
        u32x4 laA[4], gxA[4], hfA[4], lgA[4], laB[4], gxB[4], hfB[4], lgB[4];
#define SB_LOAD(la, gx, hf, lg, o0) do { _Pragma("unroll") for (int k = 0; k < 4; ++k) { const long o = (o0) + k * STP; la[k] = *(const u32x4*)(LA + o); gx[k] = *(const u32x4*)(GX + o); \
            if (DIR == 1) { hf[k] = *(const u32x4*)(HF + o); lg[k] = *(const u32x4*)(LG + o); } } } while (0)
#define SB_STEP(la, gx, hf, lg, o0) do { _Pragma("unroll") for (int k = 0; k < 4; ++k) { f32x4 a0, a1, b0, b1; scan_coef8(la[k], gx[k], a0, a1, b0, b1); \
            h0 = a0 * h0 + b0; h1 = a1 * h1 + b1; \
            if (DIR == 0) hf[k] = pg8::pack8(h0, h1); \
            else { f32x4 f0, f1, g0, g1; pg8::unpack8(hf[k], f0, f1); pg8::unpack8(lg[k], g0, g1); \
                f0 = (f0 + h0) * g0; f1 = (f1 + h1) * g1; \
                hf[k] = pg8::pack8(f0, f1); } } \
        _Pragma("unroll") for (int k = 0; k < 4; ++k) *(u32x4*)(HF + (o0) + k * STP) = hf[k]; } while (0)
        SB_LOAD(laA, gxA, hfA, lgA, off);
#pragma unroll 1
        for (int s0 = 0; s0 < 64; s0 += 8) {
            SB_LOAD(laB, gxB, hfB, lgB, off + 4 * STP);
            SB_STEP(laA, gxA, hfA, lgA, off);
            if (s0 + 8 < 64) SB_LOAD(laA, gxA, hfA, lgA, off + 8 * STP);
            SB_STEP(laB, gxB, hfB, lgB, off + 4 * STP);
            off += 8 * STP;
        }
#undef SB_LOAD
#undef SB_STEP
    }
}
__device__ __forceinline__ void moe_tile_table(const Frame& F, volatile LAS int* tend) {
    PHASE_IDS;
    if (tid == 0) { const unsigned* cnt = (const unsigned*)(F_WS + WS_CTL) + CW_CNT; int acc = 0;
        for (int e = 0; e < 8; ++e) { acc += ((int)__hip_atomic_load(cnt + 64 * e, __ATOMIC_RELAXED, __HIP_MEMORY_SCOPE_AGENT) + 255) >> 8; tend[e] = acc; } }
    __syncthreads();
}
__device__ __forceinline__ void moe_gather_phase(const Frame& F, const unsigned char* __restrict__ H2, unsigned char* __restrict__ XG) {
    PHASE_IDS;
    volatile LAS int* tend = (volatile LAS int*)(F.lds + MISC_OFF + 64);
    volatile LAS int* hist = (volatile LAS int*)(F.lds + 0); volatile LAS int* lbase = (volatile LAS int*)(F.lds + 64); volatile LAS int* dl = (volatile LAS int*)(F.lds + 128);
    moe_tile_table(F, tend);
    const int* e12 = (const int*)(F_WS + WS_E12); int* dest = (int*)(F_WS + WS_DEST); unsigned* cur = (unsigned*)(F_WS + WS_CTL) + CW_CUR;
    for (int blk = F.c; blk < MLAT / 128; blk += F.G) {
        if (tid < 8) hist[tid] = 0;
        __syncthreads();
        int e1 = 0, e2 = 0, r1 = 0, r2 = 0; const int tok = blk * 128 + tid;
        if (tid < 128) { const int w = e12[tok]; e1 = w & 255; e2 = (w >> 8) & 255; r1 = atomicAdd((int*)&hist[e1], 1); r2 = atomicAdd((int*)&hist[e2], 1); }
        __syncthreads();
        if (tid < 8) { const int base = (int)atomicAdd(cur + 64 * tid, (unsigned)hist[tid]); lbase[tid] = (tid == 0 ? 0 : tend[tid - 1]) * 256 + base; }
        __syncthreads();
        if (tid < 128) { const int d1 = lbase[e1] + r1, d2 = lbase[e2] + r2; dest[2 * tok] = d1; dest[2 * tok + 1] = d2; dl[2 * tid] = d1; dl[2 * tid + 1] = d2; }
        __syncthreads();
        for (int a = wave; a < 256; a += NWAVES) { const int d = dl[a]; const unsigned char* src = H2 + (size_t)(blk * 128 + (a >> 1)) * DM; unsigned char* dst = XG + (size_t)d * DM;
            *(u32x4*)(dst + 16 * lane) = *(const u32x4*)(src + 16 * lane); }
        __syncthreads();
    }
}

constexpr int PH_PRO0 = 0, PH_PRO1 = 1, PH_L0 = 2;
constexpr int LP_NORM = 0, LP_IN1 = 1, LP_CONV = 2, LP_GATE0 = 3, LP_SCANA0 = 4, LP_SCANB0 = 5, LP_GATE1 = 6, LP_SCANA1 = 7, LP_SCANB1 = 8, LP_MID = 9, LP_ATTN = 10,
              LP_GT = 11, LP_OUT1 = 12, LP_OUT2 = 13, LP_RES1 = 14, LP_F0 = 15;
constexpr int L0_NPH = 18;
constexpr int PH_L1 = PH_L0 + L0_NPH;
constexpr int L1_NPH = 15 + 1 + 10 + 1;
constexpr int NPHASES = PH_L1 + L1_NPH;

#ifdef PH_ONLY
#define IN(k) ((k) == PH_ONLY && in_range(A0, (k)))
#else
#define IN(k) in_range(A0, (k))
#endif
#define FRAME const Frame F = make_frame(A0, wave0)
__device__ __forceinline__ void grid_bar(ArgsP A0, int wave0) {
    extern __shared__ __attribute__((aligned(16))) unsigned char lds_raw[];
    XcdBarrier b; b.bar = bar_words(launder(A0)->ws); b.x = xb_xcc_id(); b.st = (volatile LAS unsigned*)((LAS unsigned char*)lds_raw + MISC_OFF); b.wave = wave0;
    xcd_barrier(b);
}
#define SEAM(k) do { if (!MK_PER_PHASE && IN((k) + 1)) { grid_bar(A0, wave0); } } while (0)
#define DYNP(off) ((bf16_t*)(F_WS + WS_DYN + (off)))

template <int L> __device__ __forceinline__ void layer_phases(ArgsP A0, const int wave0) {
    constexpr int P = L == 0 ? PH_L0 : PH_L1;
    constexpr size_t WL = WS_WTS + L * WTS_LSTRIDE;
    constexpr int nrows = L == 0 ? MTOT : MLAT, nmt = nrows / 256;
#define X1 ((bf16_t*)F_OUT)
#define X2 ((bf16_t*)F_OUT + (size_t)MLAT * DM)
#define X3 DYNP(D_HF)
#define XCTX (L == 0 ? F_IN(I_CTX) : (const float*)(F_WS + WS_XC))
#define XCOUT ((float*)(F_WS + WS_XC))

    if (IN(P + LP_NORM)) { FRAME;
        if constexpr (L == 0) norm1_phase<false>(F, L, F_IN(I_X), XCTX, DYNP(D_H), (unsigned char*)DYNP(D_H8), MTOT);
        else norm1_phase<true>(F, L, X2, XCTX, DYNP(D_H), (unsigned char*)DYNP(D_H8), MTOT);
        SEAM(P + LP_NORM); }
    if (IN(P + LP_IN1)) { FRAME;
        pg8::GridSched S{(const char*)DYNP(D_H), (const char*)(F_WS + WL + WO_IN1), MTOT / 256, 15, 16, DM, DM, F.G, F.c, 0, 0};
        pg8::EpiIn1 E{DYNP(D_LX), DYNP(D_LG), DYNP(D_Z2)};
        pg8::gemm_phase(F.lds, F.wave, DM, DM, S, E);
        SEAM(P + LP_IN1);
    }
    if (IN(P + LP_CONV)) { FRAME; conv_phase(F, L, DYNP(D_LX), DYNP(D_U)); mla_prep_phase(F, DYNP(D_Z2), (unsigned char*)(F_WS + WS_KR)); SEAM(P + LP_CONV); }
#pragma unroll
    for (int d = 0; d < 2; ++d) {
        const int pg = P + (d == 0 ? LP_GATE0 : LP_GATE1);
        if (IN(pg)) { FRAME;
            pg8::GateSched S{(const char*)DYNP(D_U), (const char*)(F_WS + WL + WO_GATE), MTOT / 256, F.G, F.c, d};
            pg8::EpiGates E{DYNP(D_LA), DYNP(D_GX), DYNP(D_U), F_IN(I_GAB) + (L * 2 + d) * 1024, F_IN(I_GXB) + (L * 2 + d) * 1024, (const float*)(F_WS + WS_SP8) + (L * 2 + d) * 1024};
            pg8::gemm_phase(F.lds, F.wave, DM, 128, S, E);
            SEAM(pg);
        }
        if (IN(pg + 1)) { FRAME; scan_a_phase(F, d, DYNP(D_LA), DYNP(D_GX)); SEAM(pg + 1); }
        if (IN(pg + 2)) { FRAME; if (d == 0) scan_b_phase<0>(F, DYNP(D_LA), DYNP(D_GX), DYNP(D_HF), DYNP(D_LG)); else scan_b_phase<1>(F, DYNP(D_LA), DYNP(D_GX), DYNP(D_HF), DYNP(D_LG)); SEAM(pg + 2); }
    }
    if (IN(P + LP_MID)) { FRAME;
        pool_phase(F, DYNP(D_Z2), DYNP(D_MP));
        { pg8::GridSched S{(const char*)(DYNP(D_Z2) + 1024), (const char*)(F_WS + WL + WO_UQ), nmt, 6, 6, Z2LD, QLORA, F.G, F.c, 0, 0};
          pg8::EpiQ E{(unsigned char*)DYNP(D_Q), (unsigned char*)(F_WS + WS_QC), (const float*)(F_WS + WS_RSTDQ), (const f32x2*)(F_WS + WS_ROPE)};
          pg8::gemm_phase(F.lds, F.wave, Z2LD, QLORA, S, E); }
        { pg8::GridSched S{(const char*)(DYNP(D_Z2) + 1024 + QLORA), (const char*)(F_WS + WL + WO_UKV), MTOT / 256, 4, 4, Z2LD, KVLORA, F.G, (F.c + 128) % F.G, 0, 0};
          pg8::EpiK E{(unsigned char*)DYNP(D_K), (const float*)(F_WS + WS_RSTDKV)};
          pg8::gemm_phase(F.lds, F.wave, Z2LD, KVLORA, S, E); }
        { pg8::GridSched S{(const char*)(F_WS + WL + WO_UKV + 1024 * KVLORA * 2), (const char*)(DYNP(D_Z2) + 1024 + QLORA), 4, MTOT / 256, 4, KVLORA, Z2LD, F.G, (F.c + 64) % F.G, 0, 0};
          pg8::EpiVT E{(unsigned char*)DYNP(D_V), (const float*)(F_WS + WS_RSTDKV)};
          pg8::gemm_phase(F.lds, F.wave, KVLORA, Z2LD, S, E); }
        SEAM(P + LP_MID);
    }
    if (IN(P + LP_ATTN)) { FRAME;
        const char* Qb = (const char*)DYNP(D_Q); const char* Kb = (const char*)DYNP(D_K); const char* Vb = (const char*)DYNP(D_V); char* AO = (char*)DYNP(D_AO); const char* QC = (const char*)((bf16_t*)(F_WS + WS_QC));
#pragma unroll 1
        for (int t = F.c; t < 1024 + (L == 0 ? 32 : 0); t += F.G) {
            const bool lat = t < 1024; const int cc = t & 255, bh = lat ? (t >> 8) * 8 + (cc & 7) : t - 1024, qb = cc >> 3, b = bh >> 3, h = bh & 7;
            const char* q = lat ? Qb + ((size_t)bh * SEQ + qb * 256) * DQK : QC + (size_t)bh * CTXL * DQK;
            const size_t k0 = (size_t)bh * SKV + (lat ? 0 : SEQ), kr0 = (size_t)b * SKV + (lat ? 0 : SEQ);
            char* o = AO + ((size_t)(lat ? b * SEQ + qb * 256 : MLAT + b * CTXL) * DM + h * DVH) * 2;
            att::attn_unit(q, Kb + k0 * 128, (const char*)(F_WS + WS_KR) + kr0 * 64, Vb + k0 * 128, o, lat ? SKV : CTXL, F.lds, F.wave);
        }
        __syncthreads();
        SEAM(P + LP_ATTN);
    }
    if (IN(P + LP_GT)) { FRAME;
        pg8::GridSched S{(const char*)DYNP(D_H8), (const char*)(F_WS + WL + WO_GT), nmt, 12, 8, DM / 2, DM / 2, F.G, F.c, 0, 0};
        pg8::EpiStore<1> E{DYNP(D_GT), 3072, 0, 1.f / 32.f};
        pg8::gemm_phase<pg8::EpiStore<1>, pg8::GridSched, true>(F.lds, F.wave, DM / 2, DM / 2, S, E);
        SEAM(P + LP_GT);
    }
    if (IN(P + LP_OUT1)) { FRAME;
        pg8::FatSched S{(const char*)(F_WS + WS_DYN), (const char*)(F_WS + WL), nmt, F.G, F.c};
        pg8::EpiOut1 E{DYNP(D_GT), DYNP(D_MG)};
        pg8::gemm_phase(F.lds, F.wave, DM, DM, S, E);
        SEAM(P + LP_OUT1);
    }
    if (IN(P + LP_OUT2)) { FRAME;
        pg8::GridSched S{(const char*)DYNP(D_MG), (const char*)(F_WS + WL + WO_OUT), nmt, 4, 16, DM, DM, F.G, F.c, 0, 0};
        pg8::EpiStore<0> E{DYNP(D_Y), DM, 0};
        pg8::gemm_phase(F.lds, F.wave, DM, DM, S, E);
        SEAM(P + LP_OUT2);
    }
    if constexpr (L == 0) {
        if (IN(P + LP_RES1)) { FRAME; resid1_phase<false, false, true>(F, L, F_IN(I_X), XCTX, X1, XCOUT, DYNP(D_Y), DYNP(D_H2), nrows); SEAM(P + LP_RES1); }
        if (IN(P + LP_F0)) { FRAME;
            pg8::GridSched S{(const char*)DYNP(D_H2), (const char*)(F_WS + WS_W13), nmt, 22, 16, DM, DM, F.G, F.c, 0, 0};
            pg8::EpiSwiglu8 E{(unsigned char*)DYNP(D_HID), DFF, 1.f};
            pg8::gemm_phase(F.lds, F.wave, DM, DM, S, E);
            SEAM(P + LP_F0);
        }
        if (IN(P + LP_F0 + 1)) { FRAME;
            pg8::GridSched S{(const char*)DYNP(D_HID), (const char*)(F_WS + WS_W2), nmt, 4, 22, DFF / 2, DFF / 2, F.G, F.c, 0, 0};
            pg8::EpiStoreS E{DYNP(D_F), DM, 0, 1.f / 64.f};
            pg8::gemm_phase<pg8::EpiStoreS, pg8::GridSched, true>(F.lds, F.wave, DFF / 2, DFF / 2, S, E);
            SEAM(P + LP_F0 + 1);
        }
        if (IN(P + LP_F0 + 2)) { FRAME; resid2_phase<false, true, true>(F, L, X1, XCOUT, X2, XCOUT, DYNP(D_F), nrows); SEAM(P + LP_F0 + 2); }
    } else {
        if (IN(P + LP_RES1)) { FRAME;
            resid1_phase<true, true, true>(F, L, X2, XCTX, X3, XCOUT, DYNP(D_Y), DYNP(D_H2), nrows);
            __syncthreads();
            int it0 = 0;
#pragma unroll 1
            for (int e = 0; e < NEXP; ++e) {
                wprep_fast8(F, it0, 1024, 7168, (unsigned char*)DYNP(D_WM13) + (size_t)e * 7168 * 1024, FastW13{F_IN(I_MOEW1) + (size_t)e * DM * EFF, (long)(F_IN(I_MOEW3) - F_IN(I_MOEW1)), EFF}, 32.f);
                wprep_fast8(F, it0, 3584, 1024, (unsigned char*)DYNP(D_WM2) + (size_t)e * 1024 * 3584, FastPlain{F_IN(I_MOEW2) + (size_t)e * EFF * DM, DM}, 64.f);
            }
            SEAM(P + LP_RES1);
        }
        if (IN(P + LP_F0)) { FRAME; moe_gather_phase(F, (const unsigned char*)DYNP(D_H2), (unsigned char*)DYNP(D_XG)); SEAM(P + LP_F0); }
        volatile LAS int* tend; { FRAME; tend = (volatile LAS int*)(F.lds + MISC_OFF + 64); }
#pragma unroll 1
        for (int g = 0; g < 5; ++g) {
            const int p13 = P + LP_F0 + 1 + 2 * g;
            if (!(IN(p13) || IN(p13 + 1))) continue;
            { FRAME; moe_tile_table(F, tend); }
#define TE(j) __builtin_amdgcn_readfirstlane(tend[j])
            const int ntiles = TE(7), t0 = g * 64, nM = min(64, ntiles - t0);
            if (IN(p13)) { FRAME;
                if (nM > 0) { pg8::MoeSched S{(const char*)DYNP(D_XG), (const char*)DYNP(D_WM13), {TE(0), TE(1), TE(2), TE(3), TE(4), TE(5), TE(6)}, (size_t)7168 * 1024, nM, 28, 8, DM / 2, DM / 2, F.G, F.c, t0, t0};
                    pg8::EpiSwiglu8 E{(unsigned char*)DYNP(D_HIDG), EFF};
                    pg8::gemm_phase<pg8::EpiSwiglu8, pg8::MoeSched, true>(F.lds, F.wave, DM / 2, DM / 2, S, E); }
                SEAM(p13);
            }
            if (IN(p13 + 1)) { FRAME;
                if (nM > 0) { pg8::MoeSched S{(const char*)DYNP(D_HIDG), (const char*)DYNP(D_WM2), {TE(0), TE(1), TE(2), TE(3), TE(4), TE(5), TE(6)}, (size_t)1024 * 3584, nM, 4, 28, EFF / 2, EFF / 2, F.G, F.c, t0, 0};
                    pg8::EpiStoreS E{DYNP(D_YR), DM, t0 * 256, 1.f / 64.f};
                    pg8::gemm_phase<pg8::EpiStoreS, pg8::MoeSched, true>(F.lds, F.wave, EFF / 2, EFF / 2, S, E); }
                SEAM(p13 + 1);
            }
        }
        if (IN(P + LP_F0 + 11)) { FRAME; resid2_phase<true, true, false>(F, L, X3, XCOUT, F_OUT, XCOUT, DYNP(D_YR), nrows); }
    }
#undef X1
#undef X2
#undef X3
#undef XCTX
#undef XCOUT
}

__global__ void __launch_bounds__(NTHR, 2) mega_fwd(Args args) {
    ArgsP A0 = (ArgsP)__builtin_amdgcn_kernarg_segment_ptr();
    (void)args;
    const int wave0 = __builtin_amdgcn_readfirstlane((int)threadIdx.x >> 6);
    { FRAME;
      volatile LAS unsigned* MISC = (volatile LAS unsigned*)(F.lds + MISC_OFF);
      const int tid0 = fresh_tid(F.wave); for (int u = tid0; u < (LDS_BYTES - MISC_OFF) / 4; u += NTHR) MISC[u] = 0u;
      __syncthreads();
      if (!MK_PER_PHASE) (void)xcd_barrier_post(bar_words(F_WS), MISC, F.wave);
    }

    if (IN(PH_PRO0)) { FRAME;
        mod_partials(F);
        rope_and_consts(F);
        int it0 = 0;
#pragma unroll 1
        for (int l = 0; l < 2; ++l) {
            unsigned char* wl = F_WS + WS_WTS + l * WTS_LSTRIDE;
            wprep_fast(F, it0, 1024, 3840, (bf16_t*)(wl + WO_IN1), FastIn1{F_IN(I_WIN) + (size_t)l * DM * INCOLS, INCOLS});
            wprep_fast8(F, it0, 1024, 3072, (unsigned char*)(wl + WO_GT), FastPlain{F_IN(I_WIN) + (size_t)l * DM * INCOLS + 3776, INCOLS}, 32.f);
#pragma unroll 1
            for (int nb = 0; nb < 8; ++nb)
                wprep_job(F, it0, 128, 512, (bf16_t*)(wl + WO_GATE) + (size_t)nb * 512 * 128, SrcGate{F_IN(I_GAW) + (size_t)l * 2 * 8 * 128 * 128, (long)(F_IN(I_GXW) - F_IN(I_GAW)), nb});
            wprep_job(F, it0, 1024, 1024, (bf16_t*)(wl + WO_LRU), SrcPlainS{F_IN(I_LRUPROJ) + (size_t)l * DM * DM, DM, ((ABL & 2) && ((ABL_L >> l) & 1)) ? 0.f : 1.f});
            wprep_job(F, it0, 384, 1536, (bf16_t*)(wl + WO_UQ), SrcUQ{F_IN(I_WUQ) + (size_t)l * 384 * 1536, F_IN(I_QNORMG) + l * 384});
            wprep_job(F, it0, 256, 2048, (bf16_t*)(wl + WO_UKV), SrcUKV{F_IN(I_WUKV) + (size_t)l * 256 * 2048, F_IN(I_KVNORMG) + l * 256});
            wprep_job(F, it0, 1024, 1024, (bf16_t*)(wl + WO_MLA), SrcPlainS{F_IN(I_MLAPROJ) + (size_t)l * DM * DM, DM, ((ABL & 4) && ((ABL_L >> l) & 1)) ? 0.f : 1.f});
            wprep_fast(F, it0, 1024, 1024, (bf16_t*)(wl + WO_OUT), FastPlain{F_IN(I_WOUT) + (size_t)l * DM * DM, DM});
        }
        wprep_fast(F, it0, 1024, 5632, (bf16_t*)(F_WS + WS_W13), FastW13{F_IN(I_FFNW1), (long)(F_IN(I_FFNW3) - F_IN(I_FFNW1)), DFF});
        wprep_fast8(F, it0, 2816, 1024, (unsigned char*)(F_WS + WS_W2), FastPlain{F_IN(I_FFNW2), DM}, 64.f);
        SEAM(PH_PRO0);
    }
    if (IN(PH_PRO1)) { FRAME;
        mod_reduce(F);
        pool_weights_phase(F);
        SEAM(PH_PRO1);
    }
    layer_phases<0>(A0, wave0);
    layer_phases<1>(A0, wave0);
}
#undef IN
#undef SEAM

extern "C" void kernel_launch(void* const* d_in, const int* in_sizes, int n_in, void* d_out, int out_size, void* d_ws, size_t ws_size, hipStream_t stream) {
    static int grid = 0;
    if (grid == 0) {
        if (n_in != 35 || out_size != MLAT * DM || ws_size < WS_END) { fprintf(stderr, "kernel_launch: unexpected shapes (n_in %d, out %d, ws %zu < %zu)\n", n_in, out_size, ws_size, (size_t)WS_END); grid = -1; return; }
        int dev = 0, cus = 0;
        if (hipGetDevice(&dev) != hipSuccess || hipDeviceGetAttribute(&cus, hipDeviceAttributeMultiprocessorCount, dev) != hipSuccess) { grid = -1; return; }
        if (hipFuncSetAttribute((const void*)mega_fwd, hipFuncAttributeMaxDynamicSharedMemorySize, LDS_BYTES) != hipSuccess) { fprintf(stderr, "kernel_launch: hipFuncSetAttribute failed\n"); grid = -1; return; }
        int per_cu = 0;
        if (hipOccupancyMaxActiveBlocksPerMultiprocessor(&per_cu, (const void*)mega_fwd, NTHR, LDS_BYTES) != hipSuccess || per_cu < 1) { fprintf(stderr, "kernel_launch: occupancy query says %d\n", per_cu); }
        (void)hipGetLastError();
        grid = cus;
    }
    if (grid < 0) return;
    (void)hipMemsetAsync((char*)d_ws + WS_CTL, 0, CTL_BYTES, stream);
    Args a{};
    for (int i = 0; i < 35; ++i) a.in[i] = (const float*)d_in[i];
    a.out = (float*)d_out; a.ws = (unsigned char*)d_ws;
#if MK_PER_PHASE
    for (int p = 0; p < NPHASES; ++p) { a.ph_lo = p; a.ph_hi = p + 1; hipLaunchKernelGGL(mega_fwd, dim3(grid), dim3(NTHR), LDS_BYTES, stream, a); }
#else
    a.ph_lo = 0; a.ph_hi = NPHASES;
    hipLaunchKernelGGL(mega_fwd, dim3(grid), dim3(NTHR), LDS_BYTES, stream, a);
#endif
}
```

```cpp
#include <hip/hip_runtime.h>
#include <stdint.h>
#include <stdio.h>

#ifndef ABL
#define ABL 0
#endif
#ifndef ABL_L
#define ABL_L 3
#endif
#ifndef MK_PER_PHASE
#define MK_PER_PHASE 0
#endif

#define LAS __attribute__((address_space(3)))
typedef unsigned short bf16_t;
typedef short bf16x8 __attribute__((ext_vector_type(8)));
typedef short s16x4 __attribute__((ext_vector_type(4)));
typedef float f32x4 __attribute__((ext_vector_type(4)));
typedef float f32x2 __attribute__((ext_vector_type(2)));
typedef float f32x16 __attribute__((ext_vector_type(16)));
typedef unsigned u32x4 __attribute__((ext_vector_type(4)));
typedef unsigned u32x2 __attribute__((ext_vector_type(2)));

constexpr int DM = 1024, NB = 4, SEQ = 8192, CTXL = 256, MLAT = NB * SEQ, MCTX = NB * CTXL, MTOT = MLAT + MCTX;
constexpr int INCOLS = 6848, NH = 8, DQK = 192, DVH = 128, SKV = SEQ + CTXL;
constexpr int QLORA = 384, KVLORA = 256, DFF = 2816, NEXP = 8, EFF = 3584;
constexpr float RMS_EPS = 1e-6f;
constexpr int Z2LD = 1792;
constexpr int NCHUNK = SKV / 64;

constexpr size_t MiB = 1u << 20;
constexpr size_t WS_CTL = 0, CTL_BYTES = 1 * MiB;
constexpr size_t WS_MVEC = 1 * MiB;
constexpr size_t WS_MPART = 2 * MiB;
constexpr size_t WS_KR = 2 * MiB;
constexpr size_t WS_ROPE = 10 * MiB;
constexpr size_t WS_SP8 = 12 * MiB + 512 * 1024;
constexpr size_t WS_RSTDQ = 13 * MiB, WS_RSTDKV = 13 * MiB + 256 * 1024;
constexpr size_t WS_SUMA = 14 * MiB, WS_SUMB = 16 * MiB + 512 * 1024;
constexpr size_t WS_E12 = 19 * MiB, WS_G1 = 19 * MiB + 128 * 1024, WS_DEST = 19 * MiB + 256 * 1024;
constexpr size_t WS_XC = 20 * MiB;
constexpr size_t WS_WTS = 25 * MiB, WTS_LSTRIDE = 25 * MiB;
constexpr size_t WO_IN1 = 0, WO_GT = 7 * MiB + 512 * 1024, WO_POOL = 13 * MiB + 512 * 1024, WO_GATE = 15 * MiB + 512 * 1024, WO_LRU = 16 * MiB + 512 * 1024,
                 WO_UQ = 18 * MiB + 512 * 1024, WO_UKV = 19 * MiB + 640 * 1024, WO_MLA = 20 * MiB + 640 * 1024, WO_OUT = 22 * MiB + 640 * 1024;
constexpr size_t WS_W13 = 75 * MiB, WS_W2 = 86 * MiB, WS_PPT = 91 * MiB + 512 * 1024  , WS_PWS = 95 * MiB + 512 * 1024  ;
constexpr size_t WS_DYN = 97 * MiB;
constexpr size_t SLAB = 66 * MiB;
constexpr size_t HM = 512 * 1024;
constexpr size_t D_H8 = 0  , D_H = 33 * MiB, D_Z2 = 99 * MiB, D_LX = 214 * MiB + HM, D_LA = 214 * MiB + HM, D_LG = 280 * MiB + HM, D_U = 346 * MiB + HM, D_GX = 412 * MiB + HM, D_HF = 478 * MiB + HM;
constexpr size_t D_MP = 33 * MiB, D_K = 214 * MiB + HM, D_V = 280 * MiB + HM, D_Q = 346 * MiB + HM  , D_AO = 99 * MiB;
constexpr size_t D_GT = 214 * MiB + HM, D_MG = 412 * MiB + HM, D_Y = 214 * MiB + HM, D_H2 = 280 * MiB + HM, D_HID = 0, D_F = 346 * MiB + HM;
constexpr size_t D_WM13 = 0, D_WM2 = 56 * MiB, D_XG = 84 * MiB, D_HIDG = 150 * MiB, D_YR = 346 * MiB + HM;
constexpr size_t WS_QC = 6 * MiB + HM;
constexpr size_t WS_END = WS_DYN + 544 * MiB + HM;
constexpr int CW_BAR = 4096, CW_CNT = 8192, CW_CUR = 8192 + 512;

constexpr int STAGE_BYTES = 131072, MISC_OFF = STAGE_BYTES, LDS_BYTES = STAGE_BYTES + 1024;
constexpr int NWAVES = 8, NTHR = 512;

#define LDS_WAIT() asm volatile("s_waitcnt lgkmcnt(0)" ::: "memory")
#define VM_WAIT() asm volatile("s_waitcnt vmcnt(0)" ::: "memory")
typedef __bf16 bf16x2_t __attribute__((ext_vector_type(2)));
__device__ __forceinline__ unsigned cvtpk(float lo, float hi) { const f32x2 v = {lo, hi}; return __builtin_bit_cast(unsigned, __builtin_convertvector(v, bf16x2_t)); }
__device__ __forceinline__ float bf_lo(unsigned w) { return __uint_as_float(w << 16); }
__device__ __forceinline__ float bf_hi(unsigned w) { return __uint_as_float(w & 0xffff0000u); }
__device__ __forceinline__ float bf2f(bf16_t b) { return __uint_as_float(((unsigned)b) << 16); }
__device__ __forceinline__ float wave_sum(float v) {
#pragma unroll
    for (int o = 1; o < 64; o <<= 1) v += __shfl_xor(v, o);
    return v;
}
__device__ __forceinline__ float sigmoidf_(float x) { return __builtin_amdgcn_rcpf(1.f + __builtin_amdgcn_exp2f(-1.4426950408889634f * x)); }

__device__ __forceinline__ int fresh_tid(int wave) { int l; asm volatile("v_mbcnt_lo_u32_b32 %0, -1, 0\n\tv_mbcnt_hi_u32_b32 %0, -1, %0" : "=v"(l)); return wave * 64 + l; }
#define XB_TMO      128
#define XB_XCNT(j)  (256  + 64 * (j))
#define XB_XSUB(j)  (1280 + 64 * (j))
#define XB_XGEN(j)  (2304 + 64 * (j))
#define XB_TOP      3328
#define XB_TOPGEN   3392
#define XCD_BAR_WORDS 3456
#define XB_SPIN_CAP (1u << 18)
__device__ __forceinline__ unsigned xb_ld(unsigned* p)              { return __hip_atomic_load(p, __ATOMIC_RELAXED, __HIP_MEMORY_SCOPE_AGENT); }
__device__ __forceinline__ unsigned xb_add(unsigned* p, unsigned v) { return __hip_atomic_fetch_add(p, v, __ATOMIC_RELAXED, __HIP_MEMORY_SCOPE_AGENT); }
__device__ __forceinline__ unsigned xb_xcc_id() { return (unsigned)__builtin_amdgcn_s_getreg((3 << 11) | 20) & 0xFu; }
#define XB_SPIN(cond, bar) do { unsigned _sp = 0; while (cond) { __builtin_amdgcn_s_sleep(1); \
    if ((++_sp & 255u) == 0u) { if (xb_ld(&(bar)[XB_TMO])) break; if (_sp > XB_SPIN_CAP) { atomicAdd(&(bar)[XB_TMO], 1u); break; } } } } while (0)
struct XcdBarrier { unsigned* bar; unsigned x; volatile LAS unsigned* st; int wave; };
__device__ __forceinline__ XcdBarrier xcd_barrier_post(unsigned* bar, volatile LAS unsigned* st, int wave) {
    XcdBarrier b; b.bar = bar; b.x = xb_xcc_id(); b.st = st; b.wave = wave;
    if (fresh_tid(wave) == 0) (void)xb_add(&bar[XB_XCNT(b.x)], 1u);
    return b;
}
__device__ __forceinline__ void xcd_barrier_complete(unsigned* bar, unsigned x, unsigned& nloc, unsigned& nx) {
    const unsigned G = gridDim.x * gridDim.y * gridDim.z;
    unsigned sum, cnt, mine, sp = 0u;
    for (;;) {
        sum = 0u; cnt = 0u; mine = 0u;
#pragma unroll
        for (unsigned j = 0; j < 16; ++j) { const unsigned c = xb_ld(&bar[XB_XCNT(j)]); sum += c; cnt += (c > 0u) ? 1u : 0u; mine = (j == x) ? c : mine; }
        if (sum == G) break;
        __builtin_amdgcn_s_sleep(1);
        if ((++sp & 255u) == 0u) { if (xb_ld(&bar[XB_TMO])) break; if (sp > XB_SPIN_CAP) { atomicAdd(&bar[XB_TMO], 1u); break; } }
    }
    nloc = mine > 0u ? mine : 1u; nx = cnt > 0u ? cnt : 1u;
}
__device__ __forceinline__ void xcd_barrier(const XcdBarrier& b) {
    asm volatile("s_waitcnt vmcnt(0)" ::: "memory");
    __syncthreads();
    if (fresh_tid(b.wave) == 0) {
        unsigned* bar = b.bar;
        __builtin_amdgcn_s_waitcnt(0);
        unsigned nloc = b.st[0], nx = b.st[1];
        if (nloc == 0u) { xcd_barrier_complete(bar, b.x, nloc, nx); b.st[0] = nloc; b.st[1] = nx; }
        const unsigned old = xb_add(&bar[XB_XSUB(b.x)], 1u);
        const unsigned gen = old / nloc;
        if (old + 1u == (gen + 1u) * nloc) {
            __builtin_amdgcn_fence(__ATOMIC_RELEASE, "agent");
            asm volatile("s_waitcnt vmcnt(0)" ::: "memory");
            const unsigned og = xb_add(&bar[XB_TOP], 1u);
            const unsigned tg = og / nx;
            if (og + 1u == (tg + 1u) * nx) xb_add(&bar[XB_TOPGEN], 1u);
            else XB_SPIN(xb_ld(&bar[XB_TOPGEN]) == tg, bar);
            __builtin_amdgcn_fence(__ATOMIC_ACQUIRE, "agent");
            xb_add(&bar[XB_XGEN(b.x)], 1u);
            asm volatile("s_waitcnt vmcnt(0)" ::: "memory");
        } else {
            XB_SPIN(xb_ld(&bar[XB_XGEN(b.x)]) == gen, bar);
            __builtin_amdgcn_fence(__ATOMIC_ACQUIRE, "agent");
            asm volatile("s_waitcnt vmcnt(0)" ::: "memory");
        }
    }
    __syncthreads();
}

__device__ __forceinline__ unsigned* bar_words(unsigned char* ws) { return (unsigned*)(ws + WS_CTL) + CW_BAR; }
namespace pg8 {
constexpr int BM = 256, BK = 64, HALF = 128, HTB = HALF * BK * 2, NXCD = 8, WGM = 8;
__host__ __device__ __forceinline__ int lds_byte(int r, int c) { const int st = (r >> 4) * 2 + (c >> 5), rr = r & 15, cc = c & 31, ob = rr * 64 + cc * 2; return st * 1024 + (ob ^ (((ob >> 9) & 1) << 5)); }
__host__ __device__ __forceinline__ void stage_rc(int b, int& R, int& C) { const int st = b / 1024, sb = b % 1024, swz = sb ^ (((sb >> 9) & 1) << 5); R = (st >> 1) * 16 + swz / 64; C = (st & 1) * 32 + (swz % 64) / 2; }
__host__ __device__ __forceinline__ int perm32(int rho) { const int n = rho >> 4, i = rho & 15; return 8 * (i >> 2) + 4 * n + (i & 3); }

typedef int i32x8 __attribute__((ext_vector_type(8)));
__device__ __forceinline__ i32x8 cat8(const bf16x8 lo, const bf16x8 hi) { const u32x4 a = __builtin_bit_cast(u32x4, lo), b = __builtin_bit_cast(u32x4, hi); return (i32x8){(int)a.x, (int)a.y, (int)a.z, (int)a.w, (int)b.x, (int)b.y, (int)b.z, (int)b.w}; }
__device__ __forceinline__ const char* uptr(const char* p) {
    const unsigned long long v = (unsigned long long)p; const unsigned lo = __builtin_amdgcn_readfirstlane((unsigned)v), hi = __builtin_amdgcn_readfirstlane((unsigned)(v >> 32));
    return (const char*)(((unsigned long long)hi << 32) | lo); }
template <bool FP8> struct Frag;
template <> struct Frag<false> { bf16x8 k[2]; };
template <> struct Frag<true> { i32x8 v; };
struct Unit { const char* a; const char* b; int nt; int pm, pn, aux; };

__device__ __forceinline__ void tile_of(int wgid, int nM, int nN, int& pm, int& pn) {
    const int nwg = nM * nN; { const int q = nwg / NXCD, r = nwg % NXCD, xcd = wgid % NXCD, off = wgid / NXCD; wgid = (xcd < r ? xcd * (q + 1) : r * (q + 1) + (xcd - r) * q) + off; }
    const int nig = WGM * nN, gid = wgid / nig, fm = gid * WGM, gsz = (nM - fm) < WGM ? (nM - fm) : WGM;
    pm = fm + ((wgid % nig) % gsz); pn = (wgid % nig) / gsz;
}

template <class Epi, class Sched, bool FP8 = false>
__device__ __forceinline__ void gemm_phase(LAS unsigned char* lds, const int wid, const int lda, const int ldb, const Sched& S, const Epi& E) {
    const int tid = fresh_tid(wid), lane = tid & 63, wr = wid >> 2, wc = wid & 3, fr = lane & 15, fq = lane >> 4;
    unsigned voffA[2], voffB[2];
#pragma unroll
    for (int i = 0; i < 2; ++i) { int R, C; stage_rc(tid * 16 + i * 8192, R, C); const int Rb = (R & ~31) + perm32(R & 31);
        voffA[i] = (unsigned)(R * lda + C) * 2u; voffB[i] = (unsigned)(Rb * ldb + C) * 2u; }
    const size_t kstep = (size_t)(BK * 2);
    const size_t hstepA = (size_t)HALF * lda * 2, hstepB = (size_t)HALF * ldb * 2;
    const unsigned ldsw = (unsigned)wid * 1024u;
    const int aoff = FP8 ? lds_byte(wr * 64 + fr, fq * 16) : lds_byte(wr * 64 + fr, fq * 8), boff = FP8 ? lds_byte(wc * 32 + fr, fq * 16) : lds_byte(wc * 32 + fr, fq * 8);
#define PG8_SA(b, h) (((b) * 2 + (h)) * HTB)
#define PG8_SB(b, h) ((4 + (b) * 2 + (h)) * HTB)
#define PG8_STAGE(bufoff, gbase, voff) do { _Pragma("unroll") for (int _i = 0; _i < 2; ++_i) \
        __builtin_amdgcn_global_load_lds((const unsigned*)((const char*)(gbase) + (voff)[_i]), (LAS unsigned*)(lds + (bufoff) + ldsw + _i * 8192), 16, 0, 0); } while (0)
#define PG8_LDA(dst, b, h) do { if constexpr (FP8) { _Pragma("unroll") for (int m = 0; m < 4; ++m) dst##8[m] = cat8(*(const LAS bf16x8*)(lds + PG8_SA(b, h) + aoff + m * 2048), *(const LAS bf16x8*)(lds + PG8_SA(b, h) + aoff + m * 2048 + 16)); } \
        else { _Pragma("unroll") for (int m = 0; m < 4; ++m) _Pragma("unroll") for (int k = 0; k < 2; ++k) dst[m][k] = *(const LAS bf16x8*)(lds + PG8_SA(b, h) + aoff + m * 2048 + k * 1024); } } while (0)
#define PG8_LDB(dst, b, h) do { if constexpr (FP8) { _Pragma("unroll") for (int n = 0; n < 2; ++n) dst##8[n] = cat8(*(const LAS bf16x8*)(lds + PG8_SB(b, h) + boff + n * 2048), *(const LAS bf16x8*)(lds + PG8_SB(b, h) + boff + n * 2048 + 16)); } \
        else { _Pragma("unroll") for (int n = 0; n < 2; ++n) _Pragma("unroll") for (int k = 0; k < 2; ++k) dst[n][k] = *(const LAS bf16x8*)(lds + PG8_SB(b, h) + boff + n * 2048 + k * 1024); } } while (0)
#define PG8_MMA(ai, bj, At, Bt) do { __builtin_amdgcn_s_setprio(1); if constexpr (FP8) { _Pragma("unroll") for (int m = 0; m < 4; ++m) _Pragma("unroll") for (int n = 0; n < 2; ++n) \
        asm volatile("v_mfma_scale_f32_16x16x128_f8f6f4 %0, %1, %2, %0, %3, %3 op_sel_hi:[0,0,0]" : "+v"(acc[ai][bj][m][n]) : "v"(Bt##8[n]), "v"(At##8[m]), "v"(one8)); } \
        else { _Pragma("unroll") for (int m = 0; m < 4; ++m) _Pragma("unroll") for (int n = 0; n < 2; ++n) _Pragma("unroll") for (int k = 0; k < 2; ++k) \
        acc[ai][bj][m][n] = __builtin_amdgcn_mfma_f32_16x16x32_bf16(Bt[n][k], At[m][k], acc[ai][bj][m][n], 0, 0, 0); } __builtin_amdgcn_s_setprio(0); } while (0)
#define PG8_WAIT_V(n) asm volatile("s_waitcnt vmcnt(" #n ")" ::: "memory")
#define PG8_WAIT_L(n) asm volatile("s_waitcnt lgkmcnt(" #n ")" ::: "memory")
#define PG8_BAR __builtin_amdgcn_s_barrier()
#define PG8_SCHED __builtin_amdgcn_sched_barrier(0)
    Unit cur, nxt; int ui = 0;
    if (!S.next(0, cur)) return;
    f32x4 acc[2][2][4][2];
#pragma unroll
    for (int a = 0; a < 2; ++a)
#pragma unroll
        for (int b = 0; b < 2; ++b)
#pragma unroll
            for (int m = 0; m < 4; ++m)
#pragma unroll
                for (int n = 0; n < 2; ++n) acc[a][b][m][n] = (f32x4){0.f, 0.f, 0.f, 0.f};
    bf16x8 At[4][2], B0[2][2], B1[2][2]; i32x8 At8[4], B08[2], B18[2];
    const int one8 = 0x7f7f7f7f;
    const char* cA = FP8 ? uptr(cur.a) : cur.a; const char* cB = FP8 ? uptr(cur.b) : cur.b;
    PG8_STAGE(PG8_SB(0, 0), cB, voffB); PG8_STAGE(PG8_SB(0, 1), cB + hstepB, voffB); PG8_STAGE(PG8_SA(0, 0), cA, voffA); PG8_STAGE(PG8_SA(0, 1), cA + hstepA, voffA);
    if (wr == 1) PG8_BAR;
    PG8_WAIT_V(2); PG8_BAR;
    PG8_STAGE(PG8_SB(1, 0), cB + kstep, voffB); PG8_STAGE(PG8_SA(1, 0), cA + kstep, voffA); PG8_STAGE(PG8_SB(1, 1), cB + hstepB + kstep, voffB);
    PG8_WAIT_V(6); PG8_BAR;
    for (;;) {
        const bool has_next = S.next(ui + 1, nxt);
        const char* nA = has_next ? nxt.a : cA; const char* nB = has_next ? nxt.b : cB; if constexpr (FP8) { nA = uptr(nA); nB = uptr(nB); }
        const int nt = cur.nt;
        for (int t = 0; t < nt; t += 2) {
            const bool last = (t == nt - 2);
            const char* a1 = cA + (size_t)(t + 1) * kstep;
            const char* a2 = last ? nA : cA + (size_t)(t + 2) * kstep; const char* b2 = last ? nB : cB + (size_t)(t + 2) * kstep;
            const char* a3 = a2 + kstep; const char* b3 = b2 + kstep;
            PG8_LDB(B0, 0, 0); PG8_LDB(B1, 0, 1); PG8_SCHED; PG8_LDA(At, 0, 0); PG8_STAGE(PG8_SA(1, 1), a1 + hstepA, voffA);
            PG8_WAIT_V(8); PG8_WAIT_L(0); PG8_BAR; PG8_MMA(0, 0, At, B0); PG8_MMA(0, 1, At, B1); PG8_BAR; PG8_SCHED;
            PG8_LDA(At, 0, 1); PG8_STAGE(PG8_SB(0, 0), b2, voffB); PG8_STAGE(PG8_SB(0, 1), b2 + hstepB, voffB); PG8_STAGE(PG8_SA(0, 0), a2, voffA);
            PG8_WAIT_V(8); PG8_WAIT_L(0); PG8_BAR; PG8_MMA(1, 0, At, B0); PG8_MMA(1, 1, At, B1); PG8_BAR; PG8_SCHED;
            PG8_LDB(B0, 1, 0); PG8_LDB(B1, 1, 1); PG8_SCHED; PG8_LDA(At, 1, 0); PG8_STAGE(PG8_SA(0, 1), a2 + hstepA, voffA);
            PG8_WAIT_V(8); PG8_WAIT_L(0); PG8_BAR; PG8_MMA(0, 0, At, B0); PG8_MMA(0, 1, At, B1); PG8_BAR; PG8_SCHED;
            PG8_LDA(At, 1, 1); PG8_STAGE(PG8_SB(1, 0), b3, voffB); PG8_STAGE(PG8_SB(1, 1), b3 + hstepB, voffB); PG8_STAGE(PG8_SA(1, 0), a3, voffA);
            PG8_WAIT_V(8); PG8_WAIT_L(0); PG8_BAR; PG8_MMA(1, 0, At, B0); PG8_MMA(1, 1, At, B1); PG8_BAR; PG8_SCHED;
        }
        if (wr == 0) PG8_BAR;
        if constexpr (FP8) asm volatile("s_nop 7\n\ts_nop 7\n\ts_nop 7" ::: "memory");
        const bool keep = E(acc, cur, wr, wc, fr, fq);
        if (!has_next) break;
        if (!keep) {
#pragma unroll
        for (int a = 0; a < 2; ++a)
#pragma unroll
            for (int b = 0; b < 2; ++b)
#pragma unroll
                for (int m = 0; m < 4; ++m)
#pragma unroll
                    for (int n = 0; n < 2; ++n) acc[a][b][m][n] = (f32x4){0.f, 0.f, 0.f, 0.f};
        }
        cur = nxt; cA = nA; cB = nB; ++ui;
        if (wr == 1) PG8_BAR;
    }
    PG8_WAIT_V(0);
    PG8_BAR;
#undef PG8_SA
#undef PG8_SB
#undef PG8_STAGE
#undef PG8_LDA
#undef PG8_LDB
#undef PG8_MMA
#undef PG8_WAIT_V
#undef PG8_WAIT_L
#undef PG8_BAR
#undef PG8_SCHED
}

struct GridSched {
    const char* A; const char* B; int nM, nN, nt, lda, ldb, G, c, pm0, aux;
    __device__ __forceinline__ bool next(int i, Unit& u) const {
        const int L = __builtin_amdgcn_readfirstlane(i * G + c); if (L >= nM * nN) return false;
        int pm, pn; tile_of(L, nM, nN, pm, pn);
        u.pm = pm0 + pm; u.pn = pn; u.aux = aux; u.nt = nt;
        u.a = A + (size_t)(pm0 + pm) * 256 * lda * 2; u.b = B + (size_t)pn * 256 * ldb * 2; return true;
    }
};
struct GateSched {
    const char* U; const char* W; int nM, G, c, dir;
    __device__ __forceinline__ bool next(int i, Unit& u) const {
        const int L = __builtin_amdgcn_readfirstlane(i * G + c); if (L >= nM * 8) return false;
        int pm, pn; tile_of(L, nM, 8, pm, pn);
        u.pm = pm; u.pn = pn; u.aux = dir; u.nt = 2;
        u.a = U + (size_t)pm * 256 * DM * 2 + (size_t)pn * 128 * 2; u.b = W + ((size_t)pn * 512 + (size_t)dir * 256) * 128 * 2; return true;
    }
};
struct FatSched {
    const char* dyn; const char* wl; int nM, G, c;
    __device__ __forceinline__ bool next(int i, Unit& u) const {
        const int seg = i % 3, L = __builtin_amdgcn_readfirstlane((i / 3) * G + c); if (L >= nM * 4) return false;
        int pm, pn; tile_of(L, nM, 4, pm, pn);
        u.pm = pm; u.pn = pn; u.aux = seg; u.nt = 16;
        const size_t oa = seg == 0 ? D_MP : (seg == 1 ? D_HF : D_AO), ob = seg == 0 ? WO_POOL : (seg == 1 ? WO_LRU : WO_MLA);
        u.a = dyn + oa + (size_t)pm * 256 * DM * 2; u.b = wl + ob + (size_t)pn * 256 * DM * 2; return true;
    }
};
struct MoeSched {
    const char* A; const char* B; int te[7]; size_t estride; int nM, nN, nt, lda, ldb, G, c, t0, arow0;
    __device__ __forceinline__ bool next(int i, Unit& u) const {
        const int L = __builtin_amdgcn_readfirstlane(i * G + c); if (L >= nM * nN) return false;
        int pm, pn; tile_of(L, nM, nN, pm, pn);
        const int tg = t0 + pm; int e = 0;
#pragma unroll
        for (int j = 0; j < 7; ++j) e += (tg >= te[j]) ? 1 : 0;
        u.pm = pm; u.pn = pn; u.aux = e; u.nt = nt;
        u.a = A + (size_t)(arow0 + pm) * 256 * lda * 2; u.b = B + (size_t)e * estride + (size_t)pn * 256 * ldb * 2; return true;
    }
};
struct PoolSched { const char* A; const char* B; int G, c;
    __device__ __forceinline__ bool next(int i, Unit& u) const { const int L = __builtin_amdgcn_readfirstlane(i * G + c); if (L >= 32) return false; const int l = L >> 4; u.pm = L & 3; u.pn = (L >> 2) & 3; u.aux = l; u.nt = 4;
        u.a = A + (size_t)l * DM * DM * 2 + (size_t)u.pm * 256 * DM * 2 + (size_t)u.pn * 256 * 2; u.b = B + ((size_t)l * 4 + u.pn) * 65536 * 2; return true; } };
__device__ __forceinline__ u32x4 pack8(const f32x4 v0, const f32x4 v1) { u32x4 w; w.x = cvtpk(v0[0], v0[1]); w.y = cvtpk(v0[2], v0[3]); w.z = cvtpk(v1[0], v1[1]); w.w = cvtpk(v1[2], v1[3]); return w; }
__device__ __forceinline__ void unpack8(const u32x4 w, f32x4& v0, f32x4& v1) { v0 = (f32x4){bf_lo(w.x), bf_hi(w.x), bf_lo(w.y), bf_hi(w.y)}; v1 = (f32x4){bf_lo(w.z), bf_hi(w.z), bf_lo(w.w), bf_hi(w.w)}; }
template <int ACT>
__device__ __forceinline__ void store_tile(const f32x4 (&acc)[2][2][4][2], bf16_t* base, int ldc, int row0, int col0, int wr, int wc, int fr, int fq, const float scale = 1.f) {
#pragma unroll
    for (int ai = 0; ai < 2; ++ai)
#pragma unroll
        for (int m = 0; m < 4; ++m) { bf16_t* rowp = base + (size_t)(row0 + ai * HALF + wr * 64 + m * 16 + fr) * ldc + col0 + wc * 32 + 8 * fq;
#pragma unroll
            for (int bj = 0; bj < 2; ++bj) { f32x4 v0 = acc[ai][bj][m][0] * scale, v1 = acc[ai][bj][m][1] * scale;
                if (ACT == 1) {
#pragma unroll
                    for (int j = 0; j < 4; ++j) { v0[j] = sigmoidf_(v0[j]); v1[j] = sigmoidf_(v1[j]); } }
                if (ACT == 2) {
#pragma unroll
                    for (int j = 0; j < 4; ++j) { v0[j] = v0[j] * sigmoidf_(1.5957691216057308f * (v0[j] + 0.044715f * v0[j] * v0[j] * v0[j])); v1[j] = v1[j] * sigmoidf_(1.5957691216057308f * (v1[j] + 0.044715f * v1[j] * v1[j] * v1[j])); } }
                *(u32x4*)(rowp + bj * HALF) = pack8(v0, v1); } }
}
struct EpiIn1 {
    bf16_t* LX; bf16_t* LG; bf16_t* Z2;
    __device__ __forceinline__ bool operator()(f32x4 (&acc)[2][2][4][2], const Unit& u, int wr, int wc, int fr, int fq) const {
        if (u.pn >= 4 && u.pn < 8) { store_tile<2>(acc, LG, DM, u.pm * 256, (u.pn - 4) * 256, wr, wc, fr, fq); return false; }
        bf16_t* base; int ldc, ct;
        if (u.pn < 4) { base = LX; ldc = DM; ct = u.pn * 256; } else { base = Z2; ldc = Z2LD; ct = (u.pn - 8) * 256; }
        store_tile<0>(acc, base, ldc, u.pm * 256, ct, wr, wc, fr, fq); return false;
    }
};
template <int ACT> struct EpiStore {
    bf16_t* O; int ldc; int rowoff; float scale = 1.f;
    __device__ __forceinline__ bool operator()(f32x4 (&acc)[2][2][4][2], const Unit& u, int wr, int wc, int fr, int fq) const {
        store_tile<ACT>(acc, O, ldc, rowoff + u.pm * 256, u.pn * 256, wr, wc, fr, fq, scale); return false;
    }
};
struct EpiPool {
    bf16_t* O;
    __device__ __forceinline__ bool operator()(f32x4 (&acc)[2][2][4][2], const Unit& u, int wr, int wc, int fr, int fq) const {
        store_tile<0>(acc, O + (size_t)u.aux * (WTS_LSTRIDE / 2), DM, u.pm * 256, u.pn * 256, wr, wc, fr, fq); return false;
    }
};
__device__ __forceinline__ u32x2 pack8_fp8(const f32x4 v0, const f32x4 v1) {
    int lo = 0, hi = 0; lo = __builtin_amdgcn_cvt_pk_fp8_f32(v0[0], v0[1], lo, false); lo = __builtin_amdgcn_cvt_pk_fp8_f32(v0[2], v0[3], lo, true);
    hi = __builtin_amdgcn_cvt_pk_fp8_f32(v1[0], v1[1], hi, false); hi = __builtin_amdgcn_cvt_pk_fp8_f32(v1[2], v1[3], hi, true); return (u32x2){(unsigned)lo, (unsigned)hi};
}
struct EpiSwiglu8 {
    unsigned char* O; int ldc; float sc = 0.03125f;
    __device__ __forceinline__ bool operator()(f32x4 (&acc)[2][2][4][2], const Unit& u, int wr, int wc, int fr, int fq) const {
#pragma unroll
        for (int ai = 0; ai < 2; ++ai)
#pragma unroll
            for (int m = 0; m < 4; ++m) { unsigned char* rowp = O + (size_t)(u.pm * 256 + ai * HALF + wr * 64 + m * 16 + fr) * ldc + u.pn * 128 + wc * 32 + 8 * fq;
                f32x4 v0, v1;
#pragma unroll
                for (int j = 0; j < 4; ++j) { const float a0 = acc[ai][0][m][0][j] * sc, a1 = acc[ai][0][m][1][j] * sc;
                    v0[j] = a0 * sigmoidf_(a0) * (acc[ai][1][m][0][j] * sc); v1[j] = a1 * sigmoidf_(a1) * (acc[ai][1][m][1][j] * sc); }
                *(u32x2*)rowp = pack8_fp8(v0, v1); }
        return false;
    }
};
struct EpiStoreS {
    bf16_t* O; int ldc; int rowoff; float scale;
    __device__ __forceinline__ bool operator()(f32x4 (&acc)[2][2][4][2], const Unit& u, int wr, int wc, int fr, int fq) const {
#pragma unroll
        for (int ai = 0; ai < 2; ++ai)
#pragma unroll
            for (int m = 0; m < 4; ++m) { bf16_t* rowp = O + (size_t)(rowoff + u.pm * 256 + ai * HALF + wr * 64 + m * 16 + fr) * ldc + u.pn * 256 + wc * 32 + 8 * fq;
#pragma unroll
                for (int bj = 0; bj < 2; ++bj) *(u32x4*)(rowp + bj * HALF) = pack8(acc[ai][bj][m][0] * scale, acc[ai][bj][m][1] * scale); }
        return false;
    }
};
struct EpiSwiglu {
    bf16_t* O; int ldc;
    __device__ __forceinline__ bool operator()(f32x4 (&acc)[2][2][4][2], const Unit& u, int wr, int wc, int fr, int fq) const {
#pragma unroll
        for (int ai = 0; ai < 2; ++ai)
#pragma unroll
            for (int m = 0; m < 4; ++m) { bf16_t* rowp = O + (size_t)(u.pm * 256 + ai * HALF + wr * 64 + m * 16 + fr) * ldc + u.pn * 128 + wc * 32 + 8 * fq;
                f32x4 v0, v1;
#pragma unroll
                for (int j = 0; j < 4; ++j) { const float a0 = acc[ai][0][m][0][j], a1 = acc[ai][0][m][1][j];
                    v0[j] = a0 * sigmoidf_(a0) * acc[ai][1][m][0][j]; v1[j] = a1 * sigmoidf_(a1) * acc[ai][1][m][1][j]; }
                *(u32x4*)rowp = pack8(v0, v1); }
        return false;
    }
};
struct EpiGates {
    bf16_t* LA; bf16_t* GX; const bf16_t* U; const float* ba; const float* bx; const float* sp8;
    __device__ __forceinline__ bool operator()(f32x4 (&acc)[2][2][4][2], const Unit& u, int wr, int wc, int fr, int fq) const {
        const int ch0 = u.pn * 128 + wc * 32 + 8 * fq;
        const f32x4 ba0 = *(const f32x4*)(ba + ch0), ba1 = *(const f32x4*)(ba + ch0 + 4), bx0 = *(const f32x4*)(bx + ch0), bx1 = *(const f32x4*)(bx + ch0 + 4);
        const f32x4 sp0 = *(const f32x4*)(sp8 + ch0), sp1 = *(const f32x4*)(sp8 + ch0 + 4);
#pragma unroll
        for (int ai = 0; ai < 2; ++ai)
#pragma unroll
            for (int m = 0; m < 4; ++m) { const size_t off = (size_t)(u.pm * 256 + ai * HALF + wr * 64 + m * 16 + fr) * DM + ch0;
                f32x4 u0, u1; unpack8(*(const u32x4*)(U + off), u0, u1);
                f32x4 l0, l1, g0, g1;
#pragma unroll
                for (int j = 0; j < 4; ++j) {
                    const float e0 = __builtin_amdgcn_exp2f(1.4426950408889634f * sp0[j] * sigmoidf_(acc[ai][0][m][0][j] + ba0[j])), e1 = __builtin_amdgcn_exp2f(1.4426950408889634f * sp1[j] * sigmoidf_(acc[ai][0][m][1][j] + ba1[j]));
                    l0[j] = 1.f - e0; l1[j] = 1.f - e1;
                    g0[j] = __builtin_amdgcn_sqrtf(fmaxf(1.f - e0 * e0, 0.f)) * (sigmoidf_(acc[ai][1][m][0][j] + bx0[j]) * u0[j]); g1[j] = __builtin_amdgcn_sqrtf(fmaxf(1.f - e1 * e1, 0.f)) * (sigmoidf_(acc[ai][1][m][1][j] + bx1[j]) * u1[j]); }
                *(u32x4*)(LA + off) = pack8(l0, l1); *(u32x4*)(GX + off) = pack8(g0, g1); }
        return false;
    }
};
struct EpiQ {
    unsigned char* Q; unsigned char* QC; const float* rstd; const f32x2* rope;
    __device__ __forceinline__ bool operator()(f32x4 (&acc)[2][2][4][2], const Unit& u, int wr, int wc, int fr, int fq) const {
#pragma unroll
        for (int ai = 0; ai < 2; ++ai)
#pragma unroll
            for (int m = 0; m < 4; ++m) { const int row = u.pm * 256 + ai * HALF + wr * 64 + m * 16 + fr; const float rs = rstd[row];
                int b, t, pos; unsigned char* base; int slen;
                if (row < MLAT) { b = row >> 13; t = row & (SEQ - 1); pos = t; base = Q; slen = SEQ; } else { const int rc = row - MLAT; b = rc >> 8; t = rc & (CTXL - 1); pos = SEQ; base = QC; slen = CTXL; }
#pragma unroll
                for (int bj = 0; bj < 2; ++bj) { const int c = u.pn * 256 + bj * HALF + wc * 32 + 8 * fq, h = c / DQK, dd = c - h * DQK;
                    const float rq = rs * (0.07216878364870322f * 1.4426950408889634f);
                    f32x4 v0 = acc[ai][bj][m][0] * rq, v1 = acc[ai][bj][m][1] * rq;
                    if (dd >= 128) { const int p0 = dd - 128; const f32x2* tab = rope + (size_t)pos * 32 + (p0 >> 5) * 16 + ((p0 & 31) >> 1);
                        const f32x4 cs01 = *(const f32x4*)tab, cs23 = *(const f32x4*)(tab + 2);
                        f32x4 w0, w1;
                        w0[0] = v0[0] * cs01[0] - v0[1] * cs01[1]; w0[1] = v0[1] * cs01[0] + v0[0] * cs01[1];
                        w0[2] = v0[2] * cs01[2] - v0[3] * cs01[3]; w0[3] = v0[3] * cs01[2] + v0[2] * cs01[3];
                        w1[0] = v1[0] * cs23[0] - v1[1] * cs23[1]; w1[1] = v1[1] * cs23[0] + v1[0] * cs23[1];
                        w1[2] = v1[2] * cs23[2] - v1[3] * cs23[3]; w1[3] = v1[3] * cs23[2] + v1[2] * cs23[3];
                        v0 = w0; v1 = w1; }
                    *(u32x2*)(base + ((size_t)(b * NH + h) * slen + t) * DQK + dd) = pack8_fp8(v0, v1); } }
        return false;
    }
};
struct EpiK {
    unsigned char* K; const float* rstd;
    __device__ __forceinline__ bool operator()(f32x4 (&acc)[2][2][4][2], const Unit& u, int wr, int wc, int fr, int fq) const {
        const int cl = wc * 32 + 8 * fq;
#pragma unroll
        for (int ai = 0; ai < 2; ++ai)
#pragma unroll
            for (int m = 0; m < 4; ++m) { const int row = u.pm * 256 + ai * HALF + wr * 64 + m * 16 + fr; const float rs = rstd[row];
                int b, s; if (row < MLAT) { b = row >> 13; s = row & (SEQ - 1); } else { const int rc = row - MLAT; b = rc >> 8; s = SEQ + (rc & (CTXL - 1)); }
#pragma unroll
                for (int bj = 0; bj < 2; ++bj) { const size_t key = (size_t)(b * NH + 2 * u.pn + bj) * SKV + s;
                    *(u32x2*)(K + key * 128 + cl) = pack8_fp8(acc[ai][bj][m][0] * rs, acc[ai][bj][m][1] * rs); } }
        return false;
    }
};
struct EpiVT {
    unsigned char* VT; const float* rstd;
    __device__ __forceinline__ bool operator()(f32x4 (&acc)[2][2][4][2], const Unit& u, int wr, int wc, int fr, int fq) const {
#pragma unroll
        for (int bj = 0; bj < 2; ++bj) { const int tk = u.pn * 256 + bj * HALF + wc * 32 + 8 * fq;
            int b, s; if (tk < MLAT) { b = tk >> 13; s = tk & (SEQ - 1); } else { const int rc = tk - MLAT; b = rc >> 8; s = SEQ + (rc & (CTXL - 1)); }
            const f32x4 rs0 = *(const f32x4*)(rstd + tk), rs1 = *(const f32x4*)(rstd + tk + 4);
            const int kk = s & 63, pos = 16 * (kk >> 5) + 4 * ((kk >> 3) & 3);
#pragma unroll
            for (int ai = 0; ai < 2; ++ai)
#pragma unroll
                for (int m = 0; m < 4; ++m) { const int row = u.pm * 256 + ai * HALF + wr * 64 + m * 16 + fr, h = row >> 7, dv = row & 127;
                    unsigned char* base = VT + ((size_t)(b * NH + h) * (SKV / 64) + (s >> 6)) * 8192 + dv * 64 + pos;
                    const f32x4 v0 = acc[ai][bj][m][0] * rs0, v1 = acc[ai][bj][m][1] * rs1;
                    int w0 = 0, w1 = 0; w0 = __builtin_amdgcn_cvt_pk_fp8_f32(v0[0], v0[1], w0, false); w0 = __builtin_amdgcn_cvt_pk_fp8_f32(v0[2], v0[3], w0, true);
                    w1 = __builtin_amdgcn_cvt_pk_fp8_f32(v1[0], v1[1], w1, false); w1 = __builtin_amdgcn_cvt_pk_fp8_f32(v1[2], v1[3], w1, true);
                    *(int*)base = w0; *(int*)(base + 32) = w1; } }
        return false;
    }
};
struct EpiOut1 {
    const bf16_t* GT; bf16_t* MG;
    __device__ __forceinline__ bool operator()(f32x4 (&acc)[2][2][4][2], const Unit& u, int wr, int wc, int fr, int fq) const {
        const int seg = u.aux;
#pragma unroll
        for (int ai = 0; ai < 2; ++ai)
#pragma unroll
            for (int m = 0; m < 4; ++m) { const int row = u.pm * 256 + ai * HALF + wr * 64 + m * 16 + fr;
#pragma unroll
                for (int bj = 0; bj < 2; ++bj) { const int c = u.pn * 256 + bj * HALF + wc * 32 + 8 * fq;
                    f32x4 a0, a1; unpack8(*(const u32x4*)(GT + (size_t)row * 3072 + seg * DM + c), a0, a1);
                    if (seg < 2) { f32x4 b0, b1; unpack8(*(const u32x4*)(GT + (size_t)row * 3072 + (seg + 1) * DM + c), b0, b1);
#pragma unroll
                        for (int j = 0; j < 4; ++j) { a0[j] = a0[j] * __builtin_amdgcn_rcpf(b0[j]); a1[j] = a1[j] * __builtin_amdgcn_rcpf(b1[j]); } }
                    acc[ai][bj][m][0] *= a0; acc[ai][bj][m][1] *= a1;
                    if (seg == 2) *(u32x4*)(MG + (size_t)row * DM + c) = pack8(acc[ai][bj][m][0], acc[ai][bj][m][1]); }
                asm volatile("" ::: "memory"); }
        return seg < 2;
    }
};
}

namespace att {
constexpr int DK = 192, DV = 128, NW = 8, QBLK = 32, KVBLK = 64;
constexpr float SCALE = 0.07216878364870322f;
constexpr float THR = 3.f;
constexpr int SHM_V = KVBLK * DV, SHM_K = KVBLK * DK;
constexpr int SHM_ATTN = 3 * SHM_V + 2 * SHM_K + NW * 64 * 4;
static_assert(SHM_ATTN <= STAGE_BYTES, "attention LDS fits the stage region");
#define SBAR() __builtin_amdgcn_sched_barrier(0)
__device__ __forceinline__ int crow(int r, int hi) { return (r & 3) + 8 * (r >> 2) + 4 * hi; }
__device__ __forceinline__ int k_off(int row, int c24) { return (c24 >> 3) * 8192 + row * 128 + (((c24 & 7) ^ ((row >> 1) & 7)) << 4); }
template <bool FIRST> __device__ __forceinline__ void partialSM(f32x16& p0, f32x16& p1, f32x16& negM, float& alpha) {
  constexpr float T2 = 4.f + THR * 1.4426950408889634f;
  float pmax = p0[0];
#pragma unroll
  for (int r = 1; r < 16; ++r) pmax = fmaxf(pmax, p0[r]);
#pragma unroll
  for (int r = 0; r < 16; ++r) pmax = fmaxf(pmax, p1[r]);
  { auto rr = __builtin_amdgcn_permlane32_swap(__float_as_uint(pmax), __float_as_uint(pmax), false, false);
    pmax = fmaxf(__uint_as_float(rr[0]), __uint_as_float(rr[1])); }
  if (!FIRST && __builtin_expect(__all(pmax <= T2), 1)) { alpha = 1.f; }
  else { const float delta = FIRST ? pmax - 4.f : fmaxf(pmax - 4.f, 0.f); alpha = FIRST ? 1.f : __builtin_amdgcn_exp2f(-delta);
#pragma unroll
    for (int r = 0; r < 16; ++r) { negM[r] -= delta; p0[r] -= delta; p1[r] -= delta; } }
#pragma unroll
  for (int r = 0; r < 16; ++r) p0[r] = __builtin_amdgcn_exp2f(p0[r]);
}
__device__ __forceinline__ void finishSM(f32x16& p0, f32x16& p1, float alpha, float& l_reg, pg8::i32x8& P8) {
#pragma unroll
  for (int r = 0; r < 16; ++r) p1[r] = __builtin_amdgcn_exp2f(p1[r]);
  float ps = 0;
#pragma unroll
  for (int r = 0; r < 16; ++r) ps += p0[r];
#pragma unroll
  for (int r = 0; r < 16; ++r) ps += p1[r];
  { auto rr = __builtin_amdgcn_permlane32_swap(__float_as_uint(ps), __float_as_uint(ps), false, false);
    ps = __uint_as_float(rr[0]) + __uint_as_float(rr[1]); }
  l_reg = l_reg * alpha + ps;
#pragma unroll
  for (int q = 0; q < 4; ++q) { int w = __float_as_int(p0[4 * q]), x = __float_as_int(p1[4 * q]);
    w = __builtin_amdgcn_cvt_pk_fp8_f32(p0[4 * q], p0[4 * q + 1], w, false); w = __builtin_amdgcn_cvt_pk_fp8_f32(p0[4 * q + 2], p0[4 * q + 3], w, true);
    x = __builtin_amdgcn_cvt_pk_fp8_f32(p1[4 * q], p1[4 * q + 1], x, false); x = __builtin_amdgcn_cvt_pk_fp8_f32(p1[4 * q + 2], p1[4 * q + 3], x, true);
    P8[q] = w; P8[4 + q] = x; }
}
__device__ __forceinline__ void qkt(f32x16& p0, f32x16& p1, const LAS unsigned char* Ks, const pg8::i32x8* qf, int ko0, int ko1, const f32x16& negM) {
  p0 = negM; p1 = negM;
#pragma unroll
  for (int i = 0; i < 3; ++i) {
    const u32x4 a0 = *(const LAS u32x4*)(Ks + i * 4096 + ko0), a1 = *(const LAS u32x4*)(Ks + i * 4096 + ko1);
    const u32x4 b0 = *(const LAS u32x4*)(Ks + i * 4096 + 2048 + ko0), b1 = *(const LAS u32x4*)(Ks + i * 4096 + 2048 + ko1);
    const pg8::i32x8 ka = {(int)a0.x, (int)a0.y, (int)a0.z, (int)a0.w, (int)a1.x, (int)a1.y, (int)a1.z, (int)a1.w}, kb = {(int)b0.x, (int)b0.y, (int)b0.z, (int)b0.w, (int)b1.x, (int)b1.y, (int)b1.z, (int)b1.w};
    p0 = __builtin_amdgcn_mfma_scale_f32_32x32x64_f8f6f4(ka, qf[i], p0, 0, 0, 0, 0x7f7f7f7f, 0, 0x7f7f7f7f);
    p1 = __builtin_amdgcn_mfma_scale_f32_32x32x64_f8f6f4(kb, qf[i], p1, 0, 0, 0, 0x7f7f7f7f, 0, 0x7f7f7f7f); }
}
__device__ __forceinline__ void pv8(f32x16* o, const LAS unsigned char* Vs, const pg8::i32x8 P8, int ko0, int ko1) {
#pragma unroll
  for (int d0 = 0; d0 < 4; ++d0) { const u32x4 a = *(const LAS u32x4*)(Vs + d0 * 2048 + ko0), b = *(const LAS u32x4*)(Vs + d0 * 2048 + ko1);
    const pg8::i32x8 v = {(int)a.x, (int)a.y, (int)a.z, (int)a.w, (int)b.x, (int)b.y, (int)b.z, (int)b.w};
    o[d0] = __builtin_amdgcn_mfma_scale_f32_32x32x64_f8f6f4(P8, v, o[d0], 0, 0, 0, 0x7f7f7f7f, 0, 0x7f7f7f7f); }
}
__device__ __forceinline__ void attn_unit(const char* __restrict__ Qb, const char* __restrict__ Kh, const char* __restrict__ Kr, const char* __restrict__ Vh, char* __restrict__ Ob, int seq, LAS unsigned char* lds, const int wid) {
  const int tid = fresh_tid(wid), lane = tid & 63, r32 = lane & 31, hi = lane >> 5;
  LAS unsigned char* V_lds = lds; LAS unsigned char* K_lds = lds + 3 * SHM_V;
  LAS float* ws = (LAS float*)(lds + 3 * SHM_V + 2 * SHM_K) + wid * 64; LAS float* li_l = ws; LAS float* al_l = ws + 32;
  float l_reg = 0; f32x16 o[4] = {}, negM = {}; pg8::i32x8 qf[3];
  const unsigned qoff = (unsigned)((wid * QBLK + r32) * DK + hi * 32);
#pragma unroll
  for (int i = 0; i < 3; ++i) { const u32x4 a = *reinterpret_cast<const u32x4*>(Qb + qoff + i * 64), b = *reinterpret_cast<const u32x4*>(Qb + qoff + i * 64 + 16);
    qf[i] = (pg8::i32x8){(int)a.x, (int)a.y, (int)a.z, (int)a.w, (int)b.x, (int)b.y, (int)b.z, (int)b.w}; }
  const int ko0 = r32 * 64 + 16 * ((2 * hi) ^ ((r32 >> 2) & 3)), ko1 = ko0 ^ 16;
  const unsigned kswz = (unsigned)(((lane & 3) ^ ((lane >> 4) & 3)) << 4), krow = (unsigned)(16 * (wid & 3) + (lane >> 2));
  const unsigned kgn = krow * 128 + 64 * (wid >> 2) + kswz, kgr = krow * 64 + kswz;
  LAS unsigned char* kdst = K_lds + (wid >> 2) * 4096 + (wid & 3) * 1024; LAS unsigned char* kdst2 = K_lds + 8192 + (wid & 3) * 1024;
  const unsigned vg = (unsigned)((16 * wid + (lane >> 2)) * 64) + kswz;
  LAS unsigned char* vdst = V_lds + wid * 1024;
#define SLOAD(k0, kb, vboff) do { \
    __builtin_amdgcn_global_load_lds((const unsigned*)(Vh + (size_t)(k0) * 128 + vg), (LAS unsigned*)(vdst + (vboff)), 16, 0, 0); \
    __builtin_amdgcn_global_load_lds((const unsigned*)(Kh + (size_t)(k0) * 128 + kgn), (LAS unsigned*)(kdst + (kb) * SHM_K), 16, 0, 0); \
    if (wid < 4) __builtin_amdgcn_global_load_lds((const unsigned*)(Kr + (size_t)(k0) * 64 + kgr), (LAS unsigned*)(kdst2 + (kb) * SHM_K), 16, 0, 0); } while (0)
#define TILE_SYNC() do { asm volatile("s_waitcnt vmcnt(0)" ::: "memory"); __syncthreads(); } while (0)
#define RESC(a) do { if (__any((a) < 1.f)) { if (hi == 0) al_l[r32] = (a); asm volatile("s_waitcnt lgkmcnt(0)" ::: "memory"); \
    _Pragma("unroll") for (int d = 0; d < 4; ++d) _Pragma("unroll") for (int r = 0; r < 16; ++r) o[d][r] *= al_l[crow(r, hi)]; } } while (0)
#define VROT(x) do { (x) += SHM_V; if ((x) == 3 * SHM_V) (x) = 0; } while (0)
  f32x16 pA0, pA1, pB0, pB1; float alA, alB; pg8::i32x8 P8; const int NT = seq / KVBLK;
  __syncthreads();
  SLOAD(0, 0, 0); TILE_SYNC();
  qkt(pA0, pA1, K_lds, qf, ko0, ko1, negM); partialSM<true>(pA0, pA1, negM, alA);
  SLOAD(KVBLK, 1, SHM_V); TILE_SYNC();
  int vrd = 0, vwr = 2 * SHM_V;
  for (int j = 1; j + 1 < NT; j += 2) {
    SBAR(); qkt(pB0, pB1, K_lds + SHM_K, qf, ko0, ko1, negM);
    finishSM(pA0, pA1, alA, l_reg, P8); SBAR();
    SLOAD((j + 1) * KVBLK, 0, vwr); SBAR();
    pv8(o, V_lds + vrd, P8, ko0, ko1); partialSM<false>(pB0, pB1, negM, alB);
    RESC(alB); VROT(vrd); VROT(vwr); TILE_SYNC();
    SBAR(); qkt(pA0, pA1, K_lds, qf, ko0, ko1, negM);
    finishSM(pB0, pB1, alB, l_reg, P8); SBAR();
    SLOAD((j + 2) * KVBLK, 1, vwr); SBAR();
    pv8(o, V_lds + vrd, P8, ko0, ko1); partialSM<false>(pA0, pA1, negM, alA);
    RESC(alA); VROT(vrd); VROT(vwr); TILE_SYNC();
  }
  SBAR(); qkt(pB0, pB1, K_lds + SHM_K, qf, ko0, ko1, negM);
  finishSM(pA0, pA1, alA, l_reg, P8); SBAR();
  pv8(o, V_lds + vrd, P8, ko0, ko1); partialSM<false>(pB0, pB1, negM, alB);
  RESC(alB); VROT(vrd);
  finishSM(pB0, pB1, alB, l_reg, P8); SBAR();
  pv8(o, V_lds + vrd, P8, ko0, ko1);
  if (hi == 0) li_l[r32] = l_reg; asm volatile("s_waitcnt lgkmcnt(0)" ::: "memory");
  float rli[16];
#pragma unroll
  for (int r = 0; r < 16; ++r) rli[r] = __builtin_amdgcn_rcpf(li_l[crow(r, hi)]);
  const unsigned ob0 = (unsigned)((wid * QBLK + 4 * hi) * DM + r32) * 2u;
#pragma unroll
  for (int r = 0; r < 16; ++r) {
#pragma unroll
    for (int d0 = 0; d0 < 4; ++d0) *(bf16_t*)(Ob + ob0 + (unsigned)(((r & 3) + 8 * (r >> 2)) * DM + d0 * 32) * 2u) = (bf16_t)(cvtpk(o[d0][r] * rli[r], 0.f) & 0xffffu); }
#undef SLOAD
#undef TILE_SYNC
#undef RESC
#undef VROT
}
}

struct Args { const float* in[35]; float* out; unsigned char* ws; int ph_lo, ph_hi; };
enum { I_X = 0, I_C, I_CTX, I_CCTX, I_MODW, I_MODB, I_PREMIXG, I_POSTMIXG, I_PREFFNG, I_POSTFFNG, I_WIN, I_POOLW, I_POOLSCALE, I_POOLPROJ, I_CONVW, I_CONVB,
       I_GAW, I_GAB, I_GXW, I_GXB, I_LAMBDA, I_LRUPROJ, I_QNORMG, I_WUQ, I_KVNORMG, I_WUKV, I_MLAPROJ, I_WOUT, I_FFNW1, I_FFNW3, I_FFNW2, I_ROUTERW, I_MOEW1, I_MOEW3, I_MOEW2 };

typedef const __attribute__((address_space(4))) Args* ArgsP;
struct Frame {
    LAS unsigned char* lds; int G, c, ngw, wave;
    ArgsP A;
};
__device__ __forceinline__ ArgsP launder(ArgsP a) { asm volatile("" : "+s"(a)); return a; }
__device__ __forceinline__ Frame make_frame(ArgsP A0, int wave) {
    extern __shared__ __attribute__((aligned(16))) unsigned char lds_raw[];
    Frame F; F.A = launder(A0); F.lds = (LAS unsigned char*)lds_raw; F.G = gridDim.x; F.c = blockIdx.x; F.ngw = F.G * NWAVES; F.wave = wave; return F;
}
__device__ __forceinline__ bool in_range(ArgsP A0, int k) { ArgsP a = launder(A0); return a->ph_lo <= k && k < a->ph_hi; }
#define PHASE_IDS const int wave = F.wave, tid = fresh_tid(wave), lane = tid & 63, gw = F.c * NWAVES + wave; (void)lane; (void)gw
#define RCOL(j) (lane * 8 + 512 * ((j) >> 1) + 4 * ((j) & 1))
#define F_IN(i) (F.A->in[i])
#define F_WS (F.A->ws)
#define F_OUT (F.A->out)

template <class Src> __device__ __forceinline__ void wprep_job(const Frame& F, int& it0, int K, int N, bf16_t* dst, const Src& src) {
    PHASE_IDS;
    LAS float* scr = (LAS float*)(F.lds + wave * 16384);
    const int nblk = N / 32, nitems = (K / 64) * nblk;
    int first = it0 + (((gw - it0) % F.ngw) + F.ngw) % F.ngw;
    for (int it = first; it < it0 + nitems; it += F.ngw) {
        const int r = it - it0, kb = r / nblk, nb = r % nblk, k0 = 64 * kb, n0 = 32 * nb;
#pragma unroll 8
        for (int i = 0; i < 32; ++i) { const int kk = 2 * i + (lane >> 5); scr[kk * 33 + (lane & 31)] = src(k0 + kk, n0 + (lane & 31)); }
        LDS_WAIT(); asm volatile("" ::: "memory");
        const int cc = lane & 7;
#pragma unroll
        for (int j = 0; j < 4; ++j) { const int n = (lane >> 3) + 8 * j; const LAS float* s = scr + (8 * cc) * 33 + n;
            u32x4 o; o.x = cvtpk(s[0 * 33], s[1 * 33]); o.y = cvtpk(s[2 * 33], s[3 * 33]); o.z = cvtpk(s[4 * 33], s[5 * 33]); o.w = cvtpk(s[6 * 33], s[7 * 33]);
            *(u32x4*)(dst + (size_t)(n0 + n) * K + k0 + 8 * cc) = o; }
        LDS_WAIT(); asm volatile("" ::: "memory");
    }
    it0 += nitems;
}
template <class Src> __device__ __forceinline__ void wprep_fast(const Frame& F, int& it0, int K, int N, bf16_t* dst, const Src& src) {
    PHASE_IDS;
    LAS float* scr = (LAS float*)(F.lds + wave * 16384);
    const int nblk = N / 32, nitems = (K / 64) * nblk; const long ld = src.ld;
    int first = it0 + (((gw - it0) % F.ngw) + F.ngw) % F.ngw;
    for (int it = first; it < it0 + nitems; it += F.ngw) {
        const int r = it - it0, kb = r / nblk, nb = r % nblk, k0 = 64 * kb, n0 = 32 * nb;
        const float* p = src.at(n0 + (lane & 31)); float v[32];
        if (p) { p += (long)(k0 + (lane >> 5)) * ld;
#pragma unroll
            for (int i = 0; i < 32; ++i) v[i] = __builtin_nontemporal_load(p + (long)(2 * i) * ld); }
        else {
#pragma unroll
            for (int i = 0; i < 32; ++i) v[i] = 0.f; }
#pragma unroll
        for (int i = 0; i < 32; ++i) scr[(2 * i + (lane >> 5)) * 33 + (lane & 31)] = v[i];
        LDS_WAIT(); asm volatile("" ::: "memory");
        const int cc = lane & 7;
#pragma unroll
        for (int j = 0; j < 4; ++j) { const int n = (lane >> 3) + 8 * j; const LAS float* s = scr + (8 * cc) * 33 + n;
            u32x4 o; o.x = cvtpk(s[0 * 33], s[1 * 33]); o.y = cvtpk(s[2 * 33], s[3 * 33]); o.z = cvtpk(s[4 * 33], s[5 * 33]); o.w = cvtpk(s[6 * 33], s[7 * 33]);
            *(u32x4*)(dst + (size_t)(n0 + n) * K + k0 + 8 * cc) = o; }
        LDS_WAIT(); asm volatile("" ::: "memory");
    }
    it0 += nitems;
}
template <class Src> __device__ __forceinline__ void wprep_fast8(const Frame& F, int& it0, int K, int N, unsigned char* dst, const Src& src, float scale) {
    PHASE_IDS;
    LAS float* scr = (LAS float*)(F.lds + wave * 16384);
    const int nblk = N / 32, nitems = (K / 64) * nblk; const long ld = src.ld;
    int first = it0 + (((gw - it0) % F.ngw) + F.ngw) % F.ngw;
    for (int it = first; it < it0 + nitems; it += F.ngw) {
        const int r = it - it0, kb = r / nblk, nb = r % nblk, k0 = 64 * kb, n0 = 32 * nb;
        const float* p = src.at(n0 + (lane & 31)); float v[32];
        if (p) { p += (long)(k0 + (lane >> 5)) * ld;
#pragma unroll
            for (int i = 0; i < 32; ++i) v[i] = __builtin_nontemporal_load(p + (long)(2 * i) * ld); }
        else {
#pragma unroll
            for (int i = 0; i < 32; ++i) v[i] = 0.f; }
#pragma unroll
        for (int i = 0; i < 32; ++i) scr[(2 * i + (lane >> 5)) * 33 + (lane & 31)] = v[i] * scale;
        LDS_WAIT(); asm volatile("" ::: "memory");
        const int cc = lane & 7;
#pragma unroll
        for (int j = 0; j < 4; ++j) { const int n = (lane >> 3) + 8 * j; const LAS float* s = scr + (8 * cc) * 33 + n;
            const f32x4 a = {s[0 * 33], s[1 * 33], s[2 * 33], s[3 * 33]}, b = {s[4 * 33], s[5 * 33], s[6 * 33], s[7 * 33]};
            *(u32x2*)(dst + (size_t)(n0 + n) * K + k0 + 8 * cc) = pg8::pack8_fp8(a, b); }
        LDS_WAIT(); asm volatile("" ::: "memory");
    }
    it0 += nitems;
}
struct FastPlain { const float* W; int ld; __device__ __forceinline__ const float* at(int n) const { return W + n; } };
struct FastIn1 { const float* W; int ld;
    __device__ __forceinline__ const float* at(int n) const { int c; if (n < 1024) c = 1024 + n; else if (n < 2048) c = 2048 + (n - 1024); else if (n < 3072) c = n - 2048; else if (n < 3776) c = n; else return nullptr; return W + c; } };
struct FastW13 { const float* W1; long d31; int ld;
    __device__ __forceinline__ const float* at(int n) const { const int pn = n >> 8, bj = (n >> 7) & 1, jj = n & 127; return W1 + (long)bj * d31 + pn * 128 + jj; } };
struct SrcPlain { const float* W; int ld; __device__ __forceinline__ float operator()(int k, int n) const { return W[(size_t)k * ld + n]; } };
struct SrcPlainS { const float* W; int ld; float s; __device__ __forceinline__ float operator()(int k, int n) const { return W[(size_t)k * ld + n] * s; } };
struct SrcIn1 { const float* W;
    __device__ __forceinline__ float operator()(int k, int n) const {
        int c; if (n < 1024) c = 1024 + n; else if (n < 2048) c = 2048 + (n - 1024); else if (n < 3072) c = n - 2048; else if (n < 3776) c = n; else return 0.f;
        return W[(size_t)k * INCOLS + c]; } };
struct SrcGate { const float* Wa; long dxa; int nb;
    __device__ __forceinline__ float operator()(int k, int n) const { const int d = n >> 8, bj = (n >> 7) & 1, jj = n & 127;
        return Wa[(long)bj * dxa + (((long)d * 8 + nb) * 128 + k) * 128 + jj]; } };
struct SrcUQ { const float* W; const float* g;
    __device__ __forceinline__ float operator()(int k, int n) const { const int h = n / DQK, dd = n - h * DQK; int c = n;
        if (dd >= 128) { const int p = dd - 128, axis = p >> 5, f = (p & 31) >> 1, half = p & 1; c = h * DQK + 128 + axis * 32 + half * 16 + f; }
        return W[(size_t)k * 1536 + c] * g[k]; } };
struct SrcScaleK { const float* W; const float* g; int ld; __device__ __forceinline__ float operator()(int k, int n) const { return W[(size_t)k * ld + n] * g[k]; } };
struct SrcUKV { const float* W; const float* g;
    __device__ __forceinline__ float operator()(int k, int n) const { const int v = n >> 10, h = (n >> 7) & 7, j = n & 127; return W[(size_t)k * 2048 + h * 256 + v * 128 + j] * g[k]; } };
struct SrcW13 { const float* W1; long d31; int ld;
    __device__ __forceinline__ float operator()(int k, int n) const { const int pn = n >> 8, bj = (n >> 7) & 1, jj = n & 127; return W1[(long)bj * d31 + (long)k * ld + pn * 128 + jj]; } };
struct SrcPoolWS { const float* W; const float* sc;
    __device__ __forceinline__ float operator()(int k, int n) const { return W[(size_t)n * 256 + k] * sc[k]; } };

__device__ __forceinline__ void mod_partials(const Frame& F) {
    PHASE_IDS;
    const float* c = F_IN(I_C); const float* cc = F_IN(I_CCTX); const float* mw = F_IN(I_MODW); float* part = (float*)(F_WS + WS_MPART);
    for (int task = F.c; task < 2 * 12 * 32; task += F.G) {
        const int l = task / 384, r = task % 384, cb = r / 32, kc = r % 32, col = cb * 512 + tid;
        float a0 = 0, a1 = 0, a2 = 0, a3 = 0, a4 = 0;
#pragma unroll 8
        for (int kk = 0; kk < 32; ++kk) { const int k = kc * 32 + kk; const float w = mw[((size_t)l * 1024 + k) * 6144 + col];
            const float c0 = c[k], c1 = c[1024 + k], c2 = c[2048 + k], c3 = c[3072 + k], c4 = cc[k];
            a0 += c0 * sigmoidf_(c0) * w; a1 += c1 * sigmoidf_(c1) * w; a2 += c2 * sigmoidf_(c2) * w; a3 += c3 * sigmoidf_(c3) * w; a4 += c4 * sigmoidf_(c4) * w; }
        float* p = part + (((size_t)l * 32 + kc) * 5) * 6144 + col;
        p[0] = a0; p[6144] = a1; p[2 * 6144] = a2; p[3 * 6144] = a3; p[4 * 6144] = a4;
    }
}
__device__ __forceinline__ void mod_reduce(const Frame& F) {
    PHASE_IDS;
    const float* part = (const float*)(F_WS + WS_MPART); const float* mb = F_IN(I_MODB); float* mv = (float*)(F_WS + WS_MVEC);
    for (int i = F.c * NTHR + tid; i < 2 * 5 * 6144; i += F.G * NTHR) { const int l = i / 30720, r = (i % 30720) / 6144, col = i % 6144;
        float s = mb[l * 6144 + col];
        for (int kc = 0; kc < 32; ++kc) s += part[(((size_t)l * 32 + kc) * 5 + r) * 6144 + col];
        mv[i] = s; }
}
__device__ __forceinline__ void rope_and_consts(const Frame& F) {
    PHASE_IDS;
    f32x2* rope = (f32x2*)(F_WS + WS_ROPE);
    for (int i = F.c * NTHR + tid; i < 8193 * 32; i += F.G * NTHR) { const int pos = i >> 5, a = (i >> 4) & 1, f = i & 15;
        f32x2 v = {1.f, 0.f};
        if (pos < SEQ) { const float inv = __builtin_amdgcn_exp2f(-(float)f * (13.287712379549449f / 16.f));
            const float p = (float)(a == 0 ? (pos >> 6) : (pos & 63)); const float rev = (p * inv) * 0.15915494309189535f; const float fr = rev - rintf(rev);
            v.x = __builtin_amdgcn_cosf(fr); v.y = __builtin_amdgcn_sinf(fr); }
        rope[i] = v; }
    float* sp8 = (float*)(F_WS + WS_SP8); const float* lam = F_IN(I_LAMBDA);
    for (int i = F.c * NTHR + tid; i < 2 * 2 * 1024; i += F.G * NTHR) sp8[i] = -8.f * log1pf(expf(-lam[i]));
}

__device__ __forceinline__ void pool_weights_phase(const Frame& F) {
    PHASE_IDS;
    for (int tile = F.c; tile < 512; tile += F.G) {
        const int l = tile >> 8, g = (tile >> 6) & 3, n0 = ((tile >> 2) & 15) * 64, i0 = (tile & 3) * 64 + wave * 8;
        const float* PW = F_IN(I_POOLW) + (((size_t)l * 4 + g) * 256 + i0) * 256; const float* SC = F_IN(I_POOLSCALE) + l * 1024 + g * 256;
        const float* PP = F_IN(I_POOLPROJ) + ((size_t)l * 1024 + g * 256) * DM + n0 + lane;
        float acc[8] = {0.f, 0.f, 0.f, 0.f, 0.f, 0.f, 0.f, 0.f};
#pragma unroll 4
        for (int j = 0; j < 256; ++j) { const float p = PP[(size_t)j * DM] * SC[j];
#pragma unroll
            for (int ii = 0; ii < 8; ++ii) acc[ii] += PW[ii * 256 + j] * p; }
        u32x4 o; o.x = cvtpk(acc[0], acc[1]); o.y = cvtpk(acc[2], acc[3]); o.z = cvtpk(acc[4], acc[5]); o.w = cvtpk(acc[6], acc[7]);
        *(u32x4*)((bf16_t*)(F_WS + WS_WTS + (size_t)l * WTS_LSTRIDE + WO_POOL) + (size_t)(n0 + lane) * DM + g * 256 + i0) = o;
    }
}
__device__ __forceinline__ const float* mvec_row(const Frame& F, int l, int row) { return (const float*)(F_WS + WS_MVEC) + ((size_t)l * 5 + (row < MLAT ? (row >> 13) : 4)) * 6144; }
template <bool BF> __device__ __forceinline__ void ldx8(const void* base, size_t e, f32x4& a, f32x4& b) {
    if (BF) { const u32x4 w = *(const u32x4*)((const bf16_t*)base + e); a = (f32x4){bf_lo(w.x), bf_hi(w.x), bf_lo(w.y), bf_hi(w.y)}; b = (f32x4){bf_lo(w.z), bf_hi(w.z), bf_lo(w.w), bf_hi(w.w)}; }
    else { a = *(const f32x4*)((const float*)base + e); b = *(const f32x4*)((const float*)base + e + 4); }
}
template <bool BF> __device__ __forceinline__ void stx8(void* base, size_t e, const f32x4 a, const f32x4 b) {
    if (BF) { u32x4 w; w.x = cvtpk(a[0], a[1]); w.y = cvtpk(a[2], a[3]); w.z = cvtpk(b[0], b[1]); w.w = cvtpk(b[2], b[3]); *(u32x4*)((bf16_t*)base + e) = w; }
    else { *(f32x4*)((float*)base + e) = a; *(f32x4*)((float*)base + e + 4) = b; }
}
template <bool XBF> __device__ __forceinline__ void norm1_phase(const Frame& F, int l, const void* xlat, const float* xctx, bf16_t* H, unsigned char* H8, int nrows) {
    PHASE_IDS;
    const float* g = F_IN(I_PREMIXG) + l * DM;
    for (int row = gw; row < nrows; row += F.ngw) {
        const bool lat = row < MLAT; const float* mr = mvec_row(F, l, row);
        f32x4 v[4]; float ss = 0.f;
#pragma unroll
        for (int jp = 0; jp < 2; ++jp) { if (lat) ldx8<XBF>(xlat, (size_t)row * DM + lane * 8 + 512 * jp, v[2 * jp], v[2 * jp + 1]); else ldx8<false>(xctx, (size_t)(row - MLAT) * DM + lane * 8 + 512 * jp, v[2 * jp], v[2 * jp + 1]); }
#pragma unroll
        for (int j = 0; j < 4; ++j) ss += (v[j][0] * v[j][0] + v[j][1] * v[j][1]) + (v[j][2] * v[j][2] + v[j][3] * v[j][3]);
        const float rstd = rsqrtf(wave_sum(ss) * (1.f / DM) + RMS_EPS);
#pragma unroll
        for (int j = 0; j < 4; ++j) { const int col = RCOL(j); const f32x4 gg = *(const f32x4*)(g + col), sh = *(const f32x4*)(mr + col), sc = *(const f32x4*)(mr + DM + col);
            v[j] = v[j] * rstd * gg * (sc + 1.f) + sh; }
#pragma unroll
        for (int jp = 0; jp < 2; ++jp) { const f32x4 p = v[2 * jp], q = v[2 * jp + 1]; const size_t o = (size_t)row * DM + lane * 8 + 512 * jp;
            u32x4 w; w.x = cvtpk(p[0], p[1]); w.y = cvtpk(p[2], p[3]); w.z = cvtpk(q[0], q[1]); w.w = cvtpk(q[2], q[3]); *(u32x4*)(H + o) = w;
            *(u32x2*)(H8 + o) = pg8::pack8_fp8(p, q); }
    }
}
template <bool MOE, bool XIB, bool XOB> __device__ __forceinline__ void resid1_phase(const Frame& F, int l, const void* xlat, const float* xctx, void* olat, float* octx, const bf16_t* Y, bf16_t* H2, int nrows) {
    PHASE_IDS;
    const float* gpost = F_IN(I_POSTMIXG) + l * DM; const float* gpre = F_IN(I_PREFFNG) + l * DM;
    LAS float* rw = (LAS float*)F.lds;
    volatile LAS int* hist = (volatile LAS int*)(F.lds + 32768);
    if (MOE) { const float* rwg = F_IN(I_ROUTERW);
        for (int i = tid; i < 8192; i += NTHR) rw[(i & 7) * 1024 + (i >> 3)] = rwg[i];
        if (tid < 8) hist[tid] = 0;
        __syncthreads(); }
    for (int row = gw; row < nrows; row += F.ngw) {
        const bool lat = row < MLAT; const size_t ro = lat ? (size_t)row * DM : (size_t)(row - MLAT) * DM;
        const float* mr = mvec_row(F, l, row);
        f32x4 y[4], xv[4]; float ss = 0.f;
#pragma unroll
        for (int jp = 0; jp < 2; ++jp) { if (lat) ldx8<XIB>(xlat, ro + lane * 8 + 512 * jp, xv[2 * jp], xv[2 * jp + 1]); else ldx8<false>(xctx, ro + lane * 8 + 512 * jp, xv[2 * jp], xv[2 * jp + 1]); }
#pragma unroll
        for (int jp = 0; jp < 2; ++jp) { const u32x4 w = *(const u32x4*)(Y + (size_t)row * DM + lane * 8 + 512 * jp);
            y[2 * jp] = (f32x4){bf_lo(w.x), bf_hi(w.x), bf_lo(w.y), bf_hi(w.y)}; y[2 * jp + 1] = (f32x4){bf_lo(w.z), bf_hi(w.z), bf_lo(w.w), bf_hi(w.w)}; }
#pragma unroll
        for (int j = 0; j < 4; ++j) ss += (y[j][0] * y[j][0] + y[j][1] * y[j][1]) + (y[j][2] * y[j][2] + y[j][3] * y[j][3]);
        const float rs = rsqrtf(wave_sum(ss) * (1.f / DM) + RMS_EPS);
        f32x4 xn[4]; float s2 = 0.f;
#pragma unroll
        for (int j = 0; j < 4; ++j) { const int col = RCOL(j); const f32x4 gg = *(const f32x4*)(gpost + col), gate = *(const f32x4*)(mr + 2 * DM + col);
            xn[j] = xv[j] + gate * (y[j] * rs * gg);
            s2 += (xn[j][0] * xn[j][0] + xn[j][1] * xn[j][1]) + (xn[j][2] * xn[j][2] + xn[j][3] * xn[j][3]); }
#pragma unroll
        for (int jp = 0; jp < 2; ++jp) { if (lat) stx8<XOB>(olat, ro + lane * 8 + 512 * jp, xn[2 * jp], xn[2 * jp + 1]); else stx8<false>(octx, ro + lane * 8 + 512 * jp, xn[2 * jp], xn[2 * jp + 1]); }
        const float rs2 = rsqrtf(wave_sum(s2) * (1.f / DM) + RMS_EPS);
        f32x4 h2[4];
#pragma unroll
        for (int j = 0; j < 4; ++j) { const int col = RCOL(j); const f32x4 gg = *(const f32x4*)(gpre + col), sh = *(const f32x4*)(mr + 3 * DM + col), sc = *(const f32x4*)(mr + 4 * DM + col);
            h2[j] = xn[j] * rs2 * gg * (sc + 1.f) + sh; }
#pragma unroll
        for (int jp = 0; jp < 2; ++jp) { const f32x4 p = h2[2 * jp], q = h2[2 * jp + 1]; const size_t o = (size_t)row * DM + lane * 8 + 512 * jp;
            if (MOE) { *(u32x2*)((unsigned char*)H2 + o) = pg8::pack8_fp8(p, q); }
            else { u32x4 w; w.x = cvtpk(p[0], p[1]); w.y = cvtpk(p[2], p[3]); w.z = cvtpk(q[0], q[1]); w.w = cvtpk(q[2], q[3]); *(u32x4*)(H2 + o) = w; } }
        if (MOE) {
            float lg[8];
#pragma unroll
            for (int e = 0; e < 8; ++e) { float s = 0.f;
#pragma unroll
                for (int j = 0; j < 4; ++j) { const f32x4 w = *(const LAS f32x4*)(rw + e * 1024 + RCOL(j)); s += (h2[j][0] * w[0] + h2[j][1] * w[1]) + (h2[j][2] * w[2] + h2[j][3] * w[3]); }
                lg[e] = wave_sum(s); }
            int e1 = 0; float v1 = lg[0];
#pragma unroll
            for (int e = 1; e < 8; ++e) if (lg[e] > v1) { v1 = lg[e]; e1 = e; }
            int e2 = -1; float v2 = -3.0e38f;
#pragma unroll
            for (int e = 0; e < 8; ++e) if (e != e1 && lg[e] > v2) { v2 = lg[e]; e2 = e; }
            if (lane == 0) { ((int*)(F_WS + WS_E12))[row] = e1 | (e2 << 8); ((float*)(F_WS + WS_G1))[row] = 1.f / (1.f + expf(v2 - v1));
                atomicAdd((int*)&hist[e1], 1); atomicAdd((int*)&hist[e2], 1); }
        }
    }
    if (MOE) { __syncthreads(); if (tid < 8) atomicAdd((unsigned*)(F_WS + WS_CTL) + CW_CNT + 64 * tid, (unsigned)hist[tid]); }
}
template <bool MOE, bool XIB, bool XOB> __device__ __forceinline__ void resid2_phase(const Frame& F, int l, const void* xlat, const float* xctx, void* olat, float* octx, const bf16_t* Fb, int nrows) {
    PHASE_IDS;
    const float* gpost = F_IN(I_POSTFFNG) + l * DM;
    for (int row = gw; row < nrows; row += F.ngw) {
        const bool lat = row < MLAT; const size_t ro = lat ? (size_t)row * DM : (size_t)(row - MLAT) * DM;
        const float* mr = mvec_row(F, l, row);
        f32x4 f[4], xv[4]; float ss = 0.f;
#pragma unroll
        for (int jp = 0; jp < 2; ++jp) { if (lat) ldx8<XIB>(xlat, ro + lane * 8 + 512 * jp, xv[2 * jp], xv[2 * jp + 1]); else ldx8<false>(xctx, ro + lane * 8 + 512 * jp, xv[2 * jp], xv[2 * jp + 1]); }
        if (MOE) { const int d1 = ((const int*)(F_WS + WS_DEST))[2 * row], d2 = ((const int*)(F_WS + WS_DEST))[2 * row + 1]; const float g1 = ((const float*)(F_WS + WS_G1))[row], g2 = 1.f - g1;
#pragma unroll
            for (int jp = 0; jp < 2; ++jp) { const u32x4 a = *(const u32x4*)(Fb + (size_t)d1 * DM + lane * 8 + 512 * jp), b = *(const u32x4*)(Fb + (size_t)d2 * DM + lane * 8 + 512 * jp);
                f[2 * jp] = (f32x4){bf_lo(a.x), bf_hi(a.x), bf_lo(a.y), bf_hi(a.y)} * g1 + (f32x4){bf_lo(b.x), bf_hi(b.x), bf_lo(b.y), bf_hi(b.y)} * g2;
                f[2 * jp + 1] = (f32x4){bf_lo(a.z), bf_hi(a.z), bf_lo(a.w), bf_hi(a.w)} * g1 + (f32x4){bf_lo(b.z), bf_hi(b.z), bf_lo(b.w), bf_hi(b.w)} * g2; }
        } else {
#pragma unroll
            for (int jp = 0; jp < 2; ++jp) { const u32x4 a = *(const u32x4*)(Fb + (size_t)row * DM + lane * 8 + 512 * jp);
                f[2 * jp] = (f32x4){bf_lo(a.x), bf_hi(a.x), bf_lo(a.y), bf_hi(a.y)}; f[2 * jp + 1] = (f32x4){bf_lo(a.z), bf_hi(a.z), bf_lo(a.w), bf_hi(a.w)}; }
        }
#pragma unroll
        for (int j = 0; j < 4; ++j) ss += (f[j][0] * f[j][0] + f[j][1] * f[j][1]) + (f[j][2] * f[j][2] + f[j][3] * f[j][3]);
        const float rs = rsqrtf(wave_sum(ss) * (1.f / DM) + RMS_EPS);
#pragma unroll
        for (int j = 0; j < 4; ++j) { const int col = lane * 8 + 512 * (j >> 1) + 4 * (j & 1);
            const f32x4 gg = *(const f32x4*)(gpost + col), gate = *(const f32x4*)(mr + 5 * DM + col);
            xv[j] = xv[j] + gate * (f[j] * rs * gg); }
#pragma unroll
        for (int jp = 0; jp < 2; ++jp) { if (lat) stx8<XOB>(olat, ro + lane * 8 + 512 * jp, xv[2 * jp], xv[2 * jp + 1]); else stx8<false>(octx, ro + lane * 8 + 512 * jp, xv[2 * jp], xv[2 * jp + 1]); }
    }
}
__device__ __forceinline__ void conv_phase(const Frame& F, int l, const bf16_t* __restrict__ LX, bf16_t* __restrict__ U) {
    PHASE_IDS;
    const float* cw = F_IN(I_CONVW) + l * 4 * DM; const float* cb = F_IN(I_CONVB) + l * DM;
    const int gt = F.c * NTHR + tid, ch = (gt & 127) * 8, rstep = (F.G * NTHR) >> 7;
    f32x4 w0[4], w1[4];
#pragma unroll
    for (int k = 0; k < 4; ++k) { w0[k] = *(const f32x4*)(cw + k * DM + ch); w1[k] = *(const f32x4*)(cw + k * DM + ch + 4); }
    const f32x4 b0 = *(const f32x4*)(cb + ch), b1 = *(const f32x4*)(cb + ch + 4);
#pragma unroll 2
    for (int row = gt >> 7; row < MTOT; row += rstep) {
        int t, ls; if (row < MLAT) { t = row & (SEQ - 1); ls = SEQ; } else { t = (row - MLAT) & (CTXL - 1); ls = CTXL; }
        f32x4 a0 = b0, a1 = b1;
#pragma unroll
        for (int k = 0; k < 4; ++k) { const int tt = t + k - 2; if (tt >= 0 && tt < ls) { f32x4 x0, x1; pg8::unpack8(*(const u32x4*)(LX + (size_t)(row + k - 2) * DM + ch), x0, x1);
                a0 += x0 * w0[k]; a1 += x1 * w1[k]; } }
        *(u32x4*)(U + (size_t)row * DM + ch) = pg8::pack8(a0, a1);
    }
}
__device__ __forceinline__ void pool_phase(const Frame& F, const bf16_t* __restrict__ Z2, bf16_t* __restrict__ MP) {
    PHASE_IDS;
    for (int task = F.c * NTHR + tid; task < (MTOT / 33) * 128; task += F.G * NTHR) {
        const int c8 = task & 127, row0 = (task >> 7) * 33, ch = c8 * 8, hw = 1 << (c8 >> 5);
        f32x4 s0 = {0.f, 0.f, 0.f, 0.f}, s1 = {0.f, 0.f, 0.f, 0.f};
#pragma unroll 3
        for (int d = 0; d < 33; ++d) { const int row = row0 + d; int t, ls; if (row < MLAT) { t = row & (SEQ - 1); ls = SEQ; } else { t = (row - MLAT) & (CTXL - 1); ls = CTXL; }
            const bf16_t* z = Z2 + (size_t)row * Z2LD + ch;
            if (d == 0 || t == 0) { s0 = (f32x4){0.f, 0.f, 0.f, 0.f}; s1 = s0;
                for (int tt = max(t - hw, 0); tt < min(t + hw, ls); ++tt) { f32x4 x0, x1; pg8::unpack8(*(const u32x4*)(z + (long)(tt - t) * Z2LD), x0, x1); s0 += x0; s1 += x1; } }
            const int lo = max(t - hw, 0), hi = min(t + hw, ls);
            f32x4 u0, u1; pg8::unpack8(*(const u32x4*)z, u0, u1);
            const float inv = 1.f / (float)(hi - lo);
            *(u32x4*)(MP + (size_t)row * DM + ch) = pg8::pack8(s0 * inv - u0, s1 * inv - u1);
            if (t + hw < ls) { f32x4 x0, x1; pg8::unpack8(*(const u32x4*)(z + (long)hw * Z2LD), x0, x1); s0 += x0; s1 += x1; }
            if (t - hw >= 0) { f32x4 x0, x1; pg8::unpack8(*(const u32x4*)(z - (long)hw * Z2LD), x0, x1); s0 -= x0; s1 -= x1; } }
    }
}
__device__ __forceinline__ void mla_prep_phase(const Frame& F, const bf16_t* __restrict__ Z2, unsigned char* __restrict__ KR) {
    PHASE_IDS;
    float* rq = (float*)(F_WS + WS_RSTDQ); float* rkv = (float*)(F_WS + WS_RSTDKV); const f32x2* rope = (const f32x2*)(F_WS + WS_ROPE);
    const int i = lane & 15, g = lane >> 4;
    for (int r0 = gw * 4; r0 < MTOT; r0 += F.ngw * 4) { const int row = r0 + g;
        const bf16_t* zr = Z2 + (size_t)row * Z2LD + 1024 + 8 * i;
        float sq = 0.f, skv = 0.f; f32x4 k0 = {0.f, 0.f, 0.f, 0.f}, k1 = k0;
#pragma unroll
        for (int c = 0; c < 6; ++c) { if (c < 5 || i < 8) { f32x4 a0, a1; pg8::unpack8(*(const u32x4*)(zr + 128 * c), a0, a1);
                const float s = (a0[0] * a0[0] + a0[1] * a0[1]) + (a0[2] * a0[2] + a0[3] * a0[3]) + (a1[0] * a1[0] + a1[1] * a1[1]) + (a1[2] * a1[2] + a1[3] * a1[3]);
                if (c < 3) sq += s; else if (c < 5) skv += s; else { k0 = a0; k1 = a1; } } }
#pragma unroll
        for (int o = 1; o < 16; o <<= 1) { sq += __shfl_xor(sq, o); skv += __shfl_xor(skv, o); }
        if (i == 0) { rq[row] = rsqrtf(sq * (1.f / QLORA) + RMS_EPS); rkv[row] = rsqrtf(skv * (1.f / KVLORA) + RMS_EPS); }
        float xo[8], xp[8];
#pragma unroll
        for (int j = 0; j < 4; ++j) { xo[j] = k0[j]; xo[4 + j] = k1[j]; }
#pragma unroll
        for (int j = 0; j < 8; ++j) xp[j] = __shfl_xor(xo[j], 2);
        int b, s, pos; if (row < MLAT) { b = row >> 13; s = row & (SEQ - 1); pos = s; } else { const int rc = row - MLAT; b = rc >> 8; s = SEQ + (rc & (CTXL - 1)); pos = SEQ; }
        const int axis = (i >> 2) & 1, half = (i >> 1) & 1, f0 = 8 * (i & 1);
        float res[8];
#pragma unroll
        for (int j = 0; j < 8; ++j) { const f32x2 cs = rope[(size_t)pos * 32 + axis * 16 + f0 + j];
            const float x1 = half ? xp[j] : xo[j], x2 = half ? xo[j] : xp[j];
            res[j] = half ? (x2 * cs.x + x1 * cs.y) : (x1 * cs.x - x2 * cs.y); }
        float rp[8];
#pragma unroll
        for (int j = 0; j < 8; ++j) rp[j] = __shfl_xor(res[j], 2);
        if (i < 8 && half == 0) {
            int w[4];
#pragma unroll
            for (int q = 0; q < 4; ++q) { int v = 0; v = __builtin_amdgcn_cvt_pk_fp8_f32(res[2 * q], rp[2 * q], v, false); v = __builtin_amdgcn_cvt_pk_fp8_f32(res[2 * q + 1], rp[2 * q + 1], v, true); w[q] = v; }
            *(u32x4*)(KR + ((size_t)b * SKV + s) * 64 + axis * 32 + 2 * f0) = (u32x4){(unsigned)w[0], (unsigned)w[1], (unsigned)w[2], (unsigned)w[3]}; }
    }
}
__device__ __forceinline__ int scan_row(int b, int dir, int tau) {
    if (dir == 0) return tau < CTXL ? MLAT + b * CTXL + tau : b * SEQ + (tau - CTXL);
    return tau < CTXL ? MLAT + b * CTXL + (CTXL - 1 - tau) : b * SEQ + (SEQ - 1 - (tau - CTXL));
}
__device__ __forceinline__ void scan_coef(unsigned la, unsigned gx, f32x2& a, f32x2& bb) {
    a.x = __builtin_amdgcn_exp2f(1.4426950408889634f * bf_lo(la)); a.y = __builtin_amdgcn_exp2f(1.4426950408889634f * bf_hi(la));
    bb.x = __builtin_amdgcn_sqrtf(fmaxf(1.f - a.x * a.x, 0.f)) * bf_lo(gx); bb.y = __builtin_amdgcn_sqrtf(fmaxf(1.f - a.y * a.y, 0.f)) * bf_hi(gx);
}
__device__ __forceinline__ float gelu_tanh_(float g) {
    const float u = 0.7978845608028654f * (g + 0.044715f * g * g * g); return g * __builtin_amdgcn_rcpf(1.f + __builtin_amdgcn_exp2f(-2.8853900817779268f * u));
}
__device__ __forceinline__ void scan_coef8(const u32x4 om, const u32x4 bb, f32x4& a0, f32x4& a1, f32x4& b0, f32x4& b1) {
    f32x4 o0, o1; pg8::unpack8(om, o0, o1); pg8::unpack8(bb, b0, b1); a0 = 1.f - o0; a1 = 1.f - o1;
}
__device__ __forceinline__ void scan_a_phase(const Frame& F, int dir, const bf16_t* __restrict__ LA, const bf16_t* __restrict__ GX) {
    PHASE_IDS;
    float* SA = (float*)(F_WS + WS_SUMA); float* SB = (float*)(F_WS + WS_SUMB);
    for (int task = wave * F.G + F.c; task < NB * NCHUNK * 2; task += F.ngw) {
        const int cb = task & 1, j = (task >> 1) % NCHUNK, b = (task >> 1) / NCHUNK, ch = cb * 512 + 8 * lane;
        f32x4 A0 = {1.f, 1.f, 1.f, 1.f}, A1 = A0, B0 = {0.f, 0.f, 0.f, 0.f}, B1 = B0;
        long off = (long)scan_row(b, dir, j * 64) * DM + ch; const long STP = dir == 0 ? (long)DM : -(long)DM;
        u32x4 laA[8], gxA[8], laB[8], gxB[8];
#define SA_LOAD(la, gx, o0) do { _Pragma("unroll") for (int k = 0; k < 8; ++k) { la[k] = *(const u32x4*)(LA + (o0) + k * STP); gx[k] = *(const u32x4*)(GX + (o0) + k * STP); } } while (0)
#define SA_STEP(la, gx) do { _Pragma("unroll") for (int k = 0; k < 8; ++k) { f32x4 a0, a1, b0, b1; scan_coef8(la[k], gx[k], a0, a1, b0, b1); B0 = a0 * B0 + b0; B1 = a1 * B1 + b1; A0 = A0 * a0; A1 = A1 * a1; } } while (0)
        SA_LOAD(laA, gxA, off);
#pragma unroll 1
        for (int s0 = 0; s0 < 64; s0 += 16) {
            SA_LOAD(laB, gxB, off + 8 * STP);
            SA_STEP(laA, gxA);
            if (s0 + 16 < 64) SA_LOAD(laA, gxA, off + 16 * STP);
            SA_STEP(laB, gxB);
            off += 16 * STP;
        }
#undef SA_LOAD
#undef SA_STEP
        float* pa = SA + ((size_t)b * NCHUNK + j) * DM + ch; float* pb = SB + ((size_t)b * NCHUNK + j) * DM + ch;
        *(f32x4*)pa = A0; *(f32x4*)(pa + 4) = A1; *(f32x4*)pb = B0; *(f32x4*)(pb + 4) = B1;
    }
}
template <int DIR> __device__ __forceinline__ void scan_b_phase(const Frame& F, const bf16_t* __restrict__ LA, const bf16_t* __restrict__ GX, bf16_t* HF, const bf16_t* __restrict__ LG) {
    PHASE_IDS;
    const float* SA = (const float*)(F_WS + WS_SUMA); const float* SB = (const float*)(F_WS + WS_SUMB);
    for (int task = wave * F.G + F.c; task < NB * NCHUNK * 2; task += F.ngw) {
        const int cb = task & 1, j = (task >> 1) % NCHUNK, b = (task >> 1) / NCHUNK, ch = cb * 512 + 8 * lane;
        f32x4 h0 = {0.f, 0.f, 0.f, 0.f}, h1 = h0;
#pragma unroll 8
        for (int jj = 0; jj < j; ++jj) { const float* pa = SA + ((size_t)b * NCHUNK + jj) * DM + ch; const float* pb = SB + ((size_t)b * NCHUNK + jj) * DM + ch;
            h0 = *(const f32x4*)pa * h0 + *(const f32x4*)pb; h1 = *(const f32x4*)(pa + 4) * h1 + *(const f32x4*)(pb + 4); }
        long off = (long)scan_row(b, DIR, j * 64) * DM + ch; constexpr long STP = DIR == 0 ? (long)DM : -(long)DM;
        u32x4 laA[4], gxA[4], hfA[4], lgA[4], laB[4], gxB[4], hfB[4], lgB[4];
#define SB_LOAD(la, gx, hf, lg, o0) do { _Pragma("unroll") for (int k = 0; k < 4; ++k) { const long o = (o0) + k * STP; la[k] = *(const u32x4*)(LA + o); gx[k] = *(const u32x4*)(GX + o); \
            if (DIR == 1) { hf[k] = *(const u32x4*)(HF + o); lg[k] = *(const u32x4*)(LG + o); } } } while (0)
#define SB_STEP(la, gx, hf, lg, o0) do { _Pragma("unroll") for (int k = 0; k < 4; ++k) { f32x4 a0, a1, b0, b1; scan_coef8(la[k], gx[k], a0, a1, b0, b1); \
            h0 = a0 * h0 + b0; h1 = a1 * h1 + b1; \
            if (DIR == 0) hf[k] = pg8::pack8(h0, h1); \
            else { f32x4 f0, f1, g0, g1; pg8::unpack8(hf[k], f0, f1); pg8::unpack8(lg[k], g0, g1); \
                f0 = (f0 + h0) * g0; f1 = (f1 + h1) * g1; \
                hf[k] = pg8::pack8(f0, f1); } } \
        _Pragma("unroll") for (int k = 0; k < 4; ++k) *(u32x4*)(HF + (o0) + k * STP) = hf[k]; } while (0)
        SB_LOAD(laA, gxA, hfA, lgA, off);
#pragma unroll 1
        for (int s0 = 0; s0 < 64; s0 += 8) {
            SB_LOAD(laB, gxB, hfB, lgB, off + 4 * STP);
            SB_STEP(laA, gxA, hfA, lgA, off);
            if (s0 + 8 < 64) SB_LOAD(laA, gxA, hfA, lgA, off + 8 * STP);
            SB_STEP(laB, gxB, hfB, lgB, off + 4 * STP);
            off += 8 * STP;
        }
#undef SB_LOAD
#undef SB_STEP
    }
}
__device__ __forceinline__ void moe_tile_table(const Frame& F, volatile LAS int* tend) {
    PHASE_IDS;
    if (tid == 0) { const unsigned* cnt = (const unsigned*)(F_WS + WS_CTL) + CW_CNT; int acc = 0;
        for (int e = 0; e < 8; ++e) { acc += ((int)__hip_atomic_load(cnt + 64 * e, __ATOMIC_RELAXED, __HIP_MEMORY_SCOPE_AGENT) + 255) >> 8; tend[e] = acc; } }
    __syncthreads();
}
__device__ __forceinline__ void moe_gather_phase(const Frame& F, const unsigned char* __restrict__ H2, unsigned char* __restrict__ XG) {
    PHASE_IDS;
    volatile LAS int* tend = (volatile LAS int*)(F.lds + MISC_OFF + 64);
    volatile LAS int* hist = (volatile LAS int*)(F.lds + 0); volatile LAS int* lbase = (volatile LAS int*)(F.lds + 64); volatile LAS int* dl = (volatile LAS int*)(F.lds + 128);
    moe_tile_table(F, tend);
    const int* e12 = (const int*)(F_WS + WS_E12); int* dest = (int*)(F_WS + WS_DEST); unsigned* cur = (unsigned*)(F_WS + WS_CTL) + CW_CUR;
    for (int blk = F.c; blk < MLAT / 128; blk += F.G) {
        if (tid < 8) hist[tid] = 0;
        __syncthreads();
        int e1 = 0, e2 = 0, r1 = 0, r2 = 0; const int tok = blk * 128 + tid;
        if (tid < 128) { const int w = e12[tok]; e1 = w & 255; e2 = (w >> 8) & 255; r1 = atomicAdd((int*)&hist[e1], 1); r2 = atomicAdd((int*)&hist[e2], 1); }
        __syncthreads();
        if (tid < 8) { const int base = (int)atomicAdd(cur + 64 * tid, (unsigned)hist[tid]); lbase[tid] = (tid == 0 ? 0 : tend[tid - 1]) * 256 + base; }
        __syncthreads();
        if (tid < 128) { const int d1 = lbase[e1] + r1, d2 = lbase[e2] + r2; dest[2 * tok] = d1; dest[2 * tok + 1] = d2; dl[2 * tid] = d1; dl[2 * tid + 1] = d2; }
        __syncthreads();
        for (int a = wave; a < 256; a += NWAVES) { const int d = dl[a]; const unsigned char* src = H2 + (size_t)(blk * 128 + (a >> 1)) * DM; unsigned char* dst = XG + (size_t)d * DM;
            *(u32x4*)(dst + 16 * lane) = *(const u32x4*)(src + 16 * lane); }
        __syncthreads();
    }
}

constexpr int PH_PRO0 = 0, PH_PRO1 = 1, PH_L0 = 2;
constexpr int LP_NORM = 0, LP_IN1 = 1, LP_CONV = 2, LP_GATE0 = 3, LP_SCANA0 = 4, LP_SCANB0 = 5, LP_GATE1 = 6, LP_SCANA1 = 7, LP_SCANB1 = 8, LP_MID = 9, LP_ATTN = 10,
              LP_GT = 11, LP_OUT1 = 12, LP_OUT2 = 13, LP_RES1 = 14, LP_F0 = 15;
constexpr int L0_NPH = 18;
constexpr int PH_L1 = PH_L0 + L0_NPH;
constexpr int L1_NPH = 15 + 1 + 10 + 1;
constexpr int NPHASES = PH_L1 + L1_NPH;

#ifdef PH_ONLY
#define IN(k) ((k) == PH_ONLY && in_range(A0, (k)))
#else
#define IN(k) in_range(A0, (k))
#endif
#define FRAME const Frame F = make_frame(A0, wave0)
__device__ __forceinline__ void grid_bar(ArgsP A0, int wave0) {
    extern __shared__ __attribute__((aligned(16))) unsigned char lds_raw[];
    XcdBarrier b; b.bar = bar_words(launder(A0)->ws); b.x = xb_xcc_id(); b.st = (volatile LAS unsigned*)((LAS unsigned char*)lds_raw + MISC_OFF); b.wave = wave0;
    xcd_barrier(b);
}
#define SEAM(k) do { if (!MK_PER_PHASE && IN((k) + 1)) { grid_bar(A0, wave0); } } while (0)
#define DYNP(off) ((bf16_t*)(F_WS + WS_DYN + (off)))

template <int L> __device__ __forceinline__ void layer_phases(ArgsP A0, const int wave0) {
    constexpr int P = L == 0 ? PH_L0 : PH_L1;
    constexpr size_t WL = WS_WTS + L * WTS_LSTRIDE;
    constexpr int nrows = L == 0 ? MTOT : MLAT, nmt = nrows / 256;
#define X1 ((bf16_t*)F_OUT)
#define X2 ((bf16_t*)F_OUT + (size_t)MLAT * DM)
#define X3 DYNP(D_HF)
#define XCTX (L == 0 ? F_IN(I_CTX) : (const float*)(F_WS + WS_XC))
#define XCOUT ((float*)(F_WS + WS_XC))

    if (IN(P + LP_NORM)) { FRAME;
        if constexpr (L == 0) norm1_phase<false>(F, L, F_IN(I_X), XCTX, DYNP(D_H), (unsigned char*)DYNP(D_H8), MTOT);
        else norm1_phase<true>(F, L, X2, XCTX, DYNP(D_H), (unsigned char*)DYNP(D_H8), MTOT);
        SEAM(P + LP_NORM); }
    if (IN(P + LP_IN1)) { FRAME;
        pg8::GridSched S{(const char*)DYNP(D_H), (const char*)(F_WS + WL + WO_IN1), MTOT / 256, 15, 16, DM, DM, F.G, F.c, 0, 0};
        pg8::EpiIn1 E{DYNP(D_LX), DYNP(D_LG), DYNP(D_Z2)};
        pg8::gemm_phase(F.lds, F.wave, DM, DM, S, E);
        SEAM(P + LP_IN1);
    }
    if (IN(P + LP_CONV)) { FRAME; conv_phase(F, L, DYNP(D_LX), DYNP(D_U)); mla_prep_phase(F, DYNP(D_Z2), (unsigned char*)(F_WS + WS_KR)); SEAM(P + LP_CONV); }
#pragma unroll
    for (int d = 0; d < 2; ++d) {
        const int pg = P + (d == 0 ? LP_GATE0 : LP_GATE1);
        if (IN(pg)) { FRAME;
            pg8::GateSched S{(const char*)DYNP(D_U), (const char*)(F_WS + WL + WO_GATE), MTOT / 256, F.G, F.c, d};
            pg8::EpiGates E{DYNP(D_LA), DYNP(D_GX), DYNP(D_U), F_IN(I_GAB) + (L * 2 + d) * 1024, F_IN(I_GXB) + (L * 2 + d) * 1024, (const float*)(F_WS + WS_SP8) + (L * 2 + d) * 1024};
            pg8::gemm_phase(F.lds, F.wave, DM, 128, S, E);
            SEAM(pg);
        }
        if (IN(pg + 1)) { FRAME; scan_a_phase(F, d, DYNP(D_LA), DYNP(D_GX)); SEAM(pg + 1); }
        if (IN(pg + 2)) { FRAME; if (d == 0) scan_b_phase<0>(F, DYNP(D_LA), DYNP(D_GX), DYNP(D_HF), DYNP(D_LG)); else scan_b_phase<1>(F, DYNP(D_LA), DYNP(D_GX), DYNP(D_HF), DYNP(D_LG)); SEAM(pg + 2); }
    }
    if (IN(P + LP_MID)) { FRAME;
        pool_phase(F, DYNP(D_Z2), DYNP(D_MP));
        { pg8::GridSched S{(const char*)(DYNP(D_Z2) + 1024), (const char*)(F_WS + WL + WO_UQ), nmt, 6, 6, Z2LD, QLORA, F.G, F.c, 0, 0};
          pg8::EpiQ E{(unsigned char*)DYNP(D_Q), (unsigned char*)(F_WS + WS_QC), (const float*)(F_WS + WS_RSTDQ), (const f32x2*)(F_WS + WS_ROPE)};
          pg8::gemm_phase(F.lds, F.wave, Z2LD, QLORA, S, E); }
        { pg8::GridSched S{(const char*)(DYNP(D_Z2) + 1024 + QLORA), (const char*)(F_WS + WL + WO_UKV), MTOT / 256, 4, 4, Z2LD, KVLORA, F.G, (F.c + 128) % F.G, 0, 0};
          pg8::EpiK E{(unsigned char*)DYNP(D_K), (const float*)(F_WS + WS_RSTDKV)};
          pg8::gemm_phase(F.lds, F.wave, Z2LD, KVLORA, S, E); }
        { pg8::GridSched S{(const char*)(F_WS + WL + WO_UKV + 1024 * KVLORA * 2), (const char*)(DYNP(D_Z2) + 1024 + QLORA), 4, MTOT / 256, 4, KVLORA, Z2LD, F.G, (F.c + 64) % F.G, 0, 0};
          pg8::EpiVT E{(unsigned char*)DYNP(D_V), (const float*)(F_WS + WS_RSTDKV)};
          pg8::gemm_phase(F.lds, F.wave, KVLORA, Z2LD, S, E); }
        SEAM(P + LP_MID);
    }
    if (IN(P + LP_ATTN)) { FRAME;
        const char* Qb = (const char*)DYNP(D_Q); const char* Kb = (const char*)DYNP(D_K); const char* Vb = (const char*)DYNP(D_V); char* AO = (char*)DYNP(D_AO); const char* QC = (const char*)((bf16_t*)(F_WS + WS_QC));
#pragma unroll 1
        for (int t = F.c; t < 1024 + (L == 0 ? 32 : 0); t += F.G) {
            const bool lat = t < 1024; const int cc = t & 255, bh = lat ? (t >> 8) * 8 + (cc & 7) : t - 1024, qb = cc >> 3, b = bh >> 3, h = bh & 7;
            const char* q = lat ? Qb + ((size_t)bh * SEQ + qb * 256) * DQK : QC + (size_t)bh * CTXL * DQK;
            const size_t k0 = (size_t)bh * SKV + (lat ? 0 : SEQ), kr0 = (size_t)b * SKV + (lat ? 0 : SEQ);
            char* o = AO + ((size_t)(lat ? b * SEQ + qb * 256 : MLAT + b * CTXL) * DM + h * DVH) * 2;
            att::attn_unit(q, Kb + k0 * 128, (const char*)(F_WS + WS_KR) + kr0 * 64, Vb + k0 * 128, o, lat ? SKV : CTXL, F.lds, F.wave);
        }
        __syncthreads();
        SEAM(P + LP_ATTN);
    }
    if (IN(P + LP_GT)) { FRAME;
        pg8::GridSched S{(const char*)DYNP(D_H8), (const char*)(F_WS + WL + WO_GT), nmt, 12, 8, DM / 2, DM / 2, F.G, F.c, 0, 0};
        pg8::EpiStore<1> E{DYNP(D_GT), 3072, 0, 1.f / 32.f};
        pg8::gemm_phase<pg8::EpiStore<1>, pg8::GridSched, true>(F.lds, F.wave, DM / 2, DM / 2, S, E);
        SEAM(P + LP_GT);
    }
    if (IN(P + LP_OUT1)) { FRAME;
        pg8::FatSched S{(const char*)(F_WS + WS_DYN), (const char*)(F_WS + WL), nmt, F.G, F.c};
        pg8::EpiOut1 E{DYNP(D_GT), DYNP(D_MG)};
        pg8::gemm_phase(F.lds, F.wave, DM, DM, S, E);
        SEAM(P + LP_OUT1);
    }
    if (IN(P + LP_OUT2)) { FRAME;
        pg8::GridSched S{(const char*)DYNP(D_MG), (const char*)(F_WS + WL + WO_OUT), nmt, 4, 16, DM, DM, F.G, F.c, 0, 0};
        pg8::EpiStore<0> E{DYNP(D_Y), DM, 0};
        pg8::gemm_phase(F.lds, F.wave, DM, DM, S, E);
        SEAM(P + LP_OUT2);
    }
    if constexpr (L == 0) {
        if (IN(P + LP_RES1)) { FRAME; resid1_phase<false, false, true>(F, L, F_IN(I_X), XCTX, X1, XCOUT, DYNP(D_Y), DYNP(D_H2), nrows); SEAM(P + LP_RES1); }
        if (IN(P + LP_F0)) { FRAME;
            pg8::GridSched S{(const char*)DYNP(D_H2), (const char*)(F_WS + WS_W13), nmt, 22, 16, DM, DM, F.G, F.c, 0, 0};
            pg8::EpiSwiglu8 E{(unsigned char*)DYNP(D_HID), DFF, 1.f};
            pg8::gemm_phase(F.lds, F.wave, DM, DM, S, E);
            SEAM(P + LP_F0);
        }
        if (IN(P + LP_F0 + 1)) { FRAME;
            pg8::GridSched S{(const char*)DYNP(D_HID), (const char*)(F_WS + WS_W2), nmt, 4, 22, DFF / 2, DFF / 2, F.G, F.c, 0, 0};
            pg8::EpiStoreS E{DYNP(D_F), DM, 0, 1.f / 64.f};
            pg8::gemm_phase<pg8::EpiStoreS, pg8::GridSched, true>(F.lds, F.wave, DFF / 2, DFF / 2, S, E);
            SEAM(P + LP_F0 + 1);
        }
        if (IN(P + LP_F0 + 2)) { FRAME; resid2_phase<false, true, true>(F, L, X1, XCOUT, X2, XCOUT, DYNP(D_F), nrows); SEAM(P + LP_F0 + 2); }
    } else {
        if (IN(P + LP_RES1)) { FRAME;
            resid1_phase<true, true, true>(F, L, X2, XCTX, X3, XCOUT, DYNP(D_Y), DYNP(D_H2), nrows);
            __syncthreads();
            int it0 = 0;
#pragma unroll 1
            for (int e = 0; e < NEXP; ++e) {
                wprep_fast8(F, it0, 1024, 7168, (unsigned char*)DYNP(D_WM13) + (size_t)e * 7168 * 1024, FastW13{F_IN(I_MOEW1) + (size_t)e * DM * EFF, (long)(F_IN(I_MOEW3) - F_IN(I_MOEW1)), EFF}, 32.f);
                wprep_fast8(F, it0, 3584, 1024, (unsigned char*)DYNP(D_WM2) + (size_t)e * 1024 * 3584, FastPlain{F_IN(I_MOEW2) + (size_t)e * EFF * DM, DM}, 64.f);
            }
            SEAM(P + LP_RES1);
        }
        if (IN(P + LP_F0)) { FRAME; moe_gather_phase(F, (const unsigned char*)DYNP(D_H2), (unsigned char*)DYNP(D_XG)); SEAM(P + LP_F0); }
        volatile LAS int* tend; { FRAME; tend = (volatile LAS int*)(F.lds + MISC_OFF + 64); }
#pragma unroll 1
        for (int g = 0; g < 5; ++g) {
            const int p13 = P + LP_F0 + 1 + 2 * g;
            if (!(IN(p13) || IN(p13 + 1))) continue;
            { FRAME; moe_tile_table(F, tend); }
#define TE(j) __builtin_amdgcn_readfirstlane(tend[j])
            const int ntiles = TE(7), t0 = g * 64, nM = min(64, ntiles - t0);
            if (IN(p13)) { FRAME;
                if (nM > 0) { pg8::MoeSched S{(const char*)DYNP(D_XG), (const char*)DYNP(D_WM13), {TE(0), TE(1), TE(2), TE(3), TE(4), TE(5), TE(6)}, (size_t)7168 * 1024, nM, 28, 8, DM / 2, DM / 2, F.G, F.c, t0, t0};
                    pg8::EpiSwiglu8 E{(unsigned char*)DYNP(D_HIDG), EFF};
                    pg8::gemm_phase<pg8::EpiSwiglu8, pg8::MoeSched, true>(F.lds, F.wave, DM / 2, DM / 2, S, E); }
                SEAM(p13);
            }
            if (IN(p13 + 1)) { FRAME;
                if (nM > 0) { pg8::MoeSched S{(const char*)DYNP(D_HIDG), (const char*)DYNP(D_WM2), {TE(0), TE(1), TE(2), TE(3), TE(4), TE(5), TE(6)}, (size_t)1024 * 3584, nM, 4, 28, EFF / 2, EFF / 2, F.G, F.c, t0, 0};
                    pg8::EpiStoreS E{DYNP(D_YR), DM, t0 * 256, 1.f / 64.f};
                    pg8::gemm_phase<pg8::EpiStoreS, pg8::MoeSched, true>(F.lds, F.wave, EFF / 2, EFF / 2, S, E); }
                SEAM(p13 + 1);
            }
        }
        if (IN(P + LP_F0 + 11)) { FRAME; resid2_phase<true, true, false>(F, L, X3, XCOUT, F_OUT, XCOUT, DYNP(D_YR), nrows); }
    }
#undef X1
#undef X2
#undef X3
#undef XCTX
#undef XCOUT
}

__global__ void __launch_bounds__(NTHR, 2) mega_fwd(Args args) {
    ArgsP A0 = (ArgsP)__builtin_amdgcn_kernarg_segment_ptr();
    (void)args;
    const int wave0 = __builtin_amdgcn_readfirstlane((int)threadIdx.x >> 6);
    { FRAME;
      volatile LAS unsigned* MISC = (volatile LAS unsigned*)(F.lds + MISC_OFF);
      const int tid0 = fresh_tid(F.wave); for (int u = tid0; u < (LDS_BYTES - MISC_OFF) / 4; u += NTHR) MISC[u] = 0u;
      __syncthreads();
      if (!MK_PER_PHASE) (void)xcd_barrier_post(bar_words(F_WS), MISC, F.wave);
    }

    if (IN(PH_PRO0)) { FRAME;
        mod_partials(F);
        rope_and_consts(F);
        int it0 = 0;
#pragma unroll 1
        for (int l = 0; l < 2; ++l) {
            unsigned char* wl = F_WS + WS_WTS + l * WTS_LSTRIDE;
            wprep_fast(F, it0, 1024, 3840, (bf16_t*)(wl + WO_IN1), FastIn1{F_IN(I_WIN) + (size_t)l * DM * INCOLS, INCOLS});
            wprep_fast8(F, it0, 1024, 3072, (unsigned char*)(wl + WO_GT), FastPlain{F_IN(I_WIN) + (size_t)l * DM * INCOLS + 3776, INCOLS}, 32.f);
#pragma unroll 1
            for (int nb = 0; nb < 8; ++nb)
                wprep_job(F, it0, 128, 512, (bf16_t*)(wl + WO_GATE) + (size_t)nb * 512 * 128, SrcGate{F_IN(I_GAW) + (size_t)l * 2 * 8 * 128 * 128, (long)(F_IN(I_GXW) - F_IN(I_GAW)), nb});
            wprep_job(F, it0, 1024, 1024, (bf16_t*)(wl + WO_LRU), SrcPlainS{F_IN(I_LRUPROJ) + (size_t)l * DM * DM, DM, ((ABL & 2) && ((ABL_L >> l) & 1)) ? 0.f : 1.f});
            wprep_job(F, it0, 384, 1536, (bf16_t*)(wl + WO_UQ), SrcUQ{F_IN(I_WUQ) + (size_t)l * 384 * 1536, F_IN(I_QNORMG) + l * 384});
            wprep_job(F, it0, 256, 2048, (bf16_t*)(wl + WO_UKV), SrcUKV{F_IN(I_WUKV) + (size_t)l * 256 * 2048, F_IN(I_KVNORMG) + l * 256});
            wprep_job(F, it0, 1024, 1024, (bf16_t*)(wl + WO_MLA), SrcPlainS{F_IN(I_MLAPROJ) + (size_t)l * DM * DM, DM, ((ABL & 4) && ((ABL_L >> l) & 1)) ? 0.f : 1.f});
            wprep_fast(F, it0, 1024, 1024, (bf16_t*)(wl + WO_OUT), FastPlain{F_IN(I_WOUT) + (size_t)l * DM * DM, DM});
        }
        wprep_fast(F, it0, 1024, 5632, (bf16_t*)(F_WS + WS_W13), FastW13{F_IN(I_FFNW1), (long)(F_IN(I_FFNW3) - F_IN(I_FFNW1)), DFF});
        wprep_fast8(F, it0, 2816, 1024, (unsigned char*)(F_WS + WS_W2), FastPlain{F_IN(I_FFNW2), DM}, 64.f);
        SEAM(PH_PRO0);
    }
    if (IN(PH_PRO1)) { FRAME;
        mod_reduce(F);
        pool_weights_phase(F);
        SEAM(PH_PRO1);
    }
    layer_phases<0>(A0, wave0);
    layer_phases<1>(A0, wave0);
}
#undef IN
#undef SEAM

extern "C" void kernel_launch(void* const* d_in, const int* in_sizes, int n_in, void* d_out, int out_size, void* d_ws, size_t ws_size, hipStream_t stream) {
    static int grid = 0;
    if (grid == 0) {
        if (n_in != 35 || out_size != MLAT * DM || ws_size < WS_END) { fprintf(stderr, "kernel_launch: unexpected shapes (n_in %d, out %d, ws %zu < %zu)\n", n_in, out_size, ws_size, (size_t)WS_END); grid = -1; return; }
        int dev = 0, cus = 0;
        if (hipGetDevice(&dev) != hipSuccess || hipDeviceGetAttribute(&cus, hipDeviceAttributeMultiprocessorCount, dev) != hipSuccess) { grid = -1; return; }
        if (hipFuncSetAttribute((const void*)mega_fwd, hipFuncAttributeMaxDynamicSharedMemorySize, LDS_BYTES) != hipSuccess) { fprintf(stderr, "kernel_launch: hipFuncSetAttribute failed\n"); grid = -1; return; }
        int per_cu = 0;
        if (hipOccupancyMaxActiveBlocksPerMultiprocessor(&per_cu, (const void*)mega_fwd, NTHR, LDS_BYTES) != hipSuccess || per_cu < 1) { fprintf(stderr, "kernel_launch: occupancy query says %d\n", per_cu); }
        (void)hipGetLastError();
        grid = cus;
    }
    if (grid < 0) return;
    (void)hipMemsetAsync((char*)d_ws + WS_CTL, 0, CTL_BYTES, stream);
    Args a{};
    for (int i = 0; i < 35; ++i) a.in[i] = (const float*)d_in[i];
    a.out = (float*)d_out; a.ws = (unsigned char*)d_ws;
#if MK_PER_PHASE
    for (int p = 0; p < NPHASES; ++p) { a.ph_lo = p; a.ph_hi = p + 1; hipLaunchKernelGGL(mega_fwd, dim3(grid), dim3(NTHR), LDS_BYTES, stream, a); }
#else
    a.ph_lo = 0; a.ph_hi = NPHASES;
    hipLaunchKernelGGL(mega_fwd, dim3(grid), dim3(NTHR), LDS_BYTES, stream, a);
#endif
}
```

```cpp
#include <hip/hip_runtime.h>
#include <stdint.h>
#include <stdio.h>

#ifndef ABL
#define ABL 0
#endif
#ifndef ABL_L
#define ABL_L 3
#endif
#ifndef MK_PER_PHASE
#define MK_PER_PHASE 0
#endif

#define LAS __attribute__((address_space(3)))
typedef unsigned short bf16_t;
typedef short bf16x8 __attribute__((ext_vector_type(8)));
typedef short s16x4 __attribute__((ext_vector_type(4)));
typedef float f32x4 __attribute__((ext_vector_type(4)));
typedef float f32x2 __attribute__((ext_vector_type(2)));
typedef float f32x16 __attribute__((ext_vector_type(16)));
typedef unsigned u32x4 __attribute__((ext_vector_type(4)));
typedef unsigned u32x2 __attribute__((ext_vector_type(2)));

constexpr int DM = 1024, NB = 4, SEQ = 8192, CTXL = 256, MLAT = NB * SEQ, MCTX = NB * CTXL, MTOT = MLAT + MCTX;
constexpr int INCOLS = 6848, NH = 8, DQK = 192, DVH = 128, SKV = SEQ + CTXL;
constexpr int QLORA = 384, KVLORA = 256, DFF = 2816, NEXP = 8, EFF = 3584;
constexpr float RMS_EPS = 1e-6f;
constexpr int Z2LD = 1792;
constexpr int NCHUNK = SKV / 64;

constexpr size_t MiB = 1u << 20;
constexpr size_t WS_CTL = 0, CTL_BYTES = 1 * MiB;
constexpr size_t WS_MVEC = 1 * MiB;
constexpr size_t WS_MPART = 2 * MiB;
constexpr size_t WS_KR = 2 * MiB;
constexpr size_t WS_ROPE = 10 * MiB;
constexpr size_t WS_SP8 = 12 * MiB + 512 * 1024;
constexpr size_t WS_RSTDQ = 13 * MiB, WS_RSTDKV = 13 * MiB + 256 * 1024;
constexpr size_t WS_SUMA = 14 * MiB, WS_SUMB = 16 * MiB + 512 * 1024;
constexpr size_t WS_E12 = 19 * MiB, WS_G1 = 19 * MiB + 128 * 1024, WS_DEST = 19 * MiB + 256 * 1024;
constexpr size_t WS_XC = 20 * MiB;
constexpr size_t WS_WTS = 25 * MiB, WTS_LSTRIDE = 25 * MiB;
constexpr size_t WO_IN1 = 0, WO_GT = 7 * MiB + 512 * 1024, WO_POOL = 13 * MiB + 512 * 1024, WO_GATE = 15 * MiB + 512 * 1024, WO_LRU = 16 * MiB + 512 * 1024,
                 WO_UQ = 18 * MiB + 512 * 1024, WO_UKV = 19 * MiB + 640 * 1024, WO_MLA = 20 * MiB + 640 * 1024, WO_OUT = 22 * MiB + 640 * 1024;
constexpr size_t WS_W13 = 75 * MiB, WS_W2 = 86 * MiB, WS_PPT = 91 * MiB + 512 * 1024  , WS_PWS = 95 * MiB + 512 * 1024  ;
constexpr size_t WS_DYN = 97 * MiB;
constexpr size_t SLAB = 66 * MiB;
constexpr size_t HM = 512 * 1024;
constexpr size_t D_H8 = 0  , D_H = 33 * MiB, D_Z2 = 99 * MiB, D_LX = 214 * MiB + HM, D_LA = 214 * MiB + HM, D_LG = 280 * MiB + HM, D_U = 346 * MiB + HM, D_GX = 412 * MiB + HM, D_HF = 478 * MiB + HM;
constexpr size_t D_MP = 33 * MiB, D_K = 214 * MiB + HM, D_V = 280 * MiB + HM, D_Q = 346 * MiB + HM  , D_AO = 99 * MiB;
constexpr size_t D_GT = 214 * MiB + HM, D_MG = 412 * MiB + HM, D_Y = 214 * MiB + HM, D_H2 = 280 * MiB + HM, D_HID = 0, D_F = 346 * MiB + HM;
constexpr size_t D_WM13 = 0, D_WM2 = 56 * MiB, D_XG = 84 * MiB, D_HIDG = 150 * MiB, D_YR = 346 * MiB + HM;
constexpr size_t WS_QC = 6 * MiB + HM;
constexpr size_t WS_END = WS_DYN + 544 * MiB + HM;
constexpr int CW_BAR = 4096, CW_CNT = 8192, CW_CUR = 8192 + 512;

constexpr int STAGE_BYTES = 131072, MISC_OFF = STAGE_BYTES, LDS_BYTES = STAGE_BYTES + 1024;
constexpr int NWAVES = 8, NTHR = 512;

#define LDS_WAIT() asm volatile("s_waitcnt lgkmcnt(0)" ::: "memory")
#define VM_WAIT() asm volatile("s_waitcnt vmcnt(0)" ::: "memory")
typedef __bf16 bf16x2_t __attribute__((ext_vector_type(2)));
__device__ __forceinline__ unsigned cvtpk(float lo, float hi) { const f32x2 v = {lo, hi}; return __builtin_bit_cast(unsigned, __builtin_convertvector(v, bf16x2_t)); }
__device__ __forceinline__ float bf_lo(unsigned w) { return __uint_as_float(w << 16); }
__device__ __forceinline__ float bf_hi(unsigned w) { return __uint_as_float(w & 0xffff0000u); }
__device__ __forceinline__ float bf2f(bf16_t b) { return __uint_as_float(((unsigned)b) << 16); }
__device__ __forceinline__ float wave_sum(float v) {
#pragma unroll
    for (int o = 1; o < 64; o <<= 1) v += __shfl_xor(v, o);
    return v;
}
__device__ __forceinline__ float sigmoidf_(float x) { return __builtin_amdgcn_rcpf(1.f + __builtin_amdgcn_exp2f(-1.4426950408889634f * x)); }

__device__ __forceinline__ int fresh_tid(int wave) { int l; asm volatile("v_mbcnt_lo_u32_b32 %0, -1, 0\n\tv_mbcnt_hi_u32_b32 %0, -1, %0" : "=v"(l)); return wave * 64 + l; }
#define XB_TMO      128
#define XB_XCNT(j)  (256  + 64 * (j))
#define XB_XSUB(j)  (1280 + 64 * (j))
#define XB_XGEN(j)  (2304 + 64 * (j))
#define XB_TOP      3328
#define XB_TOPGEN   3392
#define XCD_BAR_WORDS 3456
#define XB_SPIN_CAP (1u << 18)
__device__ __forceinline__ unsigned xb_ld(unsigned* p)              { return __hip_atomic_load(p, __ATOMIC_RELAXED, __HIP_MEMORY_SCOPE_AGENT); }
__device__ __forceinline__ unsigned xb_add(unsigned* p, unsigned v) { return __hip_atomic_fetch_add(p, v, __ATOMIC_RELAXED, __HIP_MEMORY_SCOPE_AGENT); }
__device__ __forceinline__ unsigned xb_xcc_id() { return (unsigned)__builtin_amdgcn_s_getreg((3 << 11) | 20) & 0xFu; }
#define XB_SPIN(cond, bar) do { unsigned _sp = 0; while (cond) { __builtin_amdgcn_s_sleep(1); \
    if ((++_sp & 255u) == 0u) { if (xb_ld(&(bar)[XB_TMO])) break; if (_sp > XB_SPIN_CAP) { atomicAdd(&(bar)[XB_TMO], 1u); break; } } } } while (0)
struct XcdBarrier { unsigned* bar; unsigned x; volatile LAS unsigned* st; int wave; };
__device__ __forceinline__ XcdBarrier xcd_barrier_post(unsigned* bar, volatile LAS unsigned* st, int wave) {
    XcdBarrier b; b.bar = bar; b.x = xb_xcc_id(); b.st = st; b.wave = wave;
    if (fresh_tid(wave) == 0) (void)xb_add(&bar[XB_XCNT(b.x)], 1u);
    return b;
}
__device__ __forceinline__ void xcd_barrier_complete(unsigned* bar, unsigned x, unsigned& nloc, unsigned& nx) {
    const unsigned G = gridDim.x * gridDim.y * gridDim.z;
    unsigned sum, cnt, mine, sp = 0u;
    for (;;) {
        sum = 0u; cnt = 0u; mine = 0u;
#pragma unroll
        for (unsigned j = 0; j < 16; ++j) { const unsigned c = xb_ld(&bar[XB_XCNT(j)]); sum += c; cnt += (c > 0u) ? 1u : 0u; mine = (j == x) ? c : mine; }
        if (sum == G) break;
        __builtin_amdgcn_s_sleep(1);
        if ((++sp & 255u) == 0u) { if (xb_ld(&bar[XB_TMO])) break; if (sp > XB_SPIN_CAP) { atomicAdd(&bar[XB_TMO], 1u); break; } }
    }
    nloc = mine > 0u ? mine : 1u; nx = cnt > 0u ? cnt : 1u;
}
__device__ __forceinline__ void xcd_barrier(const XcdBarrier& b) {
    asm volatile("s_waitcnt vmcnt(0)" ::: "memory");
    __syncthreads();
    if (fresh_tid(b.wave) == 0) {
        unsigned* bar = b.bar;
        __builtin_amdgcn_s_waitcnt(0);
        unsigned nloc = b.st[0], nx = b.st[1];
        if (nloc == 0u) { xcd_barrier_complete(bar, b.x, nloc, nx); b.st[0] = nloc; b.st[1] = nx; }
        const unsigned old = xb_add(&bar[XB_XSUB(b.x)], 1u);
        const unsigned gen = old / nloc;
        if (old + 1u == (gen + 1u) * nloc) {
            __builtin_amdgcn_fence(__ATOMIC_RELEASE, "agent");
            asm volatile("s_waitcnt vmcnt(0)" ::: "memory");
            const unsigned og = xb_add(&bar[XB_TOP], 1u);
            const unsigned tg = og / nx;
            if (og + 1u == (tg + 1u) * nx) xb_add(&bar[XB_TOPGEN], 1u);
            else XB_SPIN(xb_ld(&bar[XB_TOPGEN]) == tg, bar);
            __builtin_amdgcn_fence(__ATOMIC_ACQUIRE, "agent");
            xb_add(&bar[XB_XGEN(b.x)], 1u);
            asm volatile("s_waitcnt vmcnt(0)" ::: "memory");
        } else {
            XB_SPIN(xb_ld(&bar[XB_XGEN(b.x)]) == gen, bar);
            __builtin_amdgcn_fence(__ATOMIC_ACQUIRE, "agent");
            asm volatile("s_waitcnt vmcnt(0)" ::: "memory");
        }
    }
    __syncthreads();
}

__device__ __forceinline__ unsigned* bar_words(unsigned char* ws) { return (unsigned*)(ws + WS_CTL) + CW_BAR; }
namespace pg8 {
constexpr int BM = 256, BK = 64, HALF = 128, HTB = HALF * BK * 2, NXCD = 8, WGM = 8;
__host__ __device__ __forceinline__ int lds_byte(int r, int c) { const int st = (r >> 4) * 2 + (c >> 5), rr = r & 15, cc = c & 31, ob = rr * 64 + cc * 2; return st * 1024 + (ob ^ (((ob >> 9) & 1) << 5)); }
__host__ __device__ __forceinline__ void stage_rc(int b, int& R, int& C) { const int st = b / 1024, sb = b % 1024, swz = sb ^ (((sb >> 9) & 1) << 5); R = (st >> 1) * 16 + swz / 64; C = (st & 1) * 32 + (swz % 64) / 2; }
__host__ __device__ __forceinline__ int perm32(int rho) { const int n = rho >> 4, i = rho & 15; return 8 * (i >> 2) + 4 * n + (i & 3); }

typedef int i32x8 __attribute__((ext_vector_type(8)));
__device__ __forceinline__ i32x8 cat8(const bf16x8 lo, const bf16x8 hi) { const u32x4 a = __builtin_bit_cast(u32x4, lo), b = __builtin_bit_cast(u32x4, hi); return (i32x8){(int)a.x, (int)a.y, (int)a.z, (int)a.w, (int)b.x, (int)b.y, (int)b.z, (int)b.w}; }
__device__ __forceinline__ const char* uptr(const char* p) {
    const unsigned long long v = (unsigned long long)p; const unsigned lo = __builtin_amdgcn_readfirstlane((unsigned)v), hi = __builtin_amdgcn_readfirstlane((unsigned)(v >> 32));
    return (const char*)(((unsigned long long)hi << 32) | lo); }
template <bool FP8> struct Frag;
template <> struct Frag<false> { bf16x8 k[2]; };
template <> struct Frag<true> { i32x8 v; };
struct Unit { const char* a; const char* b; int nt; int pm, pn, aux; };

__device__ __forceinline__ void tile_of(int wgid, int nM, int nN, int& pm, int& pn) {
    const int nwg = nM * nN; { const int q = nwg / NXCD, r = nwg % NXCD, xcd = wgid % NXCD, off = wgid / NXCD; wgid = (xcd < r ? xcd * (q + 1) : r * (q + 1) + (xcd - r) * q) + off; }
    const int nig = WGM * nN, gid = wgid / nig, fm = gid * WGM, gsz = (nM - fm) < WGM ? (nM - fm) : WGM;
    pm = fm + ((wgid % nig) % gsz); pn = (wgid % nig) / gsz;
}

template <class Epi, class Sched, bool FP8 = false>
__device__ __forceinline__ void gemm_phase(LAS unsigned char* lds, const int wid, const int lda, const int ldb, const Sched& S, const Epi& E) {
    const int tid = fresh_tid(wid), lane = tid & 63, wr = wid >> 2, wc = wid & 3, fr = lane & 15, fq = lane >> 4;
    unsigned voffA[2], voffB[2];
#pragma unroll
    for (int i = 0; i < 2; ++i) { int R, C; stage_rc(tid * 16 + i * 8192, R, C); const int Rb = (R & ~31) + perm32(R & 31);
        voffA[i] = (unsigned)(R * lda + C) * 2u; voffB[i] = (unsigned)(Rb * ldb + C) * 2u; }
    const size_t kstep = (size_t)(BK * 2);
    const size_t hstepA = (size_t)HALF * lda * 2, hstepB = (size_t)HALF * ldb * 2;
    const unsigned ldsw = (unsigned)wid * 1024u;
    const int aoff = FP8 ? lds_byte(wr * 64 + fr, fq * 16) : lds_byte(wr * 64 + fr, fq * 8), boff = FP8 ? lds_byte(wc * 32 + fr, fq * 16) : lds_byte(wc * 32 + fr, fq * 8);
#define PG8_SA(b, h) (((b) * 2 + (h)) * HTB)
#define PG8_SB(b, h) ((4 + (b) * 2 + (h)) * HTB)
#define PG8_STAGE(bufoff, gbase, voff) do { _Pragma("unroll") for (int _i = 0; _i < 2; ++_i) \
        __builtin_amdgcn_global_load_lds((const unsigned*)((const char*)(gbase) + (voff)[_i]), (LAS unsigned*)(lds + (bufoff) + ldsw + _i * 8192), 16, 0, 0); } while (0)
#define PG8_LDA(dst, b, h) do { if constexpr (FP8) { _Pragma("unroll") for (int m = 0; m < 4; ++m) dst##8[m] = cat8(*(const LAS bf16x8*)(lds + PG8_SA(b, h) + aoff + m * 2048), *(const LAS bf16x8*)(lds + PG8_SA(b, h) + aoff + m * 2048 + 16)); } \
        else { _Pragma("unroll") for (int m = 0; m < 4; ++m) _Pragma("unroll") for (int k = 0; k < 2; ++k) dst[m][k] = *(const LAS bf16x8*)(lds + PG8_SA(b, h) + aoff + m * 2048 + k * 1024); } } while (0)
#define PG8_LDB(dst, b, h) do { if constexpr (FP8) { _Pragma("unroll") for (int n = 0; n < 2; ++n) dst##8[n] = cat8(*(const LAS bf16x8*)(lds + PG8_SB(b, h) + boff + n * 2048), *(const LAS bf16x8*)(lds + PG8_SB(b, h) + boff + n * 2048 + 16)); } \
        else { _Pragma("unroll") for (int n = 0; n < 2; ++n) _Pragma("unroll") for (int k = 0; k < 2; ++k) dst[n][k] = *(const LAS bf16x8*)(lds + PG8_SB(b, h) + boff + n * 2048 + k * 1024); } } while (0)
#define PG8_MMA(ai, bj, At, Bt) do { __builtin_amdgcn_s_setprio(1); if constexpr (FP8) { _Pragma("unroll") for (int m = 0; m < 4; ++m) _Pragma("unroll") for (int n = 0; n < 2; ++n) \
        asm volatile("v_mfma_scale_f32_16x16x128_f8f6f4 %0, %1, %2, %0, %3, %3 op_sel_hi:[0,0,0]" : "+v"(acc[ai][bj][m][n]) : "v"(Bt##8[n]), "v"(At##8[m]), "v"(one8)); } \
        else { _Pragma("unroll") for (int m = 0; m < 4; ++m) _Pragma("unroll") for (int n = 0; n < 2; ++n) _Pragma("unroll") for (int k = 0; k < 2; ++k) \
        acc[ai][bj][m][n] = __builtin_amdgcn_mfma_f32_16x16x32_bf16(Bt[n][k], At[m][k], acc[ai][bj][m][n], 0, 0, 0); } __builtin_amdgcn_s_setprio(0); } while (0)
#define PG8_WAIT_V(n) asm volatile("s_waitcnt vmcnt(" #n ")" ::: "memory")
#define PG8_WAIT_L(n) asm volatile("s_waitcnt lgkmcnt(" #n ")" ::: "memory")
#define PG8_BAR __builtin_amdgcn_s_barrier()
#define PG8_SCHED __builtin_amdgcn_sched_barrier(0)
    Unit cur, nxt; int ui = 0;
    if (!S.next(0, cur)) return;
    f32x4 acc[2][2][4][2];
#pragma unroll
    for (int a = 0; a < 2; ++a)
#pragma unroll
        for (int b = 0; b < 2; ++b)
#pragma unroll
            for (int m = 0; m < 4; ++m)
#pragma unroll
                for (int n = 0; n < 2; ++n) acc[a][b][m][n] = (f32x4){0.f, 0.f, 0.f, 0.f};
    bf16x8 At[4][2], B0[2][2], B1[2][2]; i32x8 At8[4], B08[2], B18[2];
    const int one8 = 0x7f7f7f7f;
    const char* cA = FP8 ? uptr(cur.a) : cur.a; const char* cB = FP8 ? uptr(cur.b) : cur.b;
    PG8_STAGE(PG8_SB(0, 0), cB, voffB); PG8_STAGE(PG8_SB(0, 1), cB + hstepB, voffB); PG8_STAGE(PG8_SA(0, 0), cA, voffA); PG8_STAGE(PG8_SA(0, 1), cA + hstepA, voffA);
    if (wr == 1) PG8_BAR;
    PG8_WAIT_V(2); PG8_BAR;
    PG8_STAGE(PG8_SB(1, 0), cB + kstep, voffB); PG8_STAGE(PG8_SA(1, 0), cA + kstep, voffA); PG8_STAGE(PG8_SB(1, 1), cB + hstepB + kstep, voffB);
    PG8_WAIT_V(6); PG8_BAR;
    for (;;) {
        const bool has_next = S.next(ui + 1, nxt);
        const char* nA = has_next ? nxt.a : cA; const char* nB = has_next ? nxt.b : cB; if constexpr (FP8) { nA = uptr(nA); nB = uptr(nB); }
        const int nt = cur.nt;
        for (int t = 0; t < nt; t += 2) {
            const bool last = (t == nt - 2);
            const char* a1 = cA + (size_t)(t + 1) * kstep;
            const char* a2 = last ? nA : cA + (size_t)(t + 2) * kstep; const char* b2 = last ? nB : cB + (size_t)(t + 2) * kstep;
            const char* a3 = a2 + kstep; const char* b3 = b2 + kstep;
            PG8_LDB(B0, 0, 0); PG8_LDB(B1, 0, 1); PG8_SCHED; PG8_LDA(At, 0, 0); PG8_STAGE(PG8_SA(1, 1), a1 + hstepA, voffA);
            PG8_WAIT_V(8); PG8_WAIT_L(0); PG8_BAR; PG8_MMA(0, 0, At, B0); PG8_MMA(0, 1, At, B1); PG8_BAR; PG8_SCHED;
            PG8_LDA(At, 0, 1); PG8_STAGE(PG8_SB(0, 0), b2, voffB); PG8_STAGE(PG8_SB(0, 1), b2 + hstepB, voffB); PG8_STAGE(PG8_SA(0, 0), a2, voffA);
            PG8_WAIT_V(8); PG8_WAIT_L(0); PG8_BAR; PG8_MMA(1, 0, At, B0); PG8_MMA(1, 1, At, B1); PG8_BAR; PG8_SCHED;
            PG8_LDB(B0, 1, 0); PG8_LDB(B1, 1, 1); PG8_SCHED; PG8_LDA(At, 1, 0); PG8_STAGE(PG8_SA(0, 1), a2 + hstepA, voffA);
            PG8_WAIT_V(8); PG8_WAIT_L(0); PG8_BAR; PG8_MMA(0, 0, At, B0); PG8_MMA(0, 1, At, B1); PG8_BAR; PG8_SCHED;
            PG8_LDA(At, 1, 1); PG8_STAGE(PG8_SB(1, 0), b3, voffB); PG8_STAGE(PG8_SB(1, 1), b3 + hstepB, voffB); PG8_STAGE(PG8_SA(1, 0), a3, voffA);
            PG8_WAIT_V(8); PG8_WAIT_L(0); PG8_BAR; PG8_MMA(1, 0, At, B0); PG8_MMA(1, 1, At, B1); PG8_BAR; PG8_SCHED;
        }
        if (wr == 0) PG8_BAR;
        if constexpr (FP8) asm volatile("s_nop 7\n\ts_nop 7\n\ts_nop 7" ::: "memory");
        const bool keep = E(acc, cur, wr, wc, fr, fq);
        if (!has_next) break;
        if (!keep) {
#pragma unroll
        for (int a = 0; a < 2; ++a)
#pragma unroll
            for (int b = 0; b < 2; ++b)
#pragma unroll
                for (int m = 0; m < 4; ++m)
#pragma unroll
                    for (int n = 0; n < 2; ++n) acc[a][b][m][n] = (f32x4){0.f, 0.f, 0.f, 0.f};
        }
        cur = nxt; cA = nA; cB = nB; ++ui;
        if (wr == 1) PG8_BAR;
    }
    PG8_WAIT_V(0);
    PG8_BAR;
#undef PG8_SA
#undef PG8_SB
#undef PG8_STAGE
#undef PG8_LDA
#undef PG8_LDB
#undef PG8_MMA
#undef PG8_WAIT_V
#undef PG8_WAIT_L
#undef PG8_BAR
#undef PG8_SCHED
}

struct GridSched {
    const char* A; const char* B; int nM, nN, nt, lda, ldb, G, c, pm0, aux;
    __device__ __forceinline__ bool next(int i, Unit& u) const {
        const int L = __builtin_amdgcn_readfirstlane(i * G + c); if (L >= nM * nN) return false;
        int pm, pn; tile_of(L, nM, nN, pm, pn);
        u.pm = pm0 + pm; u.pn = pn; u.aux = aux; u.nt = nt;
        u.a = A + (size_t)(pm0 + pm) * 256 * lda * 2; u.b = B + (size_t)pn * 256 * ldb * 2; return true;
    }
};
struct GateSched {
    const char* U; const char* W; int nM, G, c, dir;
    __device__ __forceinline__ bool next(int i, Unit& u) const {
        const int L = __builtin_amdgcn_readfirstlane(i * G + c); if (L >= nM * 8) return false;
        int pm, pn; tile_of(L, nM, 8, pm, pn);
        u.pm = pm; u.pn = pn; u.aux = dir; u.nt = 2;
        u.a = U + (size_t)pm * 256 * DM * 2 + (size_t)pn * 128 * 2; u.b = W + ((size_t)pn * 512 + (size_t)dir * 256) * 128 * 2; return true;
    }
};
struct FatSched {
    const char* dyn; const char* wl; int nM, G, c;
    __device__ __forceinline__ bool next(int i, Unit& u) const {
        const int seg = i % 3, L = __builtin_amdgcn_readfirstlane((i / 3) * G + c); if (L >= nM * 4) return false;
        int pm, pn; tile_of(L, nM, 4, pm, pn);
        u.pm = pm; u.pn = pn; u.aux = seg; u.nt = 16;
        const size_t oa = seg == 0 ? D_MP : (seg == 1 ? D_HF : D_AO), ob = seg == 0 ? WO_POOL : (seg == 1 ? WO_LRU : WO_MLA);
        u.a = dyn + oa + (size_t)pm * 256 * DM * 2; u.b = wl + ob + (size_t)pn * 256 * DM * 2; return true;
    }
};
struct MoeSched {
    const char* A; const char* B; int te[7]; size_t estride; int nM, nN, nt, lda, ldb, G, c, t0, arow0;
    __device__ __forceinline__ bool next(int i, Unit& u) const {
        const int L = __builtin_amdgcn_readfirstlane(i * G + c); if (L >= nM * nN) return false;
        int pm, pn; tile_of(L, nM, nN, pm, pn);
        const int tg = t0 + pm; int e = 0;
#pragma unroll
        for (int j = 0; j < 7; ++j) e += (tg >= te[j]) ? 1 : 0;
        u.pm = pm; u.pn = pn; u.aux = e; u.nt = nt;
        u.a = A + (size_t)(arow0 + pm) * 256 * lda * 2; u.b = B + (size_t)e * estride + (size_t)pn * 256 * ldb * 2; return true;
    }
};
struct PoolSched { const char* A; const char* B; int G, c;
    __device__ __forceinline__ bool next(int i, Unit& u) const { const int L = __builtin_amdgcn_readfirstlane(i * G + c); if (L >= 32) return false; const int l = L >> 4; u.pm = L & 3; u.pn = (L >> 2) & 3; u.aux = l; u.nt = 4;
        u.a = A + (size_t)l * DM * DM * 2 + (size_t)u.pm * 256 * DM * 2 + (size_t)u.pn * 256 * 2; u.b = B + ((size_t)l * 4 + u.pn) * 65536 * 2; return true; } };
__device__ __forceinline__ u32x4 pack8(const f32x4 v0, const f32x4 v1) { u32x4 w; w.x = cvtpk(v0[0], v0[1]); w.y = cvtpk(v0[2], v0[3]); w.z = cvtpk(v1[0], v1[1]); w.w = cvtpk(v1[2], v1[3]); return w; }
__device__ __forceinline__ void unpack8(const u32x4 w, f32x4& v0, f32x4& v1) { v0 = (f32x4){bf_lo(w.x), bf_hi(w.x), bf_lo(w.y), bf_hi(w.y)}; v1 = (f32x4){bf_lo(w.z), bf_hi(w.z), bf_lo(w.w), bf_hi(w.w)}; }
template <int ACT>
__device__ __forceinline__ void store_tile(const f32x4 (&acc)[2][2][4][2], bf16_t* base, int ldc, int row0, int col0, int wr, int wc, int fr, int fq, const float scale = 1.f) {
#pragma unroll
    for (int ai = 0; ai < 2; ++ai)
#pragma unroll
        for (int m = 0; m < 4; ++m) { bf16_t* rowp = base + (size_t)(row0 + ai * HALF + wr * 64 + m * 16 + fr) * ldc + col0 + wc * 32 + 8 * fq;
#pragma unroll
            for (int bj = 0; bj < 2; ++bj) { f32x4 v0 = acc[ai][bj][m][0] * scale, v1 = acc[ai][bj][m][1] * scale;
                if (ACT == 1) {
#pragma unroll
                    for (int j = 0; j < 4; ++j) { v0[j] = sigmoidf_(v0[j]); v1[j] = sigmoidf_(v1[j]); } }
                if (ACT == 2) {
#pragma unroll
                    for (int j = 0; j < 4; ++j) { v0[j] = v0[j] * sigmoidf_(1.5957691216057308f * (v0[j] + 0.044715f * v0[j] * v0[j] * v0[j])); v1[j] = v1[j] * sigmoidf_(1.5957691216057308f * (v1[j] + 0.044715f * v1[j] * v1[j] * v1[j])); } }
                *(u32x4*)(rowp + bj * HALF) = pack8(v0, v1); } }
}
struct EpiIn1 {
    bf16_t* LX; bf16_t* LG; bf16_t* Z2;
    __device__ __forceinline__ bool operator()(f32x4 (&acc)[2][2][4][2], const Unit& u, int wr, int wc, int fr, int fq) const {
        if (u.pn >= 4 && u.pn < 8) { store_tile<2>(acc, LG, DM, u.pm * 256, (u.pn - 4) * 256, wr, wc, fr, fq); return false; }
        bf16_t* base; int ldc, ct;
        if (u.pn < 4) { base = LX; ldc = DM; ct = u.pn * 256; } else { base = Z2; ldc = Z2LD; ct = (u.pn - 8) * 256; }
        store_tile<0>(acc, base, ldc, u.pm * 256, ct, wr, wc, fr, fq); return false;
    }
};
template <int ACT> struct EpiStore {
    bf16_t* O; int ldc; int rowoff; float scale = 1.f;
    __device__ __forceinline__ bool operator()(f32x4 (&acc)[2][2][4][2], const Unit& u, int wr, int wc, int fr, int fq) const {
        store_tile<ACT>(acc, O, ldc, rowoff + u.pm * 256, u.pn * 256, wr, wc, fr, fq, scale); return false;
    }
};
struct EpiPool {
    bf16_t* O;
    __device__ __forceinline__ bool operator()(f32x4 (&acc)[2][2][4][2], const Unit& u, int wr, int wc, int fr, int fq) const {
        store_tile<0>(acc, O + (size_t)u.aux * (WTS_LSTRIDE / 2), DM, u.pm * 256, u.pn * 256, wr, wc, fr, fq); return false;
    }
};
__device__ __forceinline__ u32x2 pack8_fp8(const f32x4 v0, const f32x4 v1) {
    int lo = 0, hi = 0; lo = __builtin_amdgcn_cvt_pk_fp8_f32(v0[0], v0[1], lo, false); lo = __builtin_amdgcn_cvt_pk_fp8_f32(v0[2], v0[3], lo, true);
    hi = __builtin_amdgcn_cvt_pk_fp8_f32(v1[0], v1[1], hi, false); hi = __builtin_amdgcn_cvt_pk_fp8_f32(v1[2], v1[3], hi, true); return (u32x2){(unsigned)lo, (unsigned)hi};
}
struct EpiSwiglu8 {
    unsigned char* O; int ldc; float sc = 0.03125f;
    __device__ __forceinline__ bool operator()(f32x4 (&acc)[2][2][4][2], const Unit& u, int wr, int wc, int fr, int fq) const {
#pragma unroll
        for (int ai = 0; ai < 2; ++ai)
#pragma unroll
            for (int m = 0; m < 4; ++m) { unsigned char* rowp = O + (size_t)(u.pm * 256 + ai * HALF + wr * 64 + m * 16 + fr) * ldc + u.pn * 128 + wc * 32 + 8 * fq;
                f32x4 v0, v1;
#pragma unroll
                for (int j = 0; j < 4; ++j) { const float a0 = acc[ai][0][m][0][j] * sc, a1 = acc[ai][0][m][1][j] * sc;
                    v0[j] = a0 * sigmoidf_(a0) * (acc[ai][1][m][0][j] * sc); v1[j] = a1 * sigmoidf_(a1) * (acc[ai][1][m][1][j] * sc); }
                *(u32x2*)rowp = pack8_fp8(v0, v1); }
        return false;
    }
};
struct EpiStoreS {
    bf16_t* O; int ldc; int rowoff; float scale;
    __device__ __forceinline__ bool operator()(f32x4 (&acc)[2][2][4][2], const Unit& u, int wr, int wc, int fr, int fq) const {
#pragma unroll
        for (int ai = 0; ai < 2; ++ai)
#pragma unroll
            for (int m = 0; m < 4; ++m) { bf16_t* rowp = O + (size_t)(rowoff + u.pm * 256 + ai * HALF + wr * 64 + m * 16 + fr) * ldc + u.pn * 256 + wc * 32 + 8 * fq;
#pragma unroll
                for (int bj = 0; bj < 2; ++bj) *(u32x4*)(rowp + bj * HALF) = pack8(acc[ai][bj][m][0] * scale, acc[ai][bj][m][1] * scale); }
        return false;
    }
};
struct EpiSwiglu {
    bf16_t* O; int ldc;
    __device__ __forceinline__ bool operator()(f32x4 (&acc)[2][2][4][2], const Unit& u, int wr, int wc, int fr, int fq) const {
#pragma unroll
        for (int ai = 0; ai < 2; ++ai)
#pragma unroll
            for (int m = 0; m < 4; ++m) { bf16_t* rowp = O + (size_t)(u.pm * 256 + ai * HALF + wr * 64 + m * 16 + fr) * ldc + u.pn * 128 + wc * 32 + 8 * fq;
                f32x4 v0, v1;
#pragma unroll
                for (int j = 0; j < 4; ++j) { const float a0 = acc[ai][0][m][0][j], a1 = acc[ai][0][m][1][j];
                    v0[j] = a0 * sigmoidf_(a0) * acc[ai][1][m][0][j]; v1[j] = a1 * sigmoidf_(a1) * acc[ai][1][m][1][j]; }
                *(u32x4*)rowp = pack8(v0, v1); }
        return false;
    }
};
struct EpiGates {
    bf16_t* LA; bf16_t* GX; const bf16_t* U; const float* ba; const float* bx; const float* sp8;
    __device__ __forceinline__ bool operator()(f32x4 (&acc)[2][2][4][2], const Unit& u, int wr, int wc, int fr, int fq) const {
        const int ch0 = u.pn * 128 + wc * 32 + 8 * fq;
        const f32x4 ba0 = *(const f32x4*)(ba + ch0), ba1 = *(const f32x4*)(ba + ch0 + 4), bx0 = *(const f32x4*)(bx + ch0), bx1 = *(const f32x4*)(bx + ch0 + 4);
        const f32x4 sp0 = *(const f32x4*)(sp8 + ch0), sp1 = *(const f32x4*)(sp8 + ch0 + 4);
#pragma unroll
        for (int ai = 0; ai < 2; ++ai)
#pragma unroll
            for (int m = 0; m < 4; ++m) { const size_t off = (size_t)(u.pm * 256 + ai * HALF + wr * 64 + m * 16 + fr) * DM + ch0;
                f32x4 u0, u1; unpack8(*(const u32x4*)(U + off), u0, u1);
                f32x4 l0, l1, g0, g1;
#pragma unroll
                for (int j = 0; j < 4; ++j) {
                    const float e0 = __builtin_amdgcn_exp2f(1.4426950408889634f * sp0[j] * sigmoidf_(acc[ai][0][m][0][j] + ba0[j])), e1 = __builtin_amdgcn_exp2f(1.4426950408889634f * sp1[j] * sigmoidf_(acc[ai][0][m][1][j] + ba1[j]));
                    l0[j] = 1.f - e0; l1[j] = 1.f - e1;
                    g0[j] = __builtin_amdgcn_sqrtf(fmaxf(1.f - e0 * e0, 0.f)) * (sigmoidf_(acc[ai][1][m][0][j] + bx0[j]) * u0[j]); g1[j] = __builtin_amdgcn_sqrtf(fmaxf(1.f - e1 * e1, 0.f)) * (sigmoidf_(acc[ai][1][m][1][j] + bx1[j]) * u1[j]); }
                *(u32x4*)(LA + off) = pack8(l0, l1); *(u32x4*)(GX + off) = pack8(g0, g1); }
        return false;
    }
};
struct EpiQ {
    unsigned char* Q; unsigned char* QC; const float* rstd; const f32x2* rope;
    __device__ __forceinline__ bool operator()(f32x4 (&acc)[2][2][4][2], const Unit& u, int wr, int wc, int fr, int fq) const {
#pragma unroll
        for (int ai = 0; ai < 2; ++ai)
#pragma unroll
            for (int m = 0; m < 4; ++m) { const int row = u.pm * 256 + ai * HALF + wr * 64 + m * 16 + fr; const float rs = rstd[row];
                int b, t, pos; unsigned char* base; int slen;
                if (row < MLAT) { b = row >> 13; t = row & (SEQ - 1); pos = t; base = Q; slen = SEQ; } else { const int rc = row - MLAT; b = rc >> 8; t = rc & (CTXL - 1); pos = SEQ; base = QC; slen = CTXL; }
#pragma unroll
                for (int bj = 0; bj < 2; ++bj) { const int c = u.pn * 256 + bj * HALF + wc * 32 + 8 * fq, h = c / DQK, dd = c - h * DQK;
                    const float rq = rs * (0.07216878364870322f * 1.4426950408889634f);
                    f32x4 v0 = acc[ai][bj][m][0] * rq, v1 = acc[ai][bj][m][1] * rq;
                    if (dd >= 128) { const int p0 = dd - 128; const f32x2* tab = rope + (size_t)pos * 32 + (p0 >> 5) * 16 + ((p0 & 31) >> 1);
                        const f32x4 cs01 = *(const f32x4*)tab, cs23 = *(const f32x4*)(tab + 2);
                        f32x4 w0, w1;
                        w0[0] = v0[0] * cs01[0] - v0[1] * cs01[1]; w0[1] = v0[1] * cs01[0] + v0[0] * cs01[1];
                        w0[2] = v0[2] * cs01[2] - v0[3] * cs01[3]; w0[3] = v0[3] * cs01[2] + v0[2] * cs01[3];
                        w1[0] = v1[0] * cs23[0] - v1[1] * cs23[1]; w1[1] = v1[1] * cs23[0] + v1[0] * cs23[1];
                        w1[2] = v1[2] * cs23[2] - v1[3] * cs23[3]; w1[3] = v1[3] * cs23[2] + v1[2] * cs23[3];
                        v0 = w0; v1 = w1; }
                    *(u32x2*)(base + ((size_t)(b * NH + h) * slen + t) * DQK + dd) = pack8_fp8(v0, v1); } }
        return false;
    }
};
struct EpiK {
    unsigned char* K; const float* rstd;
    __device__ __forceinline__ bool operator()(f32x4 (&acc)[2][2][4][2], const Unit& u, int wr, int wc, int fr, int fq) const {
        const int cl = wc * 32 + 8 * fq;
#pragma unroll
        for (int ai = 0; ai < 2; ++ai)
#pragma unroll
            for (int m = 0; m < 4; ++m) { const int row = u.pm * 256 + ai * HALF + wr * 64 + m * 16 + fr; const float rs = rstd[row];
                int b, s; if (row < MLAT) { b = row >> 13; s = row & (SEQ - 1); } else { const int rc = row - MLAT; b = rc >> 8; s = SEQ + (rc & (CTXL - 1)); }
#pragma unroll
                for (int bj = 0; bj < 2; ++bj) { const size_t key = (size_t)(b * NH + 2 * u.pn + bj) * SKV + s;
                    *(u32x2*)(K + key * 128 + cl) = pack8_fp8(acc[ai][bj][m][0] * rs, acc[ai][bj][m][1] * rs); } }
        return false;
    }
};
struct EpiVT {
    unsigned char* VT; const float* rstd;
    __device__ __forceinline__ bool operator()(f32x4 (&acc)[2][2][4][2], const Unit& u, int wr, int wc, int fr, int fq) const {
#pragma unroll
        for (int bj = 0; bj < 2; ++bj) { const int tk = u.pn * 256 + bj * HALF + wc * 32 + 8 * fq;
            int b, s; if (tk < MLAT) { b = tk >> 13; s = tk & (SEQ - 1); } else { const int rc = tk - MLAT; b = rc >> 8; s = SEQ + (rc & (CTXL - 1)); }
            const f32x4 rs0 = *(const f32x4*)(rstd + tk), rs1 = *(const f32x4*)(rstd + tk + 4);
            const int kk = s & 63, pos = 16 * (kk >> 5) + 4 * ((kk >> 3) & 3);
#pragma unroll
            for (int ai = 0; ai < 2; ++ai)
#pragma unroll
                for (int m = 0; m < 4; ++m) { const int row = u.pm * 256 + ai * HALF + wr * 64 + m * 16 + fr, h = row >> 7, dv = row & 127;
                    unsigned char* base = VT + ((size_t)(b * NH + h) * (SKV / 64) + (s >> 6)) * 8192 + dv * 64 + pos;
                    const f32x4 v0 = acc[ai][bj][m][0] * rs0, v1 = acc[ai][bj][m][1] * rs1;
                    int w0 = 0, w1 = 0; w0 = __builtin_amdgcn_cvt_pk_fp8_f32(v0[0], v0[1], w0, false); w0 = __builtin_amdgcn_cvt_pk_fp8_f32(v0[2], v0[3], w0, true);
                    w1 = __builtin_amdgcn_cvt_pk_fp8_f32(v1[0], v1[1], w1, false); w1 = __builtin_amdgcn_cvt_pk_fp8_f32(v1[2], v1[3], w1, true);
                    *(int*)base = w0; *(int*)(base + 32) = w1; } }
        return false;
    }
};
struct EpiOut1 {
    const bf16_t* GT; bf16_t* MG;
    __device__ __forceinline__ bool operator()(f32x4 (&acc)[2][2][4][2], const Unit& u, int wr, int wc, int fr, int fq) const {
        const int seg = u.aux;
#pragma unroll
        for (int ai = 0; ai < 2; ++ai)
#pragma unroll
            for (int m = 0; m < 4; ++m) { const int row = u.pm * 256 + ai * HALF + wr * 64 + m * 16 + fr;
#pragma unroll
                for (int bj = 0; bj < 2; ++bj) { const int c = u.pn * 256 + bj * HALF + wc * 32 + 8 * fq;
                    f32x4 a0, a1; unpack8(*(const u32x4*)(GT + (size_t)row * 3072 + seg * DM + c), a0, a1);
                    if (seg < 2) { f32x4 b0, b1; unpack8(*(const u32x4*)(GT + (size_t)row * 3072 + (seg + 1) * DM + c), b0, b1);
#pragma unroll
                        for (int j = 0; j < 4; ++j) { a0[j] = a0[j] * __builtin_amdgcn_rcpf(b0[j]); a1[j] = a1[j] * __builtin_amdgcn_rcpf(b1[j]); } }
                    acc[ai][bj][m][0] *= a0; acc[ai][bj][m][1] *= a1;
                    if (seg == 2) *(u32x4*)(MG + (size_t)row * DM + c) = pack8(acc[ai][bj][m][0], acc[ai][bj][m][1]); }
                asm volatile("" ::: "memory"); }
        return seg < 2;
    }
};
}

namespace att {
constexpr int DK = 192, DV = 128, NW = 8, QBLK = 32, KVBLK = 64;
constexpr float SCALE = 0.07216878364870322f;
constexpr float THR = 3.f;
constexpr int SHM_V = KVBLK * DV, SHM_K = KVBLK * DK;
constexpr int SHM_ATTN = 3 * SHM_V + 2 * SHM_K + NW * 64 * 4;
static_assert(SHM_ATTN <= STAGE_BYTES, "attention LDS fits the stage region");
#define SBAR() __builtin_amdgcn_sched_barrier(0)
__device__ __forceinline__ int crow(int r, int hi) { return (r & 3) + 8 * (r >> 2) + 4 * hi; }
__device__ __forceinline__ int k_off(int row, int c24) { return (c24 >> 3) * 8192 + row * 128 + (((c24 & 7) ^ ((row >> 1) & 7)) << 4); }
template <bool FIRST> __device__ __forceinline__ void partialSM(f32x16& p0, f32x16& p1, f32x16& negM, float& alpha) {
  constexpr float T2 = 4.f + THR * 1.4426950408889634f;
  float pmax = p0[0];
#pragma unroll
  for (int r = 1; r < 16; ++r) pmax = fmaxf(pmax, p0[r]);
#pragma unroll
  for (int r = 0; r < 16; ++r) pmax = fmaxf(pmax, p1[r]);
  { auto rr = __builtin_amdgcn_permlane32_swap(__float_as_uint(pmax), __float_as_uint(pmax), false, false);
    pmax = fmaxf(__uint_as_float(rr[0]), __uint_as_float(rr[1])); }
  if (!FIRST && __builtin_expect(__all(pmax <= T2), 1)) { alpha = 1.f; }
  else { const float delta = FIRST ? pmax - 4.f : fmaxf(pmax - 4.f, 0.f); alpha = FIRST ? 1.f : __builtin_amdgcn_exp2f(-delta);
#pragma unroll
    for (int r = 0; r < 16; ++r) { negM[r] -= delta; p0[r] -= delta; p1[r] -= delta; } }
#pragma unroll
  for (int r = 0; r < 16; ++r) p0[r] = __builtin_amdgcn_exp2f(p0[r]);
}
__device__ __forceinline__ void finishSM(f32x16& p0, f32x16& p1, float alpha, float& l_reg, pg8::i32x8& P8) {
#pragma unroll
  for (int r = 0; r < 16; ++r) p1[r] = __builtin_amdgcn_exp2f(p1[r]);
  float ps0 = p0[0], ps1 = p0[1], ps2 = p0[2], ps3 = p0[3];
#pragma unroll
  for (int r = 4; r < 16; r += 4) { ps0 += p0[r]; ps1 += p0[r + 1]; ps2 += p0[r + 2]; ps3 += p0[r + 3]; }
#pragma unroll
  for (int r = 0; r < 16; r += 4) { ps0 += p1[r]; ps1 += p1[r + 1]; ps2 += p1[r + 2]; ps3 += p1[r + 3]; }
  float ps = (ps0 + ps1) + (ps2 + ps3);
  { auto rr = __builtin_amdgcn_permlane32_swap(__float_as_uint(ps), __float_as_uint(ps), false, false);
    ps = __uint_as_float(rr[0]) + __uint_as_float(rr[1]); }
  l_reg = l_reg * alpha + ps;
#pragma unroll
  for (int q = 0; q < 4; ++q) { int w = __float_as_int(p0[4 * q]), x = __float_as_int(p1[4 * q]);
    w = __builtin_amdgcn_cvt_pk_fp8_f32(p0[4 * q], p0[4 * q + 1], w, false); w = __builtin_amdgcn_cvt_pk_fp8_f32(p0[4 * q + 2], p0[4 * q + 3], w, true);
    x = __builtin_amdgcn_cvt_pk_fp8_f32(p1[4 * q], p1[4 * q + 1], x, false); x = __builtin_amdgcn_cvt_pk_fp8_f32(p1[4 * q + 2], p1[4 * q + 3], x, true);
    P8[q] = w; P8[4 + q] = x; }
}
__device__ __forceinline__ void qkt(f32x16& p0, f32x16& p1, const LAS unsigned char* Ks, const pg8::i32x8* qf, int ko0, int ko1, const f32x16& negM) {
  p0 = negM; p1 = negM;
#pragma unroll
  for (int i = 0; i < 3; ++i) {
    const u32x4 a0 = *(const LAS u32x4*)(Ks + i * 4096 + ko0), a1 = *(const LAS u32x4*)(Ks + i * 4096 + ko1);
    const u32x4 b0 = *(const LAS u32x4*)(Ks + i * 4096 + 2048 + ko0), b1 = *(const LAS u32x4*)(Ks + i * 4096 + 2048 + ko1);
    const pg8::i32x8 ka = {(int)a0.x, (int)a0.y, (int)a0.z, (int)a0.w, (int)a1.x, (int)a1.y, (int)a1.z, (int)a1.w}, kb = {(int)b0.x, (int)b0.y, (int)b0.z, (int)b0.w, (int)b1.x, (int)b1.y, (int)b1.z, (int)b1.w};
    p0 = __builtin_amdgcn_mfma_scale_f32_32x32x64_f8f6f4(ka, qf[i], p0, 0, 0, 0, 0x7f7f7f7f, 0, 0x7f7f7f7f);
    p1 = __builtin_amdgcn_mfma_scale_f32_32x32x64_f8f6f4(kb, qf[i], p1, 0, 0, 0, 0x7f7f7f7f, 0, 0x7f7f7f7f); }
}
__device__ __forceinline__ void pv8(f32x16* o, const LAS unsigned char* Vs, const pg8::i32x8 P8, int ko0, int ko1) {
#pragma unroll
  for (int d0 = 0; d0 < 4; ++d0) { const u32x4 a = *(const LAS u32x4*)(Vs + d0 * 2048 + ko0), b = *(const LAS u32x4*)(Vs + d0 * 2048 + ko1);
    const pg8::i32x8 v = {(int)a.x, (int)a.y, (int)a.z, (int)a.w, (int)b.x, (int)b.y, (int)b.z, (int)b.w};
    o[d0] = __builtin_amdgcn_mfma_scale_f32_32x32x64_f8f6f4(P8, v, o[d0], 0, 0, 0, 0x7f7f7f7f, 0, 0x7f7f7f7f); }
}
__device__ __forceinline__ void attn_unit(const char* __restrict__ Qb, const char* __restrict__ Kh, const char* __restrict__ Kr, const char* __restrict__ Vh, char* __restrict__ Ob, int seq, LAS unsigned char* lds, const int wid) {
  const int tid = fresh_tid(wid), lane = tid & 63, r32 = lane & 31, hi = lane >> 5;
  LAS unsigned char* V_lds = lds; LAS unsigned char* K_lds = lds + 3 * SHM_V;
  LAS float* ws = (LAS float*)(lds + 3 * SHM_V + 2 * SHM_K) + wid * 64; LAS float* li_l = ws; LAS float* al_l = ws + 32;
  float l_reg = 0; f32x16 o[4] = {}, negM = {}; pg8::i32x8 qf[3];
  const unsigned qoff = (unsigned)((wid * QBLK + r32) * DK + hi * 32);
#pragma unroll
  for (int i = 0; i < 3; ++i) { const u32x4 a = *reinterpret_cast<const u32x4*>(Qb + qoff + i * 64), b = *reinterpret_cast<const u32x4*>(Qb + qoff + i * 64 + 16);
    qf[i] = (pg8::i32x8){(int)a.x, (int)a.y, (int)a.z, (int)a.w, (int)b.x, (int)b.y, (int)b.z, (int)b.w}; }
  const int ko0 = r32 * 64 + 16 * ((2 * hi) ^ ((r32 >> 2) & 3)), ko1 = ko0 ^ 16;
  const unsigned kswz = (unsigned)(((lane & 3) ^ ((lane >> 4) & 3)) << 4), krow = (unsigned)(16 * (wid & 3) + (lane >> 2));
  const unsigned kgn = krow * 128 + 64 * (wid >> 2) + kswz, kgr = krow * 64 + kswz;
  LAS unsigned char* kdst = K_lds + (wid >> 2) * 4096 + (wid & 3) * 1024; LAS unsigned char* kdst2 = K_lds + 8192 + (wid & 3) * 1024;
  const unsigned vg = (unsigned)((16 * wid + (lane >> 2)) * 64) + kswz;
  LAS unsigned char* vdst = V_lds + wid * 1024;
#define SLOAD(k0, kb, vboff) do { \
    __builtin_amdgcn_global_load_lds((const unsigned*)(Vh + (size_t)(k0) * 128 + vg), (LAS unsigned*)(vdst + (vboff)), 16, 0, 0); \
    __builtin_amdgcn_global_load_lds((const unsigned*)(Kh + (size_t)(k0) * 128 + kgn), (LAS unsigned*)(kdst + (kb) * SHM_K), 16, 0, 0); \
    if (wid < 4) __builtin_amdgcn_global_load_lds((const unsigned*)(Kr + (size_t)(k0) * 64 + kgr), (LAS unsigned*)(kdst2 + (kb) * SHM_K), 16, 0, 0); } while (0)
#define TILE_SYNC() do { asm volatile("s_waitcnt vmcnt(0)" ::: "memory"); __syncthreads(); } while (0)
#define RESC(a) do { if (__any((a) < 1.f)) { if (hi == 0) al_l[r32] = (a); asm volatile("s_waitcnt lgkmcnt(0)" ::: "memory"); \
    _Pragma("unroll") for (int d = 0; d < 4; ++d) _Pragma("unroll") for (int r = 0; r < 16; ++r) o[d][r] *= al_l[crow(r, hi)]; } } while (0)
#define VROT(x) do { (x) += SHM_V; if ((x) == 3 * SHM_V) (x) = 0; } while (0)
  f32x16 pA0, pA1, pB0, pB1; float alA, alB; pg8::i32x8 P8; const int NT = seq / KVBLK;
  __syncthreads();
  SLOAD(0, 0, 0); TILE_SYNC();
  qkt(pA0, pA1, K_lds, qf, ko0, ko1, negM); partialSM<true>(pA0, pA1, negM, alA);
  SLOAD(KVBLK, 1, SHM_V); TILE_SYNC();
  int vrd = 0, vwr = 2 * SHM_V;
  for (int j = 1; j + 1 < NT; j += 2) {
    SBAR(); qkt(pB0, pB1, K_lds + SHM_K, qf, ko0, ko1, negM);
    finishSM(pA0, pA1, alA, l_reg, P8); SBAR();
    SLOAD((j + 1) * KVBLK, 0, vwr); SBAR();
    pv8(o, V_lds + vrd, P8, ko0, ko1); partialSM<false>(pB0, pB1, negM, alB);
    RESC(alB); VROT(vrd); VROT(vwr); TILE_SYNC();
    SBAR(); qkt(pA0, pA1, K_lds, qf, ko0, ko1, negM);
    finishSM(pB0, pB1, alB, l_reg, P8); SBAR();
    SLOAD((j + 2) * KVBLK, 1, vwr); SBAR();
    pv8(o, V_lds + vrd, P8, ko0, ko1); partialSM<false>(pA0, pA1, negM, alA);
    RESC(alA); VROT(vrd); VROT(vwr); TILE_SYNC();
  }
  SBAR(); qkt(pB0, pB1, K_lds + SHM_K, qf, ko0, ko1, negM);
  finishSM(pA0, pA1, alA, l_reg, P8); SBAR();
  pv8(o, V_lds + vrd, P8, ko0, ko1); partialSM<false>(pB0, pB1, negM, alB);
  RESC(alB); VROT(vrd);
  finishSM(pB0, pB1, alB, l_reg, P8); SBAR();
  pv8(o, V_lds + vrd, P8, ko0, ko1);
  if (hi == 0) li_l[r32] = l_reg; asm volatile("s_waitcnt lgkmcnt(0)" ::: "memory");
  float rli[16];
#pragma unroll
  for (int r = 0; r < 16; ++r) rli[r] = __builtin_amdgcn_rcpf(li_l[crow(r, hi)]);
  const unsigned ob0 = (unsigned)((wid * QBLK + 4 * hi) * DM + r32) * 2u;
#pragma unroll
  for (int r = 0; r < 16; ++r) {
#pragma unroll
    for (int d0 = 0; d0 < 4; ++d0) *(bf16_t*)(Ob + ob0 + (unsigned)(((r & 3) + 8 * (r >> 2)) * DM + d0 * 32) * 2u) = (bf16_t)(cvtpk(o[d0][r] * rli[r], 0.f) & 0xffffu); }
#undef SLOAD
#undef TILE_SYNC
#undef RESC
#undef VROT
}
}

struct Args { const float* in[35]; float* out; unsigned char* ws; int ph_lo, ph_hi; };
enum { I_X = 0, I_C, I_CTX, I_CCTX, I_MODW, I_MODB, I_PREMIXG, I_POSTMIXG, I_PREFFNG, I_POSTFFNG, I_WIN, I_POOLW, I_POOLSCALE, I_POOLPROJ, I_CONVW, I_CONVB,
       I_GAW, I_GAB, I_GXW, I_GXB, I_LAMBDA, I_LRUPROJ, I_QNORMG, I_WUQ, I_KVNORMG, I_WUKV, I_MLAPROJ, I_WOUT, I_FFNW1, I_FFNW3, I_FFNW2, I_ROUTERW, I_MOEW1, I_MOEW3, I_MOEW2 };

typedef const __attribute__((address_space(4))) Args* ArgsP;
struct Frame {
    LAS unsigned char* lds; int G, c, ngw, wave;
    ArgsP A;
};
__device__ __forceinline__ ArgsP launder(ArgsP a) { asm volatile("" : "+s"(a)); return a; }
__device__ __forceinline__ Frame make_frame(ArgsP A0, int wave) {
    extern __shared__ __attribute__((aligned(16))) unsigned char lds_raw[];
    Frame F; F.A = launder(A0); F.lds = (LAS unsigned char*)lds_raw; F.G = gridDim.x; F.c = blockIdx.x; F.ngw = F.G * NWAVES; F.wave = wave; return F;
}
__device__ __forceinline__ bool in_range(ArgsP A0, int k) { ArgsP a = launder(A0); return a->ph_lo <= k && k < a->ph_hi; }
#define PHASE_IDS const int wave = F.wave, tid = fresh_tid(wave), lane = tid & 63, gw = F.c * NWAVES + wave; (void)lane; (void)gw
#define RCOL(j) (lane * 8 + 512 * ((j) >> 1) + 4 * ((j) & 1))
#define F_IN(i) (F.A->in[i])
#define F_WS (F.A->ws)
#define F_OUT (F.A->out)

template <class Src> __device__ __forceinline__ void wprep_job(const Frame& F, int& it0, int K, int N, bf16_t* dst, const Src& src) {
    PHASE_IDS;
    LAS float* scr = (LAS float*)(F.lds + wave * 16384);
    const int nblk = N / 32, nitems = (K / 64) * nblk;
    int first = it0 + (((gw - it0) % F.ngw) + F.ngw) % F.ngw;
    for (int it = first; it < it0 + nitems; it += F.ngw) {
        const int r = it - it0, kb = r / nblk, nb = r % nblk, k0 = 64 * kb, n0 = 32 * nb;
#pragma unroll 8
        for (int i = 0; i < 32; ++i) { const int kk = 2 * i + (lane >> 5); scr[kk * 33 + (lane & 31)] = src(k0 + kk, n0 + (lane & 31)); }
        LDS_WAIT(); asm volatile("" ::: "memory");
        const int cc = lane & 7;
#pragma unroll
        for (int j = 0; j < 4; ++j) { const int n = (lane >> 3) + 8 * j; const LAS float* s = scr + (8 * cc) * 33 + n;
            u32x4 o; o.x = cvtpk(s[0 * 33], s[1 * 33]); o.y = cvtpk(s[2 * 33], s[3 * 33]); o.z = cvtpk(s[4 * 33], s[5 * 33]); o.w = cvtpk(s[6 * 33], s[7 * 33]);
            *(u32x4*)(dst + (size_t)(n0 + n) * K + k0 + 8 * cc) = o; }
        LDS_WAIT(); asm volatile("" ::: "memory");
    }
    it0 += nitems;
}
template <class Src> __device__ __forceinline__ void wprep_fast(const Frame& F, int& it0, int K, int N, bf16_t* dst, const Src& src) {
    PHASE_IDS;
    LAS float* scr = (LAS float*)(F.lds + wave * 16384);
    const int nblk = N / 32, nitems = (K / 64) * nblk; const long ld = src.ld;
    int first = it0 + (((gw - it0) % F.ngw) + F.ngw) % F.ngw;
    for (int it = first; it < it0 + nitems; it += F.ngw) {
        const int r = it - it0, kb = r / nblk, nb = r % nblk, k0 = 64 * kb, n0 = 32 * nb;
        const float* p = src.at(n0 + (lane & 31)); float v[32];
        if (p) { p += (long)(k0 + (lane >> 5)) * ld;
#pragma unroll
            for (int i = 0; i < 32; ++i) v[i] = __builtin_nontemporal_load(p + (long)(2 * i) * ld); }
        else {
#pragma unroll
            for (int i = 0; i < 32; ++i) v[i] = 0.f; }
#pragma unroll
        for (int i = 0; i < 32; ++i) scr[(2 * i + (lane >> 5)) * 33 + (lane & 31)] = v[i];
        LDS_WAIT(); asm volatile("" ::: "memory");
        const int cc = lane & 7;
#pragma unroll
        for (int j = 0; j < 4; ++j) { const int n = (lane >> 3) + 8 * j; const LAS float* s = scr + (8 * cc) * 33 + n;
            u32x4 o; o.x = cvtpk(s[0 * 33], s[1 * 33]); o.y = cvtpk(s[2 * 33], s[3 * 33]); o.z = cvtpk(s[4 * 33], s[5 * 33]); o.w = cvtpk(s[6 * 33], s[7 * 33]);
            *(u32x4*)(dst + (size_t)(n0 + n) * K + k0 + 8 * cc) = o; }
        LDS_WAIT(); asm volatile("" ::: "memory");
    }
    it0 += nitems;
}
template <class Src> __device__ __forceinline__ void wprep_fast8(const Frame& F, int& it0, int K, int N, unsigned char* dst, const Src& src, float scale) {
    PHASE_IDS;
    LAS float* scr = (LAS float*)(F.lds + wave * 16384);
    const int nblk = N / 32, nitems = (K / 64) * nblk; const long ld = src.ld;
    int first = it0 + (((gw - it0) % F.ngw) + F.ngw) % F.ngw;
    for (int it = first; it < it0 + nitems; it += F.ngw) {
        const int r = it - it0, kb = r / nblk, nb = r % nblk, k0 = 64 * kb, n0 = 32 * nb;
        const float* p = src.at(n0 + (lane & 31)); float v[32];
        if (p) { p += (long)(k0 + (lane >> 5)) * ld;
#pragma unroll
            for (int i = 0; i < 32; ++i) v[i] = __builtin_nontemporal_load(p + (long)(2 * i) * ld); }
        else {
#pragma unroll
            for (int i = 0; i < 32; ++i) v[i] = 0.f; }
#pragma unroll
        for (int i = 0; i < 32; ++i) scr[(2 * i + (lane >> 5)) * 33 + (lane & 31)] = v[i] * scale;
        LDS_WAIT(); asm volatile("" ::: "memory");
        const int cc = lane & 7;
#pragma unroll
        for (int j = 0; j < 4; ++j) { const int n = (lane >> 3) + 8 * j; const LAS float* s = scr + (8 * cc) * 33 + n;
            const f32x4 a = {s[0 * 33], s[1 * 33], s[2 * 33], s[3 * 33]}, b = {s[4 * 33], s[5 * 33], s[6 * 33], s[7 * 33]};
            *(u32x2*)(dst + (size_t)(n0 + n) * K + k0 + 8 * cc) = pg8::pack8_fp8(a, b); }
        LDS_WAIT(); asm volatile("" ::: "memory");
    }
    it0 += nitems;
}
struct FastPlain { const float* W; int ld; __device__ __forceinline__ const float* at(int n) const { return W + n; } };
struct FastIn1 { const float* W; int ld;
    __device__ __forceinline__ const float* at(int n) const { int c; if (n < 1024) c = 1024 + n; else if (n < 2048) c = 2048 + (n - 1024); else if (n < 3072) c = n - 2048; else if (n < 3776) c = n; else return nullptr; return W + c; } };
struct FastW13 { const float* W1; long d31; int ld;
    __device__ __forceinline__ const float* at(int n) const { const int pn = n >> 8, bj = (n >> 7) & 1, jj = n & 127; return W1 + (long)bj * d31 + pn * 128 + jj; } };
struct SrcPlain { const float* W; int ld; __device__ __forceinline__ float operator()(int k, int n) const { return W[(size_t)k * ld + n]; } };
struct SrcPlainS { const float* W; int ld; float s; __device__ __forceinline__ float operator()(int k, int n) const { return W[(size_t)k * ld + n] * s; } };
struct SrcIn1 { const float* W;
    __device__ __forceinline__ float operator()(int k, int n) const {
        int c; if (n < 1024) c = 1024 + n; else if (n < 2048) c = 2048 + (n - 1024); else if (n < 3072) c = n - 2048; else if (n < 3776) c = n; else return 0.f;
        return W[(size_t)k * INCOLS + c]; } };
struct SrcGate { const float* Wa; long dxa; int nb;
    __device__ __forceinline__ float operator()(int k, int n) const { const int d = n >> 8, bj = (n >> 7) & 1, jj = n & 127;
        return Wa[(long)bj * dxa + (((long)d * 8 + nb) * 128 + k) * 128 + jj]; } };
struct SrcUQ { const float* W; const float* g;
    __device__ __forceinline__ float operator()(int k, int n) const { const int h = n / DQK, dd = n - h * DQK; int c = n;
        if (dd >= 128) { const int p = dd - 128, axis = p >> 5, f = (p & 31) >> 1, half = p & 1; c = h * DQK + 128 + axis * 32 + half * 16 + f; }
        return W[(size_t)k * 1536 + c] * g[k]; } };
struct SrcScaleK { const float* W; const float* g; int ld; __device__ __forceinline__ float operator()(int k, int n) const { return W[(size_t)k * ld + n] * g[k]; } };
struct SrcUKV { const float* W; const float* g;
    __device__ __forceinline__ float operator()(int k, int n) const { const int v = n >> 10, h = (n >> 7) & 7, j = n & 127; return W[(size_t)k * 2048 + h * 256 + v * 128 + j] * g[k]; } };
struct SrcW13 { const float* W1; long d31; int ld;
    __device__ __forceinline__ float operator()(int k, int n) const { const int pn = n >> 8, bj = (n >> 7) & 1, jj = n & 127; return W1[(long)bj * d31 + (long)k * ld + pn * 128 + jj]; } };
struct SrcPoolWS { const float* W; const float* sc;
    __device__ __forceinline__ float operator()(int k, int n) const { return W[(size_t)n * 256 + k] * sc[k]; } };

__device__ __forceinline__ void mod_partials(const Frame& F) {
    PHASE_IDS;
    const float* c = F_IN(I_C); const float* cc = F_IN(I_CCTX); const float* mw = F_IN(I_MODW); float* part = (float*)(F_WS + WS_MPART);
    for (int task = F.c; task < 2 * 12 * 32; task += F.G) {
        const int l = task / 384, r = task % 384, cb = r / 32, kc = r % 32, col = cb * 512 + tid;
        float a0 = 0, a1 = 0, a2 = 0, a3 = 0, a4 = 0;
#pragma unroll 8
        for (int kk = 0; kk < 32; ++kk) { const int k = kc * 32 + kk; const float w = mw[((size_t)l * 1024 + k) * 6144 + col];
            const float c0 = c[k], c1 = c[1024 + k], c2 = c[2048 + k], c3 = c[3072 + k], c4 = cc[k];
            a0 += c0 * sigmoidf_(c0) * w; a1 += c1 * sigmoidf_(c1) * w; a2 += c2 * sigmoidf_(c2) * w; a3 += c3 * sigmoidf_(c3) * w; a4 += c4 * sigmoidf_(c4) * w; }
        float* p = part + (((size_t)l * 32 + kc) * 5) * 6144 + col;
        p[0] = a0; p[6144] = a1; p[2 * 6144] = a2; p[3 * 6144] = a3; p[4 * 6144] = a4;
    }
}
__device__ __forceinline__ void mod_reduce(const Frame& F) {
    PHASE_IDS;
    const float* part = (const float*)(F_WS + WS_MPART); const float* mb = F_IN(I_MODB); float* mv = (float*)(F_WS + WS_MVEC);
    for (int i = F.c * NTHR + tid; i < 2 * 5 * 6144; i += F.G * NTHR) { const int l = i / 30720, r = (i % 30720) / 6144, col = i % 6144;
        float s = mb[l * 6144 + col];
        for (int kc = 0; kc < 32; ++kc) s += part[(((size_t)l * 32 + kc) * 5 + r) * 6144 + col];
        mv[i] = s; }
}
__device__ __forceinline__ void rope_and_consts(const Frame& F) {
    PHASE_IDS;
    f32x2* rope = (f32x2*)(F_WS + WS_ROPE);
    for (int i = F.c * NTHR + tid; i < 8193 * 32; i += F.G * NTHR) { const int pos = i >> 5, a = (i >> 4) & 1, f = i & 15;
        f32x2 v = {1.f, 0.f};
        if (pos < SEQ) { const float inv = __builtin_amdgcn_exp2f(-(float)f * (13.287712379549449f / 16.f));
            const float p = (float)(a == 0 ? (pos >> 6) : (pos & 63)); const float rev = (p * inv) * 0.15915494309189535f; const float fr = rev - rintf(rev);
            v.x = __builtin_amdgcn_cosf(fr); v.y = __builtin_amdgcn_sinf(fr); }
        rope[i] = v; }
    float* sp8 = (float*)(F_WS + WS_SP8); const float* lam = F_IN(I_LAMBDA);
    for (int i = F.c * NTHR + tid; i < 2 * 2 * 1024; i += F.G * NTHR) sp8[i] = -8.f * log1pf(expf(-lam[i]));
}

__device__ __forceinline__ void pool_weights_phase(const Frame& F) {
    PHASE_IDS;
    for (int tile = F.c; tile < 512; tile += F.G) {
        const int l = tile >> 8, g = (tile >> 6) & 3, n0 = ((tile >> 2) & 15) * 64, i0 = (tile & 3) * 64 + wave * 8;
        const float* PW = F_IN(I_POOLW) + (((size_t)l * 4 + g) * 256 + i0) * 256; const float* SC = F_IN(I_POOLSCALE) + l * 1024 + g * 256;
        const float* PP = F_IN(I_POOLPROJ) + ((size_t)l * 1024 + g * 256) * DM + n0 + lane;
        float acc[8] = {0.f, 0.f, 0.f, 0.f, 0.f, 0.f, 0.f, 0.f};
#pragma unroll 4
        for (int j = 0; j < 256; ++j) { const float p = PP[(size_t)j * DM] * SC[j];
#pragma unroll
            for (int ii = 0; ii < 8; ++ii) acc[ii] += PW[ii * 256 + j] * p; }
        u32x4 o; o.x = cvtpk(acc[0], acc[1]); o.y = cvtpk(acc[2], acc[3]); o.z = cvtpk(acc[4], acc[5]); o.w = cvtpk(acc[6], acc[7]);
        *(u32x4*)((bf16_t*)(F_WS + WS_WTS + (size_t)l * WTS_LSTRIDE + WO_POOL) + (size_t)(n0 + lane) * DM + g * 256 + i0) = o;
    }
}
__device__ __forceinline__ const float* mvec_row(const Frame& F, int l, int row) { return (const float*)(F_WS + WS_MVEC) + ((size_t)l * 5 + (row < MLAT ? (row >> 13) : 4)) * 6144; }
template <bool BF> __device__ __forceinline__ void ldx8(const void* base, size_t e, f32x4& a, f32x4& b) {
    if (BF) { const u32x4 w = *(const u32x4*)((const bf16_t*)base + e); a = (f32x4){bf_lo(w.x), bf_hi(w.x), bf_lo(w.y), bf_hi(w.y)}; b = (f32x4){bf_lo(w.z), bf_hi(w.z), bf_lo(w.w), bf_hi(w.w)}; }
    else { a = *(const f32x4*)((const float*)base + e); b = *(const f32x4*)((const float*)base + e + 4); }
}
template <bool BF> __device__ __forceinline__ void stx8(void* base, size_t e, const f32x4 a, const f32x4 b) {
    if (BF) { u32x4 w; w.x = cvtpk(a[0], a[1]); w.y = cvtpk(a[2], a[3]); w.z = cvtpk(b[0], b[1]); w.w = cvtpk(b[2], b[3]); *(u32x4*)((bf16_t*)base + e) = w; }
    else { *(f32x4*)((float*)base + e) = a; *(f32x4*)((float*)base + e + 4) = b; }
}
template <bool XBF> __device__ __forceinline__ void norm1_phase(const Frame& F, int l, const void* xlat, const float* xctx, bf16_t* H, unsigned char* H8, int nrows) {
    PHASE_IDS;
    const float* g = F_IN(I_PREMIXG) + l * DM;
    for (int row = gw; row < nrows; row += F.ngw) {
        const bool lat = row < MLAT; const float* mr = mvec_row(F, l, row);
        f32x4 v[4]; float ss = 0.f;
#pragma unroll
        for (int jp = 0; jp < 2; ++jp) { if (lat) ldx8<XBF>(xlat, (size_t)row * DM + lane * 8 + 512 * jp, v[2 * jp], v[2 * jp + 1]); else ldx8<false>(xctx, (size_t)(row - MLAT) * DM + lane * 8 + 512 * jp, v[2 * jp], v[2 * jp + 1]); }
#pragma unroll
        for (int j = 0; j < 4; ++j) ss += (v[j][0] * v[j][0] + v[j][1] * v[j][1]) + (v[j][2] * v[j][2] + v[j][3] * v[j][3]);
        const float rstd = rsqrtf(wave_sum(ss) * (1.f / DM) + RMS_EPS);
#pragma unroll
        for (int j = 0; j < 4; ++j) { const int col = RCOL(j); const f32x4 gg = *(const f32x4*)(g + col), sh = *(const f32x4*)(mr + col), sc = *(const f32x4*)(mr + DM + col);
            v[j] = v[j] * rstd * gg * (sc + 1.f) + sh; }
#pragma unroll
        for (int jp = 0; jp < 2; ++jp) { const f32x4 p = v[2 * jp], q = v[2 * jp + 1]; const size_t o = (size_t)row * DM + lane * 8 + 512 * jp;
            u32x4 w; w.x = cvtpk(p[0], p[1]); w.y = cvtpk(p[2], p[3]); w.z = cvtpk(q[0], q[1]); w.w = cvtpk(q[2], q[3]); *(u32x4*)(H + o) = w;
            *(u32x2*)(H8 + o) = pg8::pack8_fp8(p, q); }
    }
}
template <bool MOE, bool XIB, bool XOB> __device__ __forceinline__ void resid1_phase(const Frame& F, int l, const void* xlat, const float* xctx, void* olat, float* octx, const bf16_t* Y, bf16_t* H2, int nrows) {
    PHASE_IDS;
    const float* gpost = F_IN(I_POSTMIXG) + l * DM; const float* gpre = F_IN(I_PREFFNG) + l * DM;
    LAS float* rw = (LAS float*)F.lds;
    volatile LAS int* hist = (volatile LAS int*)(F.lds + 32768);
    if (MOE) { const float* rwg = F_IN(I_ROUTERW);
        for (int i = tid; i < 8192; i += NTHR) rw[(i & 7) * 1024 + (i >> 3)] = rwg[i];
        if (tid < 8) hist[tid] = 0;
        __syncthreads(); }
    for (int row = gw; row < nrows; row += F.ngw) {
        const bool lat = row < MLAT; const size_t ro = lat ? (size_t)row * DM : (size_t)(row - MLAT) * DM;
        const float* mr = mvec_row(F, l, row);
        f32x4 y[4], xv[4]; float ss = 0.f;
#pragma unroll
        for (int jp = 0; jp < 2; ++jp) { if (lat) ldx8<XIB>(xlat, ro + lane * 8 + 512 * jp, xv[2 * jp], xv[2 * jp + 1]); else ldx8<false>(xctx, ro + lane * 8 + 512 * jp, xv[2 * jp], xv[2 * jp + 1]); }
#pragma unroll
        for (int jp = 0; jp < 2; ++jp) { const u32x4 w = *(const u32x4*)(Y + (size_t)row * DM + lane * 8 + 512 * jp);
            y[2 * jp] = (f32x4){bf_lo(w.x), bf_hi(w.x), bf_lo(w.y), bf_hi(w.y)}; y[2 * jp + 1] = (f32x4){bf_lo(w.z), bf_hi(w.z), bf_lo(w.w), bf_hi(w.w)}; }
#pragma unroll
        for (int j = 0; j < 4; ++j) ss += (y[j][0] * y[j][0] + y[j][1] * y[j][1]) + (y[j][2] * y[j][2] + y[j][3] * y[j][3]);
        const float rs = rsqrtf(wave_sum(ss) * (1.f / DM) + RMS_EPS);
        f32x4 xn[4]; float s2 = 0.f;
#pragma unroll
        for (int j = 0; j < 4; ++j) { const int col = RCOL(j); const f32x4 gg = *(const f32x4*)(gpost + col), gate = *(const f32x4*)(mr + 2 * DM + col);
            xn[j] = xv[j] + gate * (y[j] * rs * gg);
            s2 += (xn[j][0] * xn[j][0] + xn[j][1] * xn[j][1]) + (xn[j][2] * xn[j][2] + xn[j][3] * xn[j][3]); }
#pragma unroll
        for (int jp = 0; jp < 2; ++jp) { if (lat) stx8<XOB>(olat, ro + lane * 8 + 512 * jp, xn[2 * jp], xn[2 * jp + 1]); else stx8<false>(octx, ro + lane * 8 + 512 * jp, xn[2 * jp], xn[2 * jp + 1]); }
        const float rs2 = rsqrtf(wave_sum(s2) * (1.f / DM) + RMS_EPS);
        f32x4 h2[4];
#pragma unroll
        for (int j = 0; j < 4; ++j) { const int col = RCOL(j); const f32x4 gg = *(const f32x4*)(gpre + col), sh = *(const f32x4*)(mr + 3 * DM + col), sc = *(const f32x4*)(mr + 4 * DM + col);
            h2[j] = xn[j] * rs2 * gg * (sc + 1.f) + sh; }
#pragma unroll
        for (int jp = 0; jp < 2; ++jp) { const f32x4 p = h2[2 * jp], q = h2[2 * jp + 1]; const size_t o = (size_t)row * DM + lane * 8 + 512 * jp;
            if (MOE) { *(u32x2*)((unsigned char*)H2 + o) = pg8::pack8_fp8(p, q); }
            else { u32x4 w; w.x = cvtpk(p[0], p[1]); w.y = cvtpk(p[2], p[3]); w.z = cvtpk(q[0], q[1]); w.w = cvtpk(q[2], q[3]); *(u32x4*)(H2 + o) = w; } }
        if (MOE) {
            float lg[8];
#pragma unroll
            for (int e = 0; e < 8; ++e) { float s = 0.f;
#pragma unroll
                for (int j = 0; j < 4; ++j) { const f32x4 w = *(const LAS f32x4*)(rw + e * 1024 + RCOL(j)); s += (h2[j][0] * w[0] + h2[j][1] * w[1]) + (h2[j][2] * w[2] + h2[j][3] * w[3]); }
                lg[e] = wave_sum(s); }
            int e1 = 0; float v1 = lg[0];
#pragma unroll
            for (int e = 1; e < 8; ++e) if (lg[e] > v1) { v1 = lg[e]; e1 = e; }
            int e2 = -1; float v2 = -3.0e38f;
#pragma unroll
            for (int e = 0; e < 8; ++e) if (e != e1 && lg[e] > v2) { v2 = lg[e]; e2 = e; }
            if (lane == 0) { ((int*)(F_WS + WS_E12))[row] = e1 | (e2 << 8); ((float*)(F_WS + WS_G1))[row] = 1.f / (1.f + expf(v2 - v1));
                atomicAdd((int*)&hist[e1], 1); atomicAdd((int*)&hist[e2], 1); }
        }
    }
    if (MOE) { __syncthreads(); if (tid < 8) atomicAdd((unsigned*)(F_WS + WS_CTL) + CW_CNT + 64 * tid, (unsigned)hist[tid]); }
}
template <bool MOE, bool XIB, bool XOB> __device__ __forceinline__ void resid2_phase(const Frame& F, int l, const void* xlat, const float* xctx, void* olat, float* octx, const bf16_t* Fb, int nrows) {
    PHASE_IDS;
    const float* gpost = F_IN(I_POSTFFNG) + l * DM;
    for (int row = gw; row < nrows; row += F.ngw) {
        const bool lat = row < MLAT; const size_t ro = lat ? (size_t)row * DM : (size_t)(row - MLAT) * DM;
        const float* mr = mvec_row(F, l, row);
        f32x4 f[4], xv[4]; float ss = 0.f;
#pragma unroll
        for (int jp = 0; jp < 2; ++jp) { if (lat) ldx8<XIB>(xlat, ro + lane * 8 + 512 * jp, xv[2 * jp], xv[2 * jp + 1]); else ldx8<false>(xctx, ro + lane * 8 + 512 * jp, xv[2 * jp], xv[2 * jp + 1]); }
        if (MOE) { const int d1 = ((const int*)(F_WS + WS_DEST))[2 * row], d2 = ((const int*)(F_WS + WS_DEST))[2 * row + 1]; const float g1 = ((const float*)(F_WS + WS_G1))[row], g2 = 1.f - g1;
#pragma unroll
            for (int jp = 0; jp < 2; ++jp) { const u32x4 a = *(const u32x4*)(Fb + (size_t)d1 * DM + lane * 8 + 512 * jp), b = *(const u32x4*)(Fb + (size_t)d2 * DM + lane * 8 + 512 * jp);
                f[2 * jp] = (f32x4){bf_lo(a.x), bf_hi(a.x), bf_lo(a.y), bf_hi(a.y)} * g1 + (f32x4){bf_lo(b.x), bf_hi(b.x), bf_lo(b.y), bf_hi(b.y)} * g2;
                f[2 * jp + 1] = (f32x4){bf_lo(a.z), bf_hi(a.z), bf_lo(a.w), bf_hi(a.w)} * g1 + (f32x4){bf_lo(b.z), bf_hi(b.z), bf_lo(b.w), bf_hi(b.w)} * g2; }
        } else {
#pragma unroll
            for (int jp = 0; jp < 2; ++jp) { const u32x4 a = *(const u32x4*)(Fb + (size_t)row * DM + lane * 8 + 512 * jp);
                f[2 * jp] = (f32x4){bf_lo(a.x), bf_hi(a.x), bf_lo(a.y), bf_hi(a.y)}; f[2 * jp + 1] = (f32x4){bf_lo(a.z), bf_hi(a.z), bf_lo(a.w), bf_hi(a.w)}; }
        }
#pragma unroll
        for (int j = 0; j < 4; ++j) ss += (f[j][0] * f[j][0] + f[j][1] * f[j][1]) + (f[j][2] * f[j][2] + f[j][3] * f[j][3]);
        const float rs = rsqrtf(wave_sum(ss) * (1.f / DM) + RMS_EPS);
#pragma unroll
        for (int j = 0; j < 4; ++j) { const int col = lane * 8 + 512 * (j >> 1) + 4 * (j & 1);
            const f32x4 gg = *(const f32x4*)(gpost + col), gate = *(const f32x4*)(mr + 5 * DM + col);
            xv[j] = xv[j] + gate * (f[j] * rs * gg); }
#pragma unroll
        for (int jp = 0; jp < 2; ++jp) { if (lat) stx8<XOB>(olat, ro + lane * 8 + 512 * jp, xv[2 * jp], xv[2 * jp + 1]); else stx8<false>(octx, ro + lane * 8 + 512 * jp, xv[2 * jp], xv[2 * jp + 1]); }
    }
}
__device__ __forceinline__ void conv_phase(const Frame& F, int l, const bf16_t* __restrict__ LX, bf16_t* __restrict__ U) {
    PHASE_IDS;
    const float* cw = F_IN(I_CONVW) + l * 4 * DM; const float* cb = F_IN(I_CONVB) + l * DM;
    const int gt = F.c * NTHR + tid, ch = (gt & 127) * 8, rstep = (F.G * NTHR) >> 7;
    f32x4 w0[4], w1[4];
#pragma unroll
    for (int k = 0; k < 4; ++k) { w0[k] = *(const f32x4*)(cw + k * DM + ch); w1[k] = *(const f32x4*)(cw + k * DM + ch + 4); }
    const f32x4 b0 = *(const f32x4*)(cb + ch), b1 = *(const f32x4*)(cb + ch + 4);
#pragma unroll 2
    for (int row = gt >> 7; row < MTOT; row += rstep) {
        int t, ls; if (row < MLAT) { t = row & (SEQ - 1); ls = SEQ; } else { t = (row - MLAT) & (CTXL - 1); ls = CTXL; }
        f32x4 a0 = b0, a1 = b1;
#pragma unroll
        for (int k = 0; k < 4; ++k) { const int tt = t + k - 2; if (tt >= 0 && tt < ls) { f32x4 x0, x1; pg8::unpack8(*(const u32x4*)(LX + (size_t)(row + k - 2) * DM + ch), x0, x1);
                a0 += x0 * w0[k]; a1 += x1 * w1[k]; } }
        *(u32x4*)(U + (size_t)row * DM + ch) = pg8::pack8(a0, a1);
    }
}
__device__ __forceinline__ void pool_phase(const Frame& F, const bf16_t* __restrict__ Z2, bf16_t* __restrict__ MP) {
    PHASE_IDS;
    for (int task = F.c * NTHR + tid; task < (MTOT / 33) * 128; task += F.G * NTHR) {
        const int c8 = task & 127, row0 = (task >> 7) * 33, ch = c8 * 8, hw = 1 << (c8 >> 5);
        f32x4 s0 = {0.f, 0.f, 0.f, 0.f}, s1 = {0.f, 0.f, 0.f, 0.f};
#pragma unroll 3
        for (int d = 0; d < 33; ++d) { const int row = row0 + d; int t, ls; if (row < MLAT) { t = row & (SEQ - 1); ls = SEQ; } else { t = (row - MLAT) & (CTXL - 1); ls = CTXL; }
            const bf16_t* z = Z2 + (size_t)row * Z2LD + ch;
            if (d == 0 || t == 0) { s0 = (f32x4){0.f, 0.f, 0.f, 0.f}; s1 = s0;
                for (int tt = max(t - hw, 0); tt < min(t + hw, ls); ++tt) { f32x4 x0, x1; pg8::unpack8(*(const u32x4*)(z + (long)(tt - t) * Z2LD), x0, x1); s0 += x0; s1 += x1; } }
            const int lo = max(t - hw, 0), hi = min(t + hw, ls);
            f32x4 u0, u1; pg8::unpack8(*(const u32x4*)z, u0, u1);
            const float inv = 1.f / (float)(hi - lo);
            *(u32x4*)(MP + (size_t)row * DM + ch) = pg8::pack8(s0 * inv - u0, s1 * inv - u1);
            if (t + hw < ls) { f32x4 x0, x1; pg8::unpack8(*(const u32x4*)(z + (long)hw * Z2LD), x0, x1); s0 += x0; s1 += x1; }
            if (t - hw >= 0) { f32x4 x0, x1; pg8::unpack8(*(const u32x4*)(z - (long)hw * Z2LD), x0, x1); s0 -= x0; s1 -= x1; } }
    }
}
__device__ __forceinline__ void mla_prep_phase(const Frame& F, const bf16_t* __restrict__ Z2, unsigned char* __restrict__ KR) {
    PHASE_IDS;
    float* rq = (float*)(F_WS + WS_RSTDQ); float* rkv = (float*)(F_WS + WS_RSTDKV); const f32x2* rope = (const f32x2*)(F_WS + WS_ROPE);
    const int i = lane & 15, g = lane >> 4;
    for (int r0 = gw * 4; r0 < MTOT; r0 += F.ngw * 4) { const int row = r0 + g;
        const bf16_t* zr = Z2 + (size_t)row * Z2LD + 1024 + 8 * i;
        float sq = 0.f, skv = 0.f; f32x4 k0 = {0.f, 0.f, 0.f, 0.f}, k1 = k0;
#pragma unroll
        for (int c = 0; c < 6; ++c) { if (c < 5 || i < 8) { f32x4 a0, a1; pg8::unpack8(*(const u32x4*)(zr + 128 * c), a0, a1);
                const float s = (a0[0] * a0[0] + a0[1] * a0[1]) + (a0[2] * a0[2] + a0[3] * a0[3]) + (a1[0] * a1[0] + a1[1] * a1[1]) + (a1[2] * a1[2] + a1[3] * a1[3]);
                if (c < 3) sq += s; else if (c < 5) skv += s; else { k0 = a0; k1 = a1; } } }
#pragma unroll
        for (int o = 1; o < 16; o <<= 1) { sq += __shfl_xor(sq, o); skv += __shfl_xor(skv, o); }
        if (i == 0) { rq[row] = rsqrtf(sq * (1.f / QLORA) + RMS_EPS); rkv[row] = rsqrtf(skv * (1.f / KVLORA) + RMS_EPS); }
        float xo[8], xp[8];
#pragma unroll
        for (int j = 0; j < 4; ++j) { xo[j] = k0[j]; xo[4 + j] = k1[j]; }
#pragma unroll
        for (int j = 0; j < 8; ++j) xp[j] = __shfl_xor(xo[j], 2);
        int b, s, pos; if (row < MLAT) { b = row >> 13; s = row & (SEQ - 1); pos = s; } else { const int rc = row - MLAT; b = rc >> 8; s = SEQ + (rc & (CTXL - 1)); pos = SEQ; }
        const int axis = (i >> 2) & 1, half = (i >> 1) & 1, f0 = 8 * (i & 1);
        float res[8];
#pragma unroll
        for (int j = 0; j < 8; ++j) { const f32x2 cs = rope[(size_t)pos * 32 + axis * 16 + f0 + j];
            const float x1 = half ? xp[j] : xo[j], x2 = half ? xo[j] : xp[j];
            res[j] = half ? (x2 * cs.x + x1 * cs.y) : (x1 * cs.x - x2 * cs.y); }
        float rp[8];
#pragma unroll
        for (int j = 0; j < 8; ++j) rp[j] = __shfl_xor(res[j], 2);
        if (i < 8 && half == 0) {
            int w[4];
#pragma unroll
            for (int q = 0; q < 4; ++q) { int v = 0; v = __builtin_amdgcn_cvt_pk_fp8_f32(res[2 * q], rp[2 * q], v, false); v = __builtin_amdgcn_cvt_pk_fp8_f32(res[2 * q + 1], rp[2 * q + 1], v, true); w[q] = v; }
            *(u32x4*)(KR + ((size_t)b * SKV + s) * 64 + axis * 32 + 2 * f0) = (u32x4){(unsigned)w[0], (unsigned)w[1], (unsigned)w[2], (unsigned)w[3]}; }
    }
}
__device__ __forceinline__ int scan_row(int b, int dir, int tau) {
    if (dir == 0) return tau < CTXL ? MLAT + b * CTXL + tau : b * SEQ + (tau - CTXL);
    return tau < CTXL ? MLAT + b * CTXL + (CTXL - 1 - tau) : b * SEQ + (SEQ - 1 - (tau - CTXL));
}
__device__ __forceinline__ void scan_coef(unsigned la, unsigned gx, f32x2& a, f32x2& bb) {
    a.x = __builtin_amdgcn_exp2f(1.4426950408889634f * bf_lo(la)); a.y = __builtin_amdgcn_exp2f(1.4426950408889634f * bf_hi(la));
    bb.x = __builtin_amdgcn_sqrtf(fmaxf(1.f - a.x * a.x, 0.f)) * bf_lo(gx); bb.y = __builtin_amdgcn_sqrtf(fmaxf(1.f - a.y * a.y, 0.f)) * bf_hi(gx);
}
__device__ __forceinline__ float gelu_tanh_(float g) {
    const float u = 0.7978845608028654f * (g + 0.044715f * g * g * g); return g * __builtin_amdgcn_rcpf(1.f + __builtin_amdgcn_exp2f(-2.8853900817779268f * u));
}
__device__ __forceinline__ void scan_coef8(const u32x4 om, const u32x4 bb, f32x4& a0, f32x4& a1, f32x4& b0, f32x4& b1) {
    f32x4 o0, o1; pg8::unpack8(om, o0, o1); pg8::unpack8(bb, b0, b1); a0 = 1.f - o0; a1 = 1.f - o1;
}
__device__ __forceinline__ void scan_a_phase(const Frame& F, int dir, const bf16_t* __restrict__ LA, const bf16_t* __restrict__ GX) {
    PHASE_IDS;
    float* SA = (float*)(F_WS + WS_SUMA); float* SB = (float*)(F_WS + WS_SUMB);
    for (int task = wave * F.G + F.c; task < NB * NCHUNK * 2; task += F.ngw) {
        const int cb = task & 1, j = (task >> 1) % NCHUNK, b = (task >> 1) / NCHUNK, ch = cb * 512 + 8 * lane;
        f32x4 A0 = {1.f, 1.f, 1.f, 1.f}, A1 = A0, B0 = {0.f, 0.f, 0.f, 0.f}, B1 = B0;
        long off = (long)scan_row(b, dir, j * 64) * DM + ch; const long STP = dir == 0 ? (long)DM : -(long)DM;
        u32x4 laA[8], gxA[8], laB[8], gxB[8];
#define SA_LOAD(la, gx, o0) do { _Pragma("unroll") for (int k = 0; k < 8; ++k) { la[k] = *(const u32x4*)(LA + (o0) + k * STP); gx[k] = *(const u32x4*)(GX + (o0) + k * STP); } } while (0)
#define SA_STEP(la, gx) do { _Pragma("unroll") for (int k = 0; k < 8; ++k) { f32x4 a0, a1, b0, b1; scan_coef8(la[k], gx[k], a0, a1, b0, b1); B0 = a0 * B0 + b0; B1 = a1 * B1 + b1; A0 = A0 * a0; A1 = A1 * a1; } } while (0)
        SA_LOAD(laA, gxA, off);
#pragma unroll 1
        for (int s0 = 0; s0 < 64; s0 += 16) {
            SA_LOAD(laB, gxB, off + 8 * STP);
            SA_STEP(laA, gxA);
            if (s0 + 16 < 64) SA_LOAD(laA, gxA, off + 16 * STP);
            SA_STEP(laB, gxB);
            off += 16 * STP;
        }
#undef SA_LOAD
#undef SA_STEP
        float* pa = SA + ((size_t)b * NCHUNK + j) * DM + ch; float* pb = SB + ((size_t)b * NCHUNK + j) * DM + ch;
        *(f32x4*)pa = A0; *(f32x4*)(pa + 4) = A1; *(f32x4*)pb = B0; *(f32x4*)(pb + 4) = B1;
    }
}
template <int DIR> __device__ __forceinline__ void scan_b_phase(const Frame& F, const bf16_t* __restrict__ LA, const bf16_t* __restrict__ GX, bf16_t* HF, const bf16_t* __restrict__ LG) {
    PHASE_IDS;
    const float* SA = (const float*)(F_WS + WS_SUMA); const float* SB = (const float*)(F_WS + WS_SUMB);
    for (int task = wave * F.G + F.c; task < NB * NCHUNK * 2; task += F.ngw) {
        const int cb = task & 1, j = (task >> 1) % NCHUNK, b = (task >> 1) / NCHUNK, ch = cb * 512 + 8 * lane;
        f32x4 h0 = {0.f, 0.f, 0.f, 0.f}, h1 = h0;
#pragma unroll 8
        for (int jj = 0; jj < j; ++jj) { const float* pa = SA + ((size_t)b * NCHUNK + jj) * DM + ch; const float* pb = SB + ((size_t)b * NCHUNK + jj) * DM + ch;
            h0 = *(const f32x4*)pa * h0 + *(const f32x4*)pb; h1 = *(const f32x4*)(pa + 4) * h1 + *(const f32x4*)(pb + 4); }
        long off = (long)scan_row(b, DIR, j * 64) * DM + ch; constexpr long STP = DIR == 0 ? (long)DM : -(long)DM;
        u32x4 laA[4], gxA[4], hfA[4], lgA[4], laB[4], gxB[4], hfB[4], lgB[4];
#define SB_LOAD(la, gx, hf, lg, o0) do { _Pragma("unroll") for (int k = 0; k < 4; ++k) { const long o = (o0) + k * STP; la[k] = *(const u32x4*)(LA + o); gx[k] = *(const u32x4*)(GX + o); \
            if (DIR == 1) { hf[k] = *(const u32x4*)(HF + o); lg[k] = *(const u32x4*)(LG + o); } } } while (0)
#define SB_STEP(la, gx, hf, lg, o0) do { _Pragma("unroll") for (int k = 0; k < 4; ++k) { f32x4 a0, a1, b0, b1; scan_coef8(la[k], gx[k], a0, a1, b0, b1); \
            h0 = a0 * h0 + b0; h1 = a1 * h1 + b1; \
            if (DIR == 0) hf[k] = pg8::pack8(h0, h1); \
            else { f32x4 f0, f1, g0, g1; pg8::unpack8(hf[k], f0, f1); pg8::unpack8(lg[k], g0, g1); \
                f0 = (f0 + h0) * g0; f1 = (f1 + h1) * g1; \
                hf[k] = pg8::pack8(f0, f1); } } \
        _Pragma("unroll") for (int k = 0; k < 4; ++k) *(u32x4*)(HF + (o0) + k * STP) = hf[k]; } while (0)
        SB_LOAD(laA, gxA, hfA, lgA, off);
#pragma unroll 1
        for (int s0 = 0; s0 < 64; s0 += 8) {
            SB_LOAD(laB, gxB, hfB, lgB, off + 4 * STP);
            SB_STEP(laA, gxA, hfA, lgA, off);
            if (s0 + 8 < 64) SB_LOAD(laA, gxA, hfA, lgA, off + 8 * STP);
            SB_STEP(laB, gxB, hfB, lgB, off + 4 * STP);
            off += 8 * STP;
        }
#undef SB_LOAD
#undef SB_STEP
    }
}
__device__ __forceinline__ void moe_tile_table(const Frame& F, volatile LAS int* tend) {
    PHASE_IDS;
    if (tid == 0) { const unsigned* cnt = (const unsigned*)(F_WS + WS_CTL) + CW_CNT; int acc = 0;
        for (int e = 0; e < 8; ++e) { acc += ((int)__hip_atomic_load(cnt + 64 * e, __ATOMIC_RELAXED, __HIP_MEMORY_SCOPE_AGENT) + 255) >> 8; tend[e] = acc; } }
    __syncthreads();
}
__device__ __forceinline__ void moe_gather_phase(const Frame& F, const unsigned char* __restrict__ H2, unsigned char* __restrict__ XG) {
    PHASE_IDS;
    volatile LAS int* tend = (volatile LAS int*)(F.lds + MISC_OFF + 64);
    volatile LAS int* hist = (volatile LAS int*)(F.lds + 0); volatile LAS int* lbase = (volatile LAS int*)(F.lds + 64); volatile LAS int* dl = (volatile LAS int*)(F.lds + 128);
    moe_tile_table(F, tend);
    const int* e12 = (const int*)(F_WS + WS_E12); int* dest = (int*)(F_WS + WS_DEST); unsigned* cur = (unsigned*)(F_WS + WS_CTL) + CW_CUR;
    for (int blk = F.c; blk < MLAT / 128; blk += F.G) {
        if (tid < 8) hist[tid] = 0;
        __syncthreads();
        int e1 = 0, e2 = 0, r1 = 0, r2 = 0; const int tok = blk * 128 + tid;
        if (tid < 128) { const int w = e12[tok]; e1 = w & 255; e2 = (w >> 8) & 255; r1 = atomicAdd((int*)&hist[e1], 1); r2 = atomicAdd((int*)&hist[e2], 1); }
        __syncthreads();
        if (tid < 8) { const int base = (int)atomicAdd(cur + 64 * tid, (unsigned)hist[tid]); lbase[tid] = (tid == 0 ? 0 : tend[tid - 1]) * 256 + base; }
        __syncthreads();
        if (tid < 128) { const int d1 = lbase[e1] + r1, d2 = lbase[e2] + r2; dest[2 * tok] = d1; dest[2 * tok + 1] = d2; dl[2 * tid] = d1; dl[2 * tid + 1] = d2; }
        __syncthreads();
        for (int a = wave; a < 256; a += NWAVES) { const int d = dl[a]; const unsigned char* src = H2 + (size_t)(blk * 128 + (a >> 1)) * DM; unsigned char* dst = XG + (size_t)d * DM;
            *(u32x4*)(dst + 16 * lane) = *(const u32x4*)(src + 16 * lane); }
        __syncthreads();
    }
}

constexpr int PH_PRO0 = 0, PH_PRO1 = 1, PH_L0 = 2;
constexpr int LP_NORM = 0, LP_IN1 = 1, LP_CONV = 2, LP_GATE0 = 3, LP_SCANA0 = 4, LP_SCANB0 = 5, LP_GATE1 = 6, LP_SCANA1 = 7, LP_SCANB1 = 8, LP_MID = 9, LP_ATTN = 10,
              LP_GT = 11, LP_OUT1 = 12, LP_OUT2 = 13, LP_RES1 = 14, LP_F0 = 15;
constexpr int L0_NPH = 18;
constexpr int PH_L1 = PH_L0 + L0_NPH;
constexpr int L1_NPH = 15 + 1 + 10 + 1;
constexpr int NPHASES = PH_L1 + L1_NPH;

#ifdef PH_ONLY
#define IN(k) ((k) == PH_ONLY && in_range(A0, (k)))
#else
#define IN(k) in_range(A0, (k))
#endif
#define FRAME const Frame F = make_frame(A0, wave0)
__device__ __forceinline__ void grid_bar(ArgsP A0, int wave0) {
    extern __shared__ __attribute__((aligned(16))) unsigned char lds_raw[];
    XcdBarrier b; b.bar = bar_words(launder(A0)->ws); b.x = xb_xcc_id(); b.st = (volatile LAS unsigned*)((LAS unsigned char*)lds_raw + MISC_OFF); b.wave = wave0;
    xcd_barrier(b);
}
#define SEAM(k) do { if (!MK_PER_PHASE && IN((k) + 1)) { grid_bar(A0, wave0); } } while (0)
#define DYNP(off) ((bf16_t*)(F_WS + WS_DYN + (off)))

template <int L> __device__ __forceinline__ void layer_phases(ArgsP A0, const int wave0) {
    constexpr int P = L == 0 ? PH_L0 : PH_L1;
    constexpr size_t WL = WS_WTS + L * WTS_LSTRIDE;
    constexpr int nrows = L == 0 ? MTOT : MLAT, nmt = nrows / 256;
#define X1 ((bf16_t*)F_OUT)
#define X2 ((bf16_t*)F_OUT + (size_t)MLAT * DM)
#define X3 DYNP(D_HF)
#define XCTX (L == 0 ? F_IN(I_CTX) : (const float*)(F_WS + WS_XC))
#define XCOUT ((float*)(F_WS + WS_XC))

    if (IN(P + LP_NORM)) { FRAME;
        if constexpr (L == 0) norm1_phase<false>(F, L, F_IN(I_X), XCTX, DYNP(D_H), (unsigned char*)DYNP(D_H8), MTOT);
        else norm1_phase<true>(F, L, X2, XCTX, DYNP(D_H), (unsigned char*)DYNP(D_H8), MTOT);
        SEAM(P + LP_NORM); }
    if (IN(P + LP_IN1)) { FRAME;
        pg8::GridSched S{(const char*)DYNP(D_H), (const char*)(F_WS + WL + WO_IN1), MTOT / 256, 15, 16, DM, DM, F.G, F.c, 0, 0};
        pg8::EpiIn1 E{DYNP(D_LX), DYNP(D_LG), DYNP(D_Z2)};
        pg8::gemm_phase(F.lds, F.wave, DM, DM, S, E);
        SEAM(P + LP_IN1);
    }
    if (IN(P + LP_CONV)) { FRAME; conv_phase(F, L, DYNP(D_LX), DYNP(D_U)); mla_prep_phase(F, DYNP(D_Z2), (unsigned char*)(F_WS + WS_KR)); SEAM(P + LP_CONV); }
#pragma unroll
    for (int d = 0; d < 2; ++d) {
        const int pg = P + (d == 0 ? LP_GATE0 : LP_GATE1);
        if (IN(pg)) { FRAME;
            pg8::GateSched S{(const char*)DYNP(D_U), (const char*)(F_WS + WL + WO_GATE), MTOT / 256, F.G, F.c, d};
            pg8::EpiGates E{DYNP(D_LA), DYNP(D_GX), DYNP(D_U), F_IN(I_GAB) + (L * 2 + d) * 1024, F_IN(I_GXB) + (L * 2 + d) * 1024, (const float*)(F_WS + WS_SP8) + (L * 2 + d) * 1024};
            pg8::gemm_phase(F.lds, F.wave, DM, 128, S, E);
            SEAM(pg);
        }
        if (IN(pg + 1)) { FRAME; scan_a_phase(F, d, DYNP(D_LA), DYNP(D_GX)); SEAM(pg + 1); }
        if (IN(pg + 2)) { FRAME; if (d == 0) scan_b_phase<0>(F, DYNP(D_LA), DYNP(D_GX), DYNP(D_HF), DYNP(D_LG)); else scan_b_phase<1>(F, DYNP(D_LA), DYNP(D_GX), DYNP(D_HF), DYNP(D_LG)); SEAM(pg + 2); }
    }
    if (IN(P + LP_MID)) { FRAME;
        pool_phase(F, DYNP(D_Z2), DYNP(D_MP));
        { pg8::GridSched S{(const char*)(DYNP(D_Z2) + 1024), (const char*)(F_WS + WL + WO_UQ), nmt, 6, 6, Z2LD, QLORA, F.G, F.c, 0, 0};
          pg8::EpiQ E{(unsigned char*)DYNP(D_Q), (unsigned char*)(F_WS + WS_QC), (const float*)(F_WS + WS_RSTDQ), (const f32x2*)(F_WS + WS_ROPE)};
          pg8::gemm_phase(F.lds, F.wave, Z2LD, QLORA, S, E); }
        { pg8::GridSched S{(const char*)(DYNP(D_Z2) + 1024 + QLORA), (const char*)(F_WS + WL + WO_UKV), MTOT / 256, 4, 4, Z2LD, KVLORA, F.G, (F.c + 128) % F.G, 0, 0};
          pg8::EpiK E{(unsigned char*)DYNP(D_K), (const float*)(F_WS + WS_RSTDKV)};
          pg8::gemm_phase(F.lds, F.wave, Z2LD, KVLORA, S, E); }
        { pg8::GridSched S{(const char*)(F_WS + WL + WO_UKV + 1024 * KVLORA * 2), (const char*)(DYNP(D_Z2) + 1024 + QLORA), 4, MTOT / 256, 4, KVLORA, Z2LD, F.G, (F.c + 64) % F.G, 0, 0};
          pg8::EpiVT E{(unsigned char*)DYNP(D_V), (const float*)(F_WS + WS_RSTDKV)};
          pg8::gemm_phase(F.lds, F.wave, KVLORA, Z2LD, S, E); }
        SEAM(P + LP_MID);
    }
    if (IN(P + LP_ATTN)) { FRAME;
        const char* Qb = (const char*)DYNP(D_Q); const char* Kb = (const char*)DYNP(D_K); const char* Vb = (const char*)DYNP(D_V); char* AO = (char*)DYNP(D_AO); const char* QC = (const char*)((bf16_t*)(F_WS + WS_QC));
#pragma unroll 1
        for (int t = F.c; t < 1024 + (L == 0 ? 32 : 0); t += F.G) {
            const bool lat = t < 1024; const int cc = t & 255, bh = lat ? (t >> 8) * 8 + (cc & 7) : t - 1024, qb = cc >> 3, b = bh >> 3, h = bh & 7;
            const char* q = lat ? Qb + ((size_t)bh * SEQ + qb * 256) * DQK : QC + (size_t)bh * CTXL * DQK;
            const size_t k0 = (size_t)bh * SKV + (lat ? 0 : SEQ), kr0 = (size_t)b * SKV + (lat ? 0 : SEQ);
            char* o = AO + ((size_t)(lat ? b * SEQ + qb * 256 : MLAT + b * CTXL) * DM + h * DVH) * 2;
            att::attn_unit(q, Kb + k0 * 128, (const char*)(F_WS + WS_KR) + kr0 * 64, Vb + k0 * 128, o, lat ? SKV : CTXL, F.lds, F.wave);
        }
        __syncthreads();
        SEAM(P + LP_ATTN);
    }
    if (IN(P + LP_GT)) { FRAME;
        pg8::GridSched S{(const char*)DYNP(D_H8), (const char*)(F_WS + WL + WO_GT), nmt, 12, 8, DM / 2, DM / 2, F.G, F.c, 0, 0};
        pg8::EpiStore<1> E{DYNP(D_GT), 3072, 0, 1.f / 32.f};
        pg8::gemm_phase<pg8::EpiStore<1>, pg8::GridSched, true>(F.lds, F.wave, DM / 2, DM / 2, S, E);
        SEAM(P + LP_GT);
    }
    if (IN(P + LP_OUT1)) { FRAME;
        pg8::FatSched S{(const char*)(F_WS + WS_DYN), (const char*)(F_WS + WL), nmt, F.G, F.c};
        pg8::EpiOut1 E{DYNP(D_GT), DYNP(D_MG)};
        pg8::gemm_phase(F.lds, F.wave, DM, DM, S, E);
        SEAM(P + LP_OUT1);
    }
    if (IN(P + LP_OUT2)) { FRAME;
        pg8::GridSched S{(const char*)DYNP(D_MG), (const char*)(F_WS + WL + WO_OUT), nmt, 4, 16, DM, DM, F.G, F.c, 0, 0};
        pg8::EpiStore<0> E{DYNP(D_Y), DM, 0};
        pg8::gemm_phase(F.lds, F.wave, DM, DM, S, E);
        SEAM(P + LP_OUT2);
    }
    if constexpr (L == 0) {
        if (IN(P + LP_RES1)) { FRAME; resid1_phase<false, false, true>(F, L, F_IN(I_X), XCTX, X1, XCOUT, DYNP(D_Y), DYNP(D_H2), nrows); SEAM(P + LP_RES1); }
        if (IN(P + LP_F0)) { FRAME;
            pg8::GridSched S{(const char*)DYNP(D_H2), (const char*)(F_WS + WS_W13), nmt, 22, 16, DM, DM, F.G, F.c, 0, 0};
            pg8::EpiSwiglu8 E{(unsigned char*)DYNP(D_HID), DFF, 1.f};
            pg8::gemm_phase(F.lds, F.wave, DM, DM, S, E);
            SEAM(P + LP_F0);
        }
        if (IN(P + LP_F0 + 1)) { FRAME;
            pg8::GridSched S{(const char*)DYNP(D_HID), (const char*)(F_WS + WS_W2), nmt, 4, 22, DFF / 2, DFF / 2, F.G, F.c, 0, 0};
            pg8::EpiStoreS E{DYNP(D_F), DM, 0, 1.f / 64.f};
            pg8::gemm_phase<pg8::EpiStoreS, pg8::GridSched, true>(F.lds, F.wave, DFF / 2, DFF / 2, S, E);
            SEAM(P + LP_F0 + 1);
        }
        if (IN(P + LP_F0 + 2)) { FRAME; resid2_phase<false, true, true>(F, L, X1, XCOUT, X2, XCOUT, DYNP(D_F), nrows); SEAM(P + LP_F0 + 2); }
    } else {
        if (IN(P + LP_RES1)) { FRAME;
            resid1_phase<true, true, true>(F, L, X2, XCTX, X3, XCOUT, DYNP(D_Y), DYNP(D_H2), nrows);
            __syncthreads();
            int it0 = 0;
#pragma unroll 1
            for (int e = 0; e < NEXP; ++e) {
                wprep_fast8(F, it0, 1024, 7168, (unsigned char*)DYNP(D_WM13) + (size_t)e * 7168 * 1024, FastW13{F_IN(I_MOEW1) + (size_t)e * DM * EFF, (long)(F_IN(I_MOEW3) - F_IN(I_MOEW1)), EFF}, 32.f);
                wprep_fast8(F, it0, 3584, 1024, (unsigned char*)DYNP(D_WM2) + (size_t)e * 1024 * 3584, FastPlain{F_IN(I_MOEW2) + (size_t)e * EFF * DM, DM}, 64.f);
            }
            SEAM(P + LP_RES1);
        }
        if (IN(P + LP_F0)) { FRAME; moe_gather_phase(F, (const unsigned char*)DYNP(D_H2), (unsigned char*)DYNP(D_XG)); SEAM(P + LP_F0); }
        volatile LAS int* tend; { FRAME; tend = (volatile LAS int*)(F.lds + MISC_OFF + 64); }
#pragma unroll 1
        for (int g = 0; g < 5; ++g) {
            const int p13 = P + LP_F0 + 1 + 2 * g;
            if (!(IN(p13) || IN(p13 + 1))) continue;
            { FRAME; moe_tile_table(F, tend); }
#define TE(j) __builtin_amdgcn_readfirstlane(tend[j])
            const int ntiles = TE(7), t0 = g * 64, nM = min(64, ntiles - t0);
            if (IN(p13)) { FRAME;
                if (nM > 0) { pg8::MoeSched S{(const char*)DYNP(D_XG), (const char*)DYNP(D_WM13), {TE(0), TE(1), TE(2), TE(3), TE(4), TE(5), TE(6)}, (size_t)7168 * 1024, nM, 28, 8, DM / 2, DM / 2, F.G, F.c, t0, t0};
                    pg8::EpiSwiglu8 E{(unsigned char*)DYNP(D_HIDG), EFF};
                    pg8::gemm_phase<pg8::EpiSwiglu8, pg8::MoeSched, true>(F.lds, F.wave, DM / 2, DM / 2, S, E); }
                SEAM(p13);
            }
            if (IN(p13 + 1)) { FRAME;
                if (nM > 0) { pg8::MoeSched S{(const char*)DYNP(D_HIDG), (const char*)DYNP(D_WM2), {TE(0), TE(1), TE(2), TE(3), TE(4), TE(5), TE(6)}, (size_t)1024 * 3584, nM, 4, 28, EFF / 2, EFF / 2, F.G, F.c, t0, 0};
                    pg8::EpiStoreS E{DYNP(D_YR), DM, t0 * 256, 1.f / 64.f};
                    pg8::gemm_phase<pg8::EpiStoreS, pg8::MoeSched, true>(F.lds, F.wave, EFF / 2, EFF / 2, S, E); }
                SEAM(p13 + 1);
            }
        }
        if (IN(P + LP_F0 + 11)) { FRAME; resid2_phase<true, true, false>(F, L, X3, XCOUT, F_OUT, XCOUT, DYNP(D_YR), nrows); }
    }
#undef X1
#undef X2
#undef X3
#undef XCTX
#undef XCOUT
}

__global__ void __launch_bounds__(NTHR, 2) mega_fwd(Args args) {
    ArgsP A0 = (ArgsP)__builtin_amdgcn_kernarg_segment_ptr();
    (void)args;
    const int wave0 = __builtin_amdgcn_readfirstlane((int)threadIdx.x >> 6);
    { FRAME;
      volatile LAS unsigned* MISC = (volatile LAS unsigned*)(F.lds + MISC_OFF);
      const int tid0 = fresh_tid(F.wave); for (int u = tid0; u < (LDS_BYTES - MISC_OFF) / 4; u += NTHR) MISC[u] = 0u;
      __syncthreads();
      if (!MK_PER_PHASE) (void)xcd_barrier_post(bar_words(F_WS), MISC, F.wave);
    }

    if (IN(PH_PRO0)) { FRAME;
        mod_partials(F);
        rope_and_consts(F);
        int it0 = 0;
#pragma unroll 1
        for (int l = 0; l < 2; ++l) {
            unsigned char* wl = F_WS + WS_WTS + l * WTS_LSTRIDE;
            wprep_fast(F, it0, 1024, 3840, (bf16_t*)(wl + WO_IN1), FastIn1{F_IN(I_WIN) + (size_t)l * DM * INCOLS, INCOLS});
            wprep_fast8(F, it0, 1024, 3072, (unsigned char*)(wl + WO_GT), FastPlain{F_IN(I_WIN) + (size_t)l * DM * INCOLS + 3776, INCOLS}, 32.f);
#pragma unroll 1
            for (int nb = 0; nb < 8; ++nb)
                wprep_job(F, it0, 128, 512, (bf16_t*)(wl + WO_GATE) + (size_t)nb * 512 * 128, SrcGate{F_IN(I_GAW) + (size_t)l * 2 * 8 * 128 * 128, (long)(F_IN(I_GXW) - F_IN(I_GAW)), nb});
            wprep_job(F, it0, 1024, 1024, (bf16_t*)(wl + WO_LRU), SrcPlainS{F_IN(I_LRUPROJ) + (size_t)l * DM * DM, DM, ((ABL & 2) && ((ABL_L >> l) & 1)) ? 0.f : 1.f});
            wprep_job(F, it0, 384, 1536, (bf16_t*)(wl + WO_UQ), SrcUQ{F_IN(I_WUQ) + (size_t)l * 384 * 1536, F_IN(I_QNORMG) + l * 384});
            wprep_job(F, it0, 256, 2048, (bf16_t*)(wl + WO_UKV), SrcUKV{F_IN(I_WUKV) + (size_t)l * 256 * 2048, F_IN(I_KVNORMG) + l * 256});
            wprep_job(F, it0, 1024, 1024, (bf16_t*)(wl + WO_MLA), SrcPlainS{F_IN(I_MLAPROJ) + (size_t)l * DM * DM, DM, ((ABL & 4) && ((ABL_L >> l) & 1)) ? 0.f : 1.f});
            wprep_fast(F, it0, 1024, 1024, (bf16_t*)(wl + WO_OUT), FastPlain{F_IN(I_WOUT) + (size_t)l * DM * DM, DM});
        }
        wprep_fast(F, it0, 1024, 5632, (bf16_t*)(F_WS + WS_W13), FastW13{F_IN(I_FFNW1), (long)(F_IN(I_FFNW3) - F_IN(I_FFNW1)), DFF});
        wprep_fast8(F, it0, 2816, 1024, (unsigned char*)(F_WS + WS_W2), FastPlain{F_IN(I_FFNW2), DM}, 64.f);
        SEAM(PH_PRO0);
    }
    if (IN(PH_PRO1)) { FRAME;
        mod_reduce(F);
        pool_weights_phase(F);
        SEAM(PH_PRO1);
    }
    layer_phases<0>(A0, wave0);
    layer_phases<1>(A0, wave0);
}
#undef IN
#undef SEAM

extern "C" void kernel_launch(void* const* d_in, const int* in_sizes, int n_in, void* d_out, int out_size, void* d_ws, size_t ws_size, hipStream_t stream) {
    static int grid = 0;
    if (grid == 0) {
        if (n_in != 35 || out_size != MLAT * DM || ws_size < WS_END) { fprintf(stderr, "kernel_launch: unexpected shapes (n_in %d, out %d, ws %zu < %zu)\n", n_in, out_size, ws_size, (size_t)WS_END); grid = -1; return; }
        int dev = 0, cus = 0;
        if (hipGetDevice(&dev) != hipSuccess || hipDeviceGetAttribute(&cus, hipDeviceAttributeMultiprocessorCount, dev) != hipSuccess) { grid = -1; return; }
        if (hipFuncSetAttribute((const void*)mega_fwd, hipFuncAttributeMaxDynamicSharedMemorySize, LDS_BYTES) != hipSuccess) { fprintf(stderr, "kernel_launch: hipFuncSetAttribute failed\n"); grid = -1; return; }
        int per_cu = 0;
        if (hipOccupancyMaxActiveBlocksPerMultiprocessor(&per_cu, (const void*)mega_fwd, NTHR, LDS_BYTES) != hipSuccess || per_cu < 1) { fprintf(stderr, "kernel_launch: occupancy query says %d\n", per_cu); }
        (void)hipGetLastError();
        grid = cus;
    }
    if (grid < 0) return;
    (void)hipMemsetAsync((char*)d_ws + WS_CTL, 0, CTL_BYTES, stream);
    Args a{};
    for (int i = 0; i < 35; ++i) a.in[i] = (const float*)d_in[i];
    a.out = (float*)d_out; a.ws = (unsigned char*)d_ws;
#if MK_PER_PHASE
    for (int p = 0; p < NPHASES; ++p) { a.ph_lo = p; a.ph_hi = p + 1; hipLaunchKernelGGL(mega_fwd, dim3(grid), dim3(NTHR), LDS_BYTES, stream, a); }
#else
    a.ph_lo = 0; a.ph_hi = NPHASES;
    hipLaunchKernelGGL(mega_fwd, dim3(grid), dim3(NTHR), LDS_BYTES, stream, a);
#endif
}
```
